# Optimizing an MI355X kernel written in HIP

```python
import jax, jax.numpy as jnp
from jax import lax
import numpy as np

D_MODEL = 1024
BATCH = 8
SEQ = 2048
DEPTH = 2
DEC_BATCH = 128
DEC_SEQ = 8
PAST_LEN = 2048
PAGE_SIZE = 128

N_MIXERS = 2
N_A = (DEPTH + 1) // 2
N_B = DEPTH // 2
RW_HEAD = 64
RW_HEADS = D_MODEL // RW_HEAD
RW_DECAY_LORA = 64
RW_AAA_LORA = 64
RW_GATE_LORA = 160
RW_GN_EPS = 64e-5
ATT_GROUPS = ((128, 1), (512, 4), (2048, 16))
N_GROUPS = 3
ATT_HEADS = 8
ATT_HEAD_DIM = 64
ATT_WIDTH = ATT_HEADS * ATT_HEAD_DIM
ATT_SCALE = ATT_HEAD_DIM ** -0.5
ROT_DIM = ATT_HEAD_DIM // 4
ROPE_THETA = 500000.0
D_FF = 2816
CONV_W = 3
NORM_EPS = 1e-6
F32 = jnp.float32

kernel_name = 'hybrid_rwkv7_dilated_swa_convffn_step'


def rmsnorm(x, g):
    xf = x.astype(F32)
    y = xf * lax.rsqrt(jnp.mean(xf * xf, axis=-1, keepdims=True) + NORM_EPS)
    return (y * g.astype(F32)).astype(x.dtype)


def rope(x, pos):
    half = ROT_DIM // 2
    inv = jnp.power(ROPE_THETA, -jnp.arange(half, dtype=F32) / half)
    ang = pos.astype(F32)[:, None] * inv[None, :]
    cos = jnp.cos(ang)[None, :, None, :]
    sin = jnp.sin(ang)[None, :, None, :]
    xf = x.astype(F32)
    x1, x2 = xf[..., :half], xf[..., half:ROT_DIM]
    out = jnp.concatenate([x1 * cos - x2 * sin, x2 * cos + x1 * sin, xf[..., ROT_DIM:]], axis=-1)
    return out.astype(x.dtype)


def rwkv7_mix(xn, shift_prev, s0, p):
    (mu, wr, wk, wv, wo, w0, w1, w2, a0, a1, a2, g1, g2, k_k, k_a, r_k, lnx_g, lnx_b) = p
    b, t, d = xn.shape
    h, n = RW_HEADS, RW_HEAD
    prev = jnp.concatenate([shift_prev[:, None, :].astype(xn.dtype), xn[:, :-1]], axis=1)
    xx = prev - xn
    xr, xw, xk, xv, xa, xg = [xn + xx * mu[i] for i in range(6)]
    r = xr @ wr
    k = xk @ wk
    v = xv @ wv
    w = -jax.nn.softplus(-(w0 + jnp.tanh(xw @ w1) @ w2)) - 0.5
    a = jax.nn.sigmoid(a0 + (xa @ a1) @ a2)
    g = jax.nn.sigmoid(xg @ g1) @ g2
    heads = lambda z: z.reshape(b, t, h, n).astype(F32)
    kk = heads(k * k_k)
    kk = kk / jnp.maximum(jnp.linalg.norm(kk, axis=-1, keepdims=True), 1e-12)
    k = k * (1 + (a - 1) * k_a)
    r_h, k_h, v_h, a_h = heads(r), heads(k), heads(v), heads(a)
    decay = jnp.exp(-jnp.exp(heads(w)))

    def step(S, inp):
        r_t, d_t, k_t, v_t, kk_t, a_t = inp
        sk = jnp.einsum('bhvk,bhk->bhv', S, kk_t)
        S = (S * d_t[:, :, None, :] - sk[..., None] * (kk_t * a_t)[:, :, None, :]
             + v_t[..., None] * k_t[:, :, None, :])
        return S, jnp.einsum('bhvk,bhk->bhv', S, r_t)

    tm = lambda z: jnp.swapaxes(z, 0, 1)
    s_fin, ys = lax.scan(step, s0.astype(F32),
                         (tm(r_h), tm(decay), tm(k_h), tm(v_h), tm(kk), tm(a_h)))
    y = tm(ys)
    mean = jnp.mean(y, axis=-1, keepdims=True)
    var = jnp.mean(jnp.square(y - mean), axis=-1, keepdims=True)
    y = ((y - mean) * lax.rsqrt(var + RW_GN_EPS)).reshape(b, t, d) * lnx_g + lnx_b
    bonus = jnp.sum(r_h * k_h * r_k, axis=-1, keepdims=True) * v_h
    y = (y + bonus.reshape(b, t, d)).astype(xn.dtype)
    out = (y * g) @ wo
    return out, xn[:, -1], s_fin.astype(s0.dtype)


def dilated_group_prompt(q, k, v, window, dil):
    b, s, h, e = q.shape
    blk = window // dil
    n_sub = s // dil
    nb = -(-n_sub // blk)
    lp = nb * blk

    def sub(z):
        z = z.reshape(b, n_sub, dil, h, e).transpose(0, 2, 1, 3, 4)
        return jnp.pad(z, ((0, 0), (0, 0), (0, lp - n_sub), (0, 0), (0, 0)))

    def band(z):
        z = jnp.pad(sub(z), ((0, 0), (0, 0), (blk, 0), (0, 0), (0, 0))).reshape(b, dil, nb + 1, blk, h, e)
        return jnp.concatenate([z[:, :, :-1], z[:, :, 1:]], axis=3)

    qb = sub(q).reshape(b, dil, nb, blk, h, e)
    kb, vb = band(k), band(v)
    sc = jnp.einsum('bdnqhe,bdnkhe->bdnqhk', qb, kb, preferred_element_type=F32) * ATT_SCALE
    qi = jnp.arange(blk)[:, None]
    kj = jnp.arange(2 * blk)[None, :]
    dist = qi + blk - kj
    kidx = jnp.arange(nb)[:, None, None] * blk + kj[None] - blk
    valid = (dist >= 0)[None] & (dist <= blk)[None] & (kidx >= 0)
    sc = jnp.where(valid[None, None, :, :, None, :], sc, -jnp.inf)
    lse = jax.nn.logsumexp(sc, axis=-1)
    pr = jnp.exp(sc - lse[..., None])
    o = jnp.einsum('bdnqhk,bdnkhe->bdnqhe', pr, vb.astype(F32))
    o = o.reshape(b, dil, lp, h, e)[:, :, :n_sub].transpose(0, 2, 1, 3, 4).reshape(b, s, h, e)
    lse = lse.reshape(b, dil, lp, h)[:, :, :n_sub].transpose(0, 2, 1, 3).reshape(b, s, h)
    return o, lse


def dilated_group_sample(q, k_all, v_all, window, dil, offset):
    t = q.shape[1]
    nk = window // dil + 1
    idx = offset + jnp.arange(t)[:, None] - dil * jnp.arange(nk)[None, :]
    valid = idx >= 0
    idx = jnp.maximum(idx, 0)
    kg = jnp.take(k_all, idx, axis=1)
    vg = jnp.take(v_all, idx, axis=1)
    sc = jnp.einsum('bthe,btjhe->bthj', q, kg, preferred_element_type=F32) * ATT_SCALE
    sc = jnp.where(valid[None, :, None, :], sc, -jnp.inf)
    lse = jax.nn.logsumexp(sc, axis=-1)
    pr = jnp.exp(sc - lse[..., None])
    o = jnp.einsum('bthj,btjhe->bthe', pr, vg.astype(F32))
    return o, lse


def dilated_attention(xn, pos, bufs, wqkv, wo):
    b, t, _ = xn.shape
    qkv = (xn @ wqkv).reshape(b, t, 3, N_GROUPS, ATT_HEADS, ATT_HEAD_DIM)
    outs, lses, new = [], [], []
    for gi in range(N_GROUPS):
        window, dil = ATT_GROUPS[gi]
        q = rope(qkv[:, :, 0, gi], pos)
        k = rope(qkv[:, :, 1, gi], pos)
        v = qkv[:, :, 2, gi]
        if bufs is None:
            o, lse = dilated_group_prompt(q, k, v, window, dil)
            keep = min(window, t)
            new.append(jnp.stack([k[:, t - keep:], v[:, t - keep:]], axis=2))
        else:
            buf = bufs[gi].astype(k.dtype)
            k_all = jnp.concatenate([buf[:, :, 0], k], axis=1)
            v_all = jnp.concatenate([buf[:, :, 1], v], axis=1)
            o, lse = dilated_group_sample(q, k_all, v_all, window, dil, buf.shape[1])
            new.append(jnp.stack([k, v], axis=2))
        outs.append(o)
        lses.append(lse)
    wts = jax.nn.softmax(jnp.stack(lses), axis=0)
    o = jnp.sum(wts[..., None] * jnp.stack(outs), axis=0)
    y = o.reshape(b, t, ATT_WIDTH).astype(xn.dtype) @ wo
    return y, new


def conv_ffn(xn, prev, wup, cw, cb, wdown):
    t = xn.shape[1]
    hid = xn @ wup
    hp = jnp.concatenate([prev.astype(hid.dtype), hid], axis=1)
    c = cb
    for j in range(CONV_W):
        c = c + hp[:, j:j + t] * cw[j]
    gate, val = jnp.split(c, 2, axis=-1)
    out = (jax.nn.gelu(gate, approximate=True) * val) @ wdown
    return out, hp[:, t:]


def run_trunk(x, pos, shift0, wkv0, kv_bufs, conv0, norm_g, rw, at_wqkv, at_wo, ff):
    new_shift, new_wkv, new_conv = [], [], []
    new_kv = [[], [], []]
    ia = 0
    ib = 0
    for layer in range(DEPTH):
        g = norm_g[layer]
        hn = rmsnorm(x, g[0])
        if layer % N_MIXERS == 0:
            mo, sh, st = rwkv7_mix(hn, shift0[ia], wkv0[ia], [p[ia] for p in rw])
            new_shift.append(sh)
            new_wkv.append(st)
            ia += 1
        else:
            bufs = None if kv_bufs is None else [buf[ib] for buf in kv_bufs]
            mo, kvs = dilated_attention(hn, pos, bufs, at_wqkv[ib], at_wo[ib])
            for gi in range(N_GROUPS):
                new_kv[gi].append(kvs[gi])
            ib += 1
        x = x + rmsnorm(mo, g[1])
        hn = rmsnorm(x, g[2])
        fo, cs = conv_ffn(hn, conv0[layer], ff[0][layer], ff[1][layer], ff[2][layer], ff[3][layer])
        new_conv.append(cs)
        x = x + rmsnorm(fo, g[3])
    kv_out = [jnp.stack(kv) for kv in new_kv]
    return x, jnp.stack(new_shift), jnp.stack(new_wkv), kv_out, jnp.stack(new_conv)


def setup_inputs(seed: int = 0) -> dict:
    key = jax.random.key(seed)
    ks = iter(jax.random.split(key, 64))
    nrm = lambda shape, scale=1.0: jax.random.normal(next(ks), shape, F32) * scale
    D = D_MODEL
    H, N = RW_HEADS, RW_HEAD
    F2 = 2 * D_FF
    wl = [min(w, PAST_LEN) for (w, _) in ATT_GROUPS]
    kvshape = lambda L: (N_B, DEC_BATCH, L, 2, ATT_HEADS, ATT_HEAD_DIM)
    return {
        'x_prompt': nrm((BATCH, SEQ, D)),
        'x_sample': nrm((DEC_BATCH, DEC_SEQ, D)),
        'state_shift': nrm((N_A, DEC_BATCH, D)),
        'state_wkv': nrm((N_A, DEC_BATCH, H, N, N), 0.3),
        'cache_kv_w128': nrm(kvshape(wl[0])),
        'cache_kv_w512': nrm(kvshape(wl[1])),
        'cache_kv_w2048': nrm(kvshape(wl[2])),
        'state_conv': nrm((DEPTH, DEC_BATCH, CONV_W - 1, F2)),
        'norm_g': 1.0 + nrm((DEPTH, 4, D), 0.05),
        'rw_mu': jax.random.uniform(next(ks), (N_A, 6, D), F32),
        'rw_wr': nrm((N_A, D, D), D ** -0.5),
        'rw_wk': nrm((N_A, D, D), D ** -0.5),
        'rw_wv': nrm((N_A, D, D), D ** -0.5),
        'rw_wo': nrm((N_A, D, D), D ** -0.5),
        'rw_w0': nrm((N_A, D), 0.5),
        'rw_w1': nrm((N_A, D, RW_DECAY_LORA), D ** -0.5),
        'rw_w2': nrm((N_A, RW_DECAY_LORA, D), 0.3 * RW_DECAY_LORA ** -0.5),
        'rw_a0': nrm((N_A, D), 0.5),
        'rw_a1': nrm((N_A, D, RW_AAA_LORA), D ** -0.5),
        'rw_a2': nrm((N_A, RW_AAA_LORA, D), 0.3 * RW_AAA_LORA ** -0.5),
        'rw_g1': nrm((N_A, D, RW_GATE_LORA), D ** -0.5),
        'rw_g2': nrm((N_A, RW_GATE_LORA, D), RW_GATE_LORA ** -0.5),
        'rw_kk': 0.85 + nrm((N_A, D), 0.05),
        'rw_ka': 1.0 + nrm((N_A, D), 0.05),
        'rw_rk': nrm((N_A, H, N), 0.1),
        'rw_lnx_g': 1.0 + nrm((N_A, D), 0.05),
        'rw_lnx_b': nrm((N_A, D), 0.02),
        'at_wqkv': nrm((N_B, D, 3 * N_GROUPS * ATT_WIDTH), D ** -0.5),
        'at_wo': nrm((N_B, ATT_WIDTH, D), ATT_WIDTH ** -0.5),
        'ff_wup': nrm((DEPTH, D, F2), D ** -0.5),
        'ff_conv_w': nrm((DEPTH, CONV_W, F2), CONV_W ** -0.5),
        'ff_conv_b': nrm((DEPTH, F2), 0.02),
        'ff_wdown': nrm((DEPTH, D_FF, D), D_FF ** -0.5),
    }


def reference(x_prompt, x_sample, state_shift, state_wkv, cache_kv_w128, cache_kv_w512,
              cache_kv_w2048, state_conv, norm_g, rw_mu, rw_wr, rw_wk, rw_wv, rw_wo,
              rw_w0, rw_w1, rw_w2, rw_a0, rw_a1, rw_a2, rw_g1, rw_g2, rw_kk, rw_ka, rw_rk,
              rw_lnx_g, rw_lnx_b, at_wqkv, at_wo, ff_wup, ff_conv_w, ff_conv_b, ff_wdown):
    rw = (rw_mu, rw_wr, rw_wk, rw_wv, rw_wo, rw_w0, rw_w1, rw_w2, rw_a0, rw_a1, rw_a2,
          rw_g1, rw_g2, rw_kk, rw_ka, rw_rk, rw_lnx_g, rw_lnx_b)
    ff = (ff_wup, ff_conv_w, ff_conv_b, ff_wdown)
    dt = x_prompt.dtype
    bp, tp = x_prompt.shape[0], x_prompt.shape[1]
    ts = x_sample.shape[1]
    pos_p = jnp.arange(tp, dtype=jnp.int32)
    y_prompt, p_shift, p_wkv, p_kv, p_conv = run_trunk(
        x_prompt, pos_p,
        jnp.zeros((N_A, bp, D_MODEL), dt),
        jnp.zeros((N_A, bp, RW_HEADS, RW_HEAD, RW_HEAD), dt),
        None,
        jnp.zeros((DEPTH, bp, CONV_W - 1, 2 * D_FF), dt),
        norm_g, rw, at_wqkv, at_wo, ff)
    pos_s = PAST_LEN + jnp.arange(ts, dtype=jnp.int32)
    y_sample, s_shift, s_wkv, s_kv, s_conv = run_trunk(
        x_sample, pos_s, state_shift, state_wkv,
        (cache_kv_w128, cache_kv_w512, cache_kv_w2048), state_conv,
        norm_g, rw, at_wqkv, at_wo, ff)
    return (y_prompt, y_sample, p_shift, p_wkv, p_kv[0], p_kv[1], p_kv[2], p_conv,
            s_shift, s_wkv, s_kv[0], s_kv[1], s_kv[2], s_conv)
```

```cpp
#include <hip/hip_runtime.h>
#include <cstdio>
#include <cstdint>
namespace pg8 {
#define PG8_LAS __attribute__((address_space(3)))
typedef unsigned short bf16_t;
typedef short bf16x8 __attribute__((ext_vector_type(8)));
typedef float f32x4 __attribute__((ext_vector_type(4)));
typedef float f32x2 __attribute__((ext_vector_type(2)));
typedef unsigned u32x4 __attribute__((ext_vector_type(4)));
typedef unsigned u32x2 __attribute__((ext_vector_type(2)));
constexpr int BM = 256, BK = 64, HALF = 128, HTB = HALF * BK * 2  , STAGE_BYTES = 8 * HTB, NXCD = 8, WGM = 8;

__host__ __device__ __forceinline__ int lds_byte(int r, int c) { const int st = (r >> 4) * 2 + (c >> 5), rr = r & 15, cc = c & 31, ob = rr * 64 + cc * 2; return st * 1024 + (ob ^ (((ob >> 9) & 1) << 5)); }
__host__ __device__ __forceinline__ void stage_rc(int b, int& R, int& C) { const int st = b / 1024, sb = b % 1024, swz = sb ^ (((sb >> 9) & 1) << 5); R = (st >> 1) * 16 + swz / 64; C = (st & 1) * 32 + (swz % 64) / 2; }
__host__ __device__ __forceinline__ int perm32(int rho) { const int n = rho >> 4, i = rho & 15; return 8 * (i >> 2) + 4 * n + (i & 3); }

struct Unit { int pm, pn; };
struct Gemm { const bf16_t* A; const bf16_t* Bt; int M, N, K; size_t a_sel_bytes; };

struct StaticOrder {
    int nM, nN, nwg, G, c;
    __host__ __device__ __forceinline__ void init(int M, int N, int G_, int c_) { nM = M / BM; nN = N / BM; nwg = nM * nN; G = G_; c = c_; }
    __host__ __device__ __forceinline__ bool next(int i, Unit& u) const {
        const long L = (long)i * G + c; if (L >= nwg) return false;
        int wgid = (int)L; { const int q = nwg / NXCD, r = nwg % NXCD, xcd = wgid % NXCD, off = wgid / NXCD; wgid = (xcd < r ? xcd * (q + 1) : r * (q + 1) + (xcd - r) * q) + off; }
        const int nig = WGM * nN, gid = wgid / nig, fm = gid * WGM, gsz = (nM - fm) < WGM ? (nM - fm) : WGM;
        u.pm = fm + ((wgid % nig) % gsz); u.pn = (wgid % nig) / gsz; return true;
    }
    __device__ __forceinline__ void a_ready(const Unit&) const {}
    __device__ __forceinline__ void done(const Unit&) const {}
};

__device__ __forceinline__ unsigned cvt_pk_bf16(float lo, float hi) { unsigned r; asm volatile("v_cvt_pk_bf16_f32 %0, %1, %2" : "=v"(r) : "v"(lo), "v"(hi)); return r; }
__device__ __forceinline__ float fast_tanh(float x) { return 1.0f - 2.0f / (1.0f + __expf(2.0f * x)); }
__device__ __forceinline__ float fast_sigmoid(float x) { return 1.0f / (1.0f + __expf(-x)); }

struct EpiF32 {
    static constexpr bool PERM = false, AFTER_DRAIN = false;
    static __device__ __forceinline__ int asel(int) { return 0; }
    float* C; int ldc;
    __device__ __forceinline__ void operator()(const f32x4 (&acc)[2][2][4][2], const Unit& u, int wr, int wc, int fr, int fq) const {
        const int row0 = u.pm * BM + wr * 64 + fr, col0 = u.pn * BM + wc * 32 + 4 * fq;
#pragma unroll
        for (int ai = 0; ai < 2; ++ai)
#pragma unroll
            for (int m = 0; m < 4; ++m) { float* rowp = C + (size_t)(row0 + ai * HALF + m * 16) * ldc + col0;
#pragma unroll
                for (int bj = 0; bj < 2; ++bj)
#pragma unroll
                    for (int n = 0; n < 2; ++n) *(f32x4*)(rowp + bj * HALF + n * 16) = acc[ai][bj][m][n]; }
    }
};
struct EpiBf16 {
    static constexpr bool PERM = true, AFTER_DRAIN = false;
    static __device__ __forceinline__ int asel(int) { return 0; }
    bf16_t* O; int ldc;
    __device__ __forceinline__ void operator()(const f32x4 (&acc)[2][2][4][2], const Unit& u, int wr, int wc, int fr, int fq) const {
        const int row0 = u.pm * BM + wr * 64 + fr, col0 = u.pn * BM + wc * 32 + 8 * fq;
#pragma unroll
        for (int ai = 0; ai < 2; ++ai)
#pragma unroll
            for (int m = 0; m < 4; ++m) { bf16_t* rowp = O + (size_t)(row0 + ai * HALF + m * 16) * ldc + col0;
#pragma unroll
                for (int bj = 0; bj < 2; ++bj) { const f32x4 v0 = acc[ai][bj][m][0], v1 = acc[ai][bj][m][1];
                    u32x4 w; w.x = cvt_pk_bf16(v0[0], v0[1]); w.y = cvt_pk_bf16(v0[2], v0[3]); w.z = cvt_pk_bf16(v1[0], v1[1]); w.w = cvt_pk_bf16(v1[2], v1[3]);
                    *(u32x4*)(rowp + bj * HALF) = w; } }
    }
};
constexpr size_t RKV_STRIDE = (size_t)17408 * 1024;
struct EpiG1 {
    static constexpr bool PERM = false, AFTER_DRAIN = false;
    static __device__ __forceinline__ int asel(int pn) { return pn < 12 ? (pn >> 2) : pn - 9; }
    float* RKV; bf16_t* L2A;
    __device__ __forceinline__ void operator()(const f32x4 (&acc)[2][2][4][2], const Unit& u, int wr, int wc, int fr, int fq) const {
        const int row0 = u.pm * BM + wr * 64 + fr;
        if (u.pn < 12) {
            float* base = RKV + (size_t)(u.pn >> 2) * RKV_STRIDE; const int col0 = (u.pn & 3) * BM + wc * 32 + 4 * fq;
#pragma unroll
            for (int ai = 0; ai < 2; ++ai)
#pragma unroll
                for (int m = 0; m < 4; ++m) { float* rowp = base + (size_t)(row0 + ai * HALF + m * 16) * 1024 + col0;
#pragma unroll
                    for (int bj = 0; bj < 2; ++bj)
#pragma unroll
                        for (int n = 0; n < 2; ++n) *(f32x4*)(rowp + bj * HALF + n * 16) = acc[ai][bj][m][n]; }
        } else {
            const int mode = u.pn - 12, cbase = mode == 0 ? 0 : (mode == 1 ? 64 : 128);
#pragma unroll
            for (int ai = 0; ai < 2; ++ai)
#pragma unroll
                for (int m = 0; m < 4; ++m) { bf16_t* rowp = L2A + (size_t)(row0 + ai * HALF + m * 16) * 384 + cbase;
#pragma unroll
                    for (int bj = 0; bj < 2; ++bj)
#pragma unroll
                        for (int n = 0; n < 2; ++n) { const int lc = bj * HALF + wc * 32 + n * 16 + 4 * fq;
                            if (mode < 2 && lc >= 64) continue;
                            f32x4 v = acc[ai][bj][m][n];
                            if (mode == 0) { v[0] = fast_tanh(v[0]); v[1] = fast_tanh(v[1]); v[2] = fast_tanh(v[2]); v[3] = fast_tanh(v[3]); }
                            if (mode == 2) { v[0] = fast_sigmoid(v[0]); v[1] = fast_sigmoid(v[1]); v[2] = fast_sigmoid(v[2]); v[3] = fast_sigmoid(v[3]); }
                            u32x2 w; w.x = cvt_pk_bf16(v[0], v[1]); w.y = cvt_pk_bf16(v[2], v[3]); *(u32x2*)(rowp + lc) = w; } }
        }
    }
};
struct EpiL2 {
    static constexpr bool PERM = false, AFTER_DRAIN = false;
    static __device__ __forceinline__ int asel(int) { return 0; }
    float* DAG; const float* w0; const float* a0;
    __device__ __forceinline__ void operator()(const f32x4 (&acc)[2][2][4][2], const Unit& u, int wr, int wc, int fr, int fq) const {
        const int row0 = u.pm * BM + wr * 64 + fr, mode = u.pn >> 2, col0 = (u.pn & 3) * BM + wc * 32 + 4 * fq;
        float* base = DAG + (size_t)mode * RKV_STRIDE + (size_t)row0 * 1024 + col0;
        if (mode == 0) {
#pragma unroll
            for (int bj = 0; bj < 2; ++bj)
#pragma unroll
                for (int n = 0; n < 2; ++n) { const f32x4 bv = *(const f32x4*)(w0 + col0 + bj * HALF + n * 16);
#pragma unroll
                    for (int ai = 0; ai < 2; ++ai)
#pragma unroll
                        for (int m = 0; m < 4; ++m) { f32x4 v = acc[ai][bj][m][n] + bv;
#pragma unroll
                            for (int j = 0; j < 4; ++j) { const float z = v[j], sp = fmaxf(-z, 0.f) + __logf(1.0f + __expf(-fabsf(z))); v[j] = __expf(-__expf(-sp - 0.5f)); }
                            *(f32x4*)(base + (size_t)(ai * HALF + m * 16) * 1024 + bj * HALF + n * 16) = v; } }
        } else if (mode == 1) {
#pragma unroll
            for (int bj = 0; bj < 2; ++bj)
#pragma unroll
                for (int n = 0; n < 2; ++n) { const f32x4 bv = *(const f32x4*)(a0 + col0 + bj * HALF + n * 16);
#pragma unroll
                    for (int ai = 0; ai < 2; ++ai)
#pragma unroll
                        for (int m = 0; m < 4; ++m) { f32x4 v = acc[ai][bj][m][n] + bv;
#pragma unroll
                            for (int j = 0; j < 4; ++j) v[j] = fast_sigmoid(v[j]);
                            *(f32x4*)(base + (size_t)(ai * HALF + m * 16) * 1024 + bj * HALF + n * 16) = v; } }
        } else {
#pragma unroll
            for (int ai = 0; ai < 2; ++ai)
#pragma unroll
                for (int m = 0; m < 4; ++m)
#pragma unroll
                    for (int bj = 0; bj < 2; ++bj)
#pragma unroll
                        for (int n = 0; n < 2; ++n) *(f32x4*)(base + (size_t)(ai * HALF + m * 16) * 1024 + bj * HALF + n * 16) = acc[ai][bj][m][n];
        }
    }
};
constexpr int EX_FLOATS_PER_BLK = 2 * 2 * 128;
__device__ __forceinline__ float gelu_tanh_f(float x) { const float u = 0.7978845608028654f * (x + 0.044715f * x * x * x); return 0.5f * x * (1.0f + fast_tanh(u)); }
#define PG8_ROR(x, n) __builtin_bit_cast(float, __builtin_amdgcn_mov_dpp(__builtin_bit_cast(int, (x)), 0x120 + (n), 0xF, 0xF, false))
struct EpiConv {
    static constexpr bool PERM = true, AFTER_DRAIN = false;
    static __device__ __forceinline__ int asel(int) { return 0; }
    bf16_t* ACT; float* HALO; float* RAWS; float* pconv; float* sconv; const float* cw; const float* cb; PG8_LAS float* X;
    __device__ __forceinline__ void operator()(f32x4 (&acc)[2][2][4][2], const Unit& u, int wr, int wc, int fr, int fq) const {
        constexpr int FFc = 2816, F2c = 5632, MPc = 16384;
        const int lcb = wc * 32 + 8 * fq, cg = u.pn * 128 + lcb;
        if (fr >= 14) {
#pragma unroll
            for (int ai = 0; ai < 2; ++ai)
#pragma unroll
                for (int bj = 0; bj < 2; ++bj)
#pragma unroll
                    for (int n = 0; n < 2; ++n) *(PG8_LAS f32x4*)(X + (ai * 2 + wr) * EX_FLOATS_PER_BLK + ((fr - 14) * 2 + bj) * 128 + lcb + 4 * n) = acc[ai][bj][3][n];
        }
        asm volatile("s_waitcnt lgkmcnt(0)" ::: "memory"); __builtin_amdgcn_s_barrier(); asm volatile("" ::: "memory");
        const int row0 = u.pm * BM + wr * 64 + fr;
        if (u.pm >= 64) {
            const int t = fr & 7;
            if (t < 2 || t >= 6) {
#pragma unroll
                for (int ai = 0; ai < 2; ++ai)
#pragma unroll
                    for (int m = 0; m < 4; ++m) { const int rs = row0 + ai * HALF + m * 16 - MPc; float* dst = t < 2 ? RAWS + (size_t)rs * F2c : sconv + ((size_t)(rs >> 3) * 2 + (t - 6)) * F2c;
#pragma unroll
                        for (int bj = 0; bj < 2; ++bj)
#pragma unroll
                            for (int n = 0; n < 2; ++n) *(f32x4*)(dst + bj * FFc + cg + 4 * n) = acc[ai][bj][m][n]; }
            }
        } else {
            if (wr == 0 && fr < 2) {
#pragma unroll
                for (int bj = 0; bj < 2; ++bj)
#pragma unroll
                    for (int n = 0; n < 2; ++n) *(f32x4*)(HALO + ((size_t)u.pm * 4 + fr) * F2c + bj * FFc + cg + 4 * n) = acc[0][bj][0][n]; }
            if (wr == 1 && fr >= 14) {
#pragma unroll
                for (int bj = 0; bj < 2; ++bj)
#pragma unroll
                    for (int n = 0; n < 2; ++n) { *(f32x4*)(HALO + ((size_t)u.pm * 4 + fr - 12) * F2c + bj * FFc + cg + 4 * n) = acc[1][bj][3][n];
                        if ((u.pm & 7) == 7) *(f32x4*)(pconv + ((size_t)(u.pm >> 3) * 2 + (fr - 14)) * F2c + bj * FFc + cg + 4 * n) = acc[1][bj][3][n]; } }
        }
        asm volatile("" ::: "memory"); __builtin_amdgcn_sched_barrier(0);
#pragma unroll
        for (int n = 0; n < 2; ++n)
#pragma unroll
            for (int s = 0; s < 2; ++s) {
                const int c = s * FFc + cg + 4 * n;
                const f32x4 bb = *(const f32x4*)(cb + c), w0 = *(const f32x4*)(cw + c), w1 = *(const f32x4*)(cw + F2c + c), w2 = *(const f32x4*)(cw + 2 * F2c + c);
#pragma unroll
                for (int ai = 0; ai < 2; ++ai) {
                    const int pblk = wr == 1 ? ai * 2 : 1; const bool has_prev = (wr == 1 || ai == 1);
                    f32x4 e1 = *(const PG8_LAS f32x4*)(X + pblk * EX_FLOATS_PER_BLK + (1 * 2 + s) * 128 + lcb + 4 * n), e2 = *(const PG8_LAS f32x4*)(X + pblk * EX_FLOATS_PER_BLK + (0 * 2 + s) * 128 + lcb + 4 * n);
                    if (!has_prev) { e1 = (f32x4){0.f, 0.f, 0.f, 0.f}; e2 = e1; }
                    f32x4 p1, p2;
#pragma unroll
                    for (int m = 0; m < 4; ++m) {
                        const f32x4 a = acc[ai][s][m][n]; f32x4 r1, r2, h1, h2;
                        asm volatile("s_nop 1\n\tv_mov_b32_dpp %0, %8 row_ror:1 row_mask:0xf bank_mask:0xf\n\tv_mov_b32_dpp %1, %9 row_ror:1 row_mask:0xf bank_mask:0xf\n\tv_mov_b32_dpp %2, %10 row_ror:1 row_mask:0xf bank_mask:0xf\n\tv_mov_b32_dpp %3, %11 row_ror:1 row_mask:0xf bank_mask:0xf\n\t"
                                     "v_mov_b32_dpp %4, %8 row_ror:2 row_mask:0xf bank_mask:0xf\n\tv_mov_b32_dpp %5, %9 row_ror:2 row_mask:0xf bank_mask:0xf\n\tv_mov_b32_dpp %6, %10 row_ror:2 row_mask:0xf bank_mask:0xf\n\tv_mov_b32_dpp %7, %11 row_ror:2 row_mask:0xf bank_mask:0xf"
                                     : "=&v"(r1[0]), "=&v"(r1[1]), "=&v"(r1[2]), "=&v"(r1[3]), "=&v"(r2[0]), "=&v"(r2[1]), "=&v"(r2[2]), "=&v"(r2[3]) : "v"(a[0]), "v"(a[1]), "v"(a[2]), "v"(a[3]));
                        if (m == 0) { h1 = fr >= 1 ? r1 : e1; h2 = fr >= 2 ? r2 : (fr == 0 ? e2 : e1); }
                        else { h1 = fr >= 1 ? r1 : p1; h2 = fr >= 2 ? r2 : p2; }
                        p1 = r1; p2 = r2;
                        acc[ai][s][m][n] = bb + w0 * h2 + w1 * h1 + w2 * a;
                        __builtin_amdgcn_sched_barrier(0);
                    }
                }
                asm volatile("" ::: "memory"); __builtin_amdgcn_sched_barrier(0);
            }
#pragma unroll
        for (int ai = 0; ai < 2; ++ai)
#pragma unroll
            for (int m = 0; m < 4; ++m) { const int row = row0 + ai * HALF + m * 16; u32x4 o;
                { const f32x4 g = acc[ai][0][m][0], v = acc[ai][1][m][0]; o.x = cvt_pk_bf16(gelu_tanh_f(g[0]) * v[0], gelu_tanh_f(g[1]) * v[1]); o.y = cvt_pk_bf16(gelu_tanh_f(g[2]) * v[2], gelu_tanh_f(g[3]) * v[3]); }
                { const f32x4 g = acc[ai][0][m][1], v = acc[ai][1][m][1]; o.z = cvt_pk_bf16(gelu_tanh_f(g[0]) * v[0], gelu_tanh_f(g[1]) * v[1]); o.w = cvt_pk_bf16(gelu_tanh_f(g[2]) * v[2], gelu_tanh_f(g[3]) * v[3]); }
                *(u32x4*)(ACT + (size_t)row * FFc + cg) = o; }
    }
};
template <class Epi, class Sched, bool ALIGN_EPI = false, bool SP2 = false>
__device__ __forceinline__ void gemm_phase(PG8_LAS unsigned char* lds, const Gemm g, const Sched& S, const Epi& E) {
    const int tid = threadIdx.x, wid = __builtin_amdgcn_readfirstlane(tid >> 6), lane = tid & 63, wr = wid >> 2, wc = wid & 3, fr = lane & 15, fq = lane >> 4;
    int K = g.K; asm volatile("" : "+s"(K));
    const int nt = K / BK;
    unsigned voffA[2], voffB[2];
#pragma unroll
    for (int i = 0; i < 2; ++i) { int R, C; stage_rc(tid * 16 + i * 8192, R, C); const int Rb = Epi::PERM ? ((R & ~31) + perm32(R & 31)) : R;
        voffA[i] = (unsigned)(R * K + C) * 2u; voffB[i] = (unsigned)(Rb * K + C) * 2u; }
    const size_t kstep = (size_t)(BK * 2);
    const size_t hstep = (size_t)HALF * K * 2;
    const size_t tstep = 2 * hstep;
    const unsigned ldsw = (unsigned)wid * 1024u;
    const int aoff = lds_byte(wr * 64 + fr, fq * 8), boff = lds_byte(wc * 32 + fr, fq * 8);
#define PG8_SA(b, h) (((b) * 2 + (h)) * HTB)
#define PG8_SB(b, h) ((4 + (b) * 2 + (h)) * HTB)
#define PG8_STAGE(bufoff, gbase, voff) do { _Pragma("unroll") for (int _i = 0; _i < 2; ++_i) \
        __builtin_amdgcn_global_load_lds((const unsigned*)((const char*)(gbase) + (voff)[_i]), (PG8_LAS unsigned*)(lds + (bufoff) + ldsw + _i * 8192), 16, 0, 0); } while (0)
#define PG8_LDA(dst, b, h) do { _Pragma("unroll") for (int m = 0; m < 4; ++m) _Pragma("unroll") for (int k = 0; k < 2; ++k) dst[m][k] = *(const PG8_LAS bf16x8*)(lds + PG8_SA(b, h) + aoff + m * 2048 + k * 1024); } while (0)
#define PG8_LDB(dst, b, h) do { _Pragma("unroll") for (int n = 0; n < 2; ++n) _Pragma("unroll") for (int k = 0; k < 2; ++k) dst[n][k] = *(const PG8_LAS bf16x8*)(lds + PG8_SB(b, h) + boff + n * 2048 + k * 1024); } while (0)
#define PG8_MMA(ai, bj, At, Bt) do { __builtin_amdgcn_s_setprio(1); _Pragma("unroll") for (int m = 0; m < 4; ++m) _Pragma("unroll") for (int n = 0; n < 2; ++n) _Pragma("unroll") for (int k = 0; k < 2; ++k) \
        acc[ai][bj][m][n] = __builtin_amdgcn_mfma_f32_16x16x32_bf16(Bt[n][k], At[m][k], acc[ai][bj][m][n], 0, 0, 0); __builtin_amdgcn_s_setprio(0); } while (0)
#define PG8_WAIT_V(n) asm volatile("s_waitcnt vmcnt(" #n ")" ::: "memory")
#define PG8_WAIT_L(n) asm volatile("s_waitcnt lgkmcnt(" #n ")" ::: "memory")
#define PG8_BAR __builtin_amdgcn_s_barrier()
#define PG8_SCHED __builtin_amdgcn_sched_barrier(0)
    Unit cur, nxt; int ui = 0;
    if (!S.next(0, cur)) return;
    f32x4 acc[2][2][4][2];
#pragma unroll
    for (int a = 0; a < 2; ++a)
#pragma unroll
        for (int b = 0; b < 2; ++b)
#pragma unroll
            for (int m = 0; m < 4; ++m)
#pragma unroll
                for (int n = 0; n < 2; ++n) acc[a][b][m][n] = (f32x4){0.f, 0.f, 0.f, 0.f};
    bf16x8 At[4][2], B0[2][2], B1[2][2];
    const char* cA = (const char*)g.A + (size_t)Epi::asel(cur.pn) * g.a_sel_bytes + (size_t)cur.pm * tstep; const char* cB = (const char*)g.Bt + (size_t)cur.pn * tstep;
    S.a_ready(cur);
    if constexpr (SP2) {
        PG8_STAGE(PG8_SB(0, 0), cB, voffB); PG8_STAGE(PG8_SB(0, 1), cB + hstep, voffB); PG8_STAGE(PG8_SA(0, 0), cA, voffA); PG8_STAGE(PG8_SA(0, 1), cA + hstep, voffA);
        if (wr == 1) PG8_BAR;
        PG8_WAIT_V(2); PG8_BAR;
        PG8_STAGE(PG8_SB(1, 0), cB + kstep, voffB); PG8_STAGE(PG8_SA(1, 0), cA + kstep, voffA); PG8_STAGE(PG8_SB(1, 1), cB + hstep + kstep, voffB);
        PG8_WAIT_V(6); PG8_BAR;
    } else {
        PG8_STAGE(PG8_SB(0, 0), cB, voffB); PG8_STAGE(PG8_SA(0, 0), cA, voffA); PG8_STAGE(PG8_SB(0, 1), cB + hstep, voffB); PG8_STAGE(PG8_SA(0, 1), cA + hstep, voffA);
        if (wr == 1) PG8_BAR;
        PG8_WAIT_V(4); PG8_BAR;
        PG8_STAGE(PG8_SB(1, 0), cB + kstep, voffB); PG8_STAGE(PG8_SA(1, 0), cA + kstep, voffA); PG8_STAGE(PG8_SB(1, 1), cB + hstep + kstep, voffB);
        PG8_WAIT_V(6); PG8_BAR;
    }
    for (;;) {
        const bool has_next = S.next(ui + 1, nxt);
        const char* nA = has_next ? (const char*)g.A + (size_t)Epi::asel(nxt.pn) * g.a_sel_bytes + (size_t)nxt.pm * tstep : cA; const char* nB = has_next ? (const char*)g.Bt + (size_t)nxt.pn * tstep : cB;
        for (int t = 0; t < nt; t += 2) {
            const bool last = (t == nt - 2);
            const char* a1 = cA + (size_t)(t + 1) * kstep;
            const char* a2 = last ? nA : cA + (size_t)(t + 2) * kstep; const char* b2 = last ? nB : cB + (size_t)(t + 2) * kstep;
            const char* a3 = a2 + kstep; const char* b3 = b2 + kstep;
            if (last && has_next) S.a_ready(nxt);
            if constexpr (SP2) {
            PG8_LDB(B0, 0, 0); PG8_LDB(B1, 0, 1); PG8_SCHED; PG8_LDA(At, 0, 0); PG8_STAGE(PG8_SA(1, 1), a1 + hstep, voffA);
            PG8_WAIT_V(8); PG8_WAIT_L(0); PG8_BAR; PG8_MMA(0, 0, At, B0); PG8_MMA(0, 1, At, B1); PG8_BAR; PG8_SCHED;
            PG8_LDA(At, 0, 1); PG8_STAGE(PG8_SB(0, 0), b2, voffB); PG8_STAGE(PG8_SB(0, 1), b2 + hstep, voffB); PG8_STAGE(PG8_SA(0, 0), a2, voffA);
            PG8_WAIT_V(8); PG8_WAIT_L(0); PG8_BAR; PG8_MMA(1, 0, At, B0); PG8_MMA(1, 1, At, B1); PG8_BAR; PG8_SCHED;
            PG8_LDB(B0, 1, 0); PG8_LDB(B1, 1, 1); PG8_SCHED; PG8_LDA(At, 1, 0); PG8_STAGE(PG8_SA(0, 1), a2 + hstep, voffA);
            PG8_WAIT_V(8); PG8_WAIT_L(0); PG8_BAR; PG8_MMA(0, 0, At, B0); PG8_MMA(0, 1, At, B1); PG8_BAR; PG8_SCHED;
            PG8_LDA(At, 1, 1); PG8_STAGE(PG8_SB(1, 0), b3, voffB); PG8_STAGE(PG8_SB(1, 1), b3 + hstep, voffB); PG8_STAGE(PG8_SA(1, 0), a3, voffA);
            PG8_WAIT_V(8); PG8_WAIT_L(0); PG8_BAR; PG8_MMA(1, 0, At, B0); PG8_MMA(1, 1, At, B1); PG8_BAR; PG8_SCHED;
            } else {
            PG8_LDB(B0, 0, 0); PG8_SCHED; PG8_LDA(At, 0, 0); PG8_STAGE(PG8_SA(1, 1), a1 + hstep, voffA);
            PG8_WAIT_L(8); PG8_BAR; PG8_WAIT_L(0); PG8_MMA(0, 0, At, B0); PG8_BAR; PG8_SCHED;
            PG8_LDB(B1, 0, 1); PG8_STAGE(PG8_SB(0, 0), b2, voffB);
            PG8_BAR; PG8_WAIT_L(0); PG8_MMA(0, 1, At, B1); PG8_BAR;
            PG8_LDA(At, 0, 1); PG8_STAGE(PG8_SA(0, 0), a2, voffA);
            PG8_BAR; PG8_WAIT_L(0); PG8_MMA(1, 0, At, B0); PG8_BAR; PG8_SCHED;
            PG8_STAGE(PG8_SB(0, 1), b2 + hstep, voffB);
            PG8_WAIT_V(6); PG8_BAR; PG8_MMA(1, 1, At, B1); PG8_BAR;
            PG8_LDB(B0, 1, 0); PG8_SCHED; PG8_LDA(At, 1, 0); PG8_STAGE(PG8_SA(0, 1), a2 + hstep, voffA);
            PG8_WAIT_L(8); PG8_BAR; PG8_WAIT_L(0); PG8_MMA(0, 0, At, B0); PG8_BAR; PG8_SCHED;
            PG8_LDB(B1, 1, 1); PG8_STAGE(PG8_SB(1, 0), b3, voffB);
            PG8_BAR; PG8_WAIT_L(0); PG8_MMA(0, 1, At, B1); PG8_BAR;
            PG8_LDA(At, 1, 1); PG8_STAGE(PG8_SA(1, 0), a3, voffA);
            PG8_BAR; PG8_WAIT_L(0); PG8_MMA(1, 0, At, B0); PG8_BAR; PG8_SCHED;
            PG8_STAGE(PG8_SB(1, 1), b3 + hstep, voffB);
            PG8_WAIT_V(6); PG8_BAR; PG8_MMA(1, 1, At, B1); PG8_BAR;
            }
        }
        if constexpr (ALIGN_EPI) { if (wr == 0) PG8_BAR; }
        if constexpr (!Epi::AFTER_DRAIN) { E(acc, cur, wr, wc, fr, fq); S.done(cur); }
        if (!has_next) break;
#pragma unroll
        for (int a = 0; a < 2; ++a)
#pragma unroll
            for (int b = 0; b < 2; ++b)
#pragma unroll
                for (int m = 0; m < 4; ++m)
#pragma unroll
                    for (int n = 0; n < 2; ++n) acc[a][b][m][n] = (f32x4){0.f, 0.f, 0.f, 0.f};
        cur = nxt; cA = nA; cB = nB; ++ui;
        if constexpr (ALIGN_EPI) { if (wr == 1) PG8_BAR; }
    }
    PG8_WAIT_V(0);
    if constexpr (!ALIGN_EPI) { if (wr == 0) PG8_BAR; }
    PG8_BAR;
    if constexpr (Epi::AFTER_DRAIN) { E.fused(acc, cur, wr, wc, fr, fq, lds, wid, lane); S.done(cur); }
#undef PG8_SA
#undef PG8_SB
#undef PG8_STAGE
#undef PG8_LDA
#undef PG8_LDB
#undef PG8_MMA
#undef PG8_WAIT_V
#undef PG8_WAIT_L
#undef PG8_BAR
#undef PG8_SCHED
}
}
using pg8::fast_tanh; using pg8::fast_sigmoid;

constexpr int D = 1024, PB = 8, PT = 2048, SBN = 128, STN = 8;
constexpr int MP = PB * PT, MS = SBN * STN, M = MP + MS;
constexpr int RH = 16, FF = 2816, F2 = 5632, AH = 8, AW = 512, NQKV = 4608;
constexpr float NORM_EPS = 1e-6f, GN_EPS = 64e-5f;
constexpr size_t O_YP = 0, O_YS = O_YP + (size_t)MP * D, O_PSHIFT = O_YS + (size_t)MS * D, O_PWKV = O_PSHIFT + (size_t)PB * D,
    O_PKV128 = O_PWKV + (size_t)PB * RH * 64 * 64, O_PKV512 = O_PKV128 + (size_t)PB * 128 * 1024, O_PKV2048 = O_PKV512 + (size_t)PB * 512 * 1024,
    O_PCONV = O_PKV2048 + (size_t)PB * 2048 * 1024, O_SSHIFT = O_PCONV + (size_t)2 * PB * 2 * F2, O_SWKV = O_SSHIFT + (size_t)SBN * D,
    O_SKV128 = O_SWKV + (size_t)SBN * RH * 64 * 64, O_SKV512 = O_SKV128 + (size_t)SBN * 8 * 1024, O_SKV2048 = O_SKV512 + (size_t)SBN * 8 * 1024,
    O_SCONV = O_SKV2048 + (size_t)SBN * 8 * 1024, O_END = O_SCONV + (size_t)2 * SBN * 2 * F2;
static_assert(O_END == 55107584, "output size");
constexpr size_t MiB = 1u << 20;
constexpr size_t WS_CTL = 0, CTL_ZERO_BYTES = 1 * MiB;
constexpr size_t WS_ROPE = 1 * MiB;
constexpr size_t WS_W1CAT = 2 * MiB, WS_WL2 = 10 * MiB, WS_WORW = 13 * MiB, WS_WUP0 = 15 * MiB, WS_WDN0 = 26 * MiB, WS_WQKV = 32 * MiB, WS_WOAT = 41 * MiB, WS_WUP1 = 42 * MiB, WS_WDN1 = 53 * MiB;
constexpr size_t RB16 = (size_t)M * D * 2, RF32 = (size_t)M * D * 4;
constexpr size_t WS_XM = 64 * MiB;
constexpr size_t WS_R = WS_XM + 6 * RB16, WS_K = WS_R + RF32, WS_V = WS_K + RF32, WS_DC = WS_V + RF32, WS_AA = WS_DC + RF32, WS_GG = WS_AA + RF32;
constexpr size_t WS_L2A = WS_GG + RF32;
constexpr size_t WS_Y = WS_L2A + 13 * MiB, WS_BONUS = WS_Y + RF32, WS_YG = WS_BONUS + 2 * MiB, WS_MO = WS_YG + RB16;
constexpr size_t WS_X1 = WS_MO + RF32, WS_X2 = WS_X1 + RF32, WS_X3 = WS_X2 + RF32, WS_XN = WS_X3 + RF32;
constexpr size_t WS_HID = WS_XN + RB16;
constexpr size_t WS_ACT = WS_HID + (size_t)M * F2 * 2;
constexpr size_t WS_QKV = WS_ACT + (size_t)M * FF * 2;
constexpr size_t WS_OG = WS_QKV + (size_t)M * NQKV * 2;
constexpr size_t WS_LSE = WS_OG + (size_t)3 * M * AW * 2;
constexpr size_t WS_OM = WS_LSE + 2 * MiB;
constexpr size_t WS_END = WS_OM + (size_t)M * AW * 2 + MiB;
static_assert(WS_W1CAT + (size_t)3840 * 1024 * 2 <= WS_WL2 && WS_WL2 + (size_t)3072 * 384 * 2 <= WS_WORW && WS_WUP0 + (size_t)F2 * D * 2 <= WS_WDN0 && WS_WDN0 + (size_t)D * FF * 2 <= WS_WQKV &&
              WS_WQKV + (size_t)NQKV * D * 2 <= WS_WOAT && WS_WUP1 + (size_t)F2 * D * 2 <= WS_WDN1 && WS_WDN1 + (size_t)D * FF * 2 <= WS_XM && (size_t)M * 384 * 2 <= 13 * MiB && (size_t)3 * M * 8 * 4 <= 2 * MiB, "ws map");
constexpr int CW_TMO = 0, CW_BAR = 4096;

constexpr int NWAVES = 8;
constexpr int RING_OFF = 0, RING_BYTES = 131072;
constexpr int LDSCTL_OFF = RING_BYTES, MISC_OFF = LDSCTL_OFF + 320;
constexpr int EX_OFF = MISC_OFF + 128;
constexpr int LDS_BYTES = 147456;

#define GAS __attribute__((address_space(1)))
#define LAS __attribute__((address_space(3)))
typedef unsigned short bf16;
typedef unsigned v4u __attribute__((ext_vector_type(4)));
typedef unsigned v2u __attribute__((ext_vector_type(2)));
typedef float f32x4 __attribute__((ext_vector_type(4)));
typedef float f32x2 __attribute__((ext_vector_type(2)));
typedef short bf16x8 __attribute__((ext_vector_type(8)));
typedef GAS unsigned gu32;
#define RLX_AGENT __ATOMIC_RELAXED, __HIP_MEMORY_SCOPE_AGENT
#define LDS_WAIT() asm volatile("s_waitcnt lgkmcnt(0)" ::: "memory")
#define VM_WAIT() asm volatile("s_waitcnt vmcnt(0)" ::: "memory")
__device__ __forceinline__ unsigned f2bf(float f) { unsigned u = __builtin_bit_cast(unsigned, f); return (u + 0x7fffu + ((u >> 16) & 1u)) >> 16; }
__device__ __forceinline__ unsigned pk2(float lo, float hi) { return f2bf(lo) | (f2bf(hi) << 16); }
__device__ __forceinline__ float bflo(unsigned w) { return __builtin_bit_cast(float, w << 16); }
__device__ __forceinline__ float bfhi(unsigned w) { return __builtin_bit_cast(float, w & 0xffff0000u); }
__device__ __forceinline__ float wave_sum(float v) {
#pragma unroll
    for (int o = 1; o < 64; o <<= 1) v += __shfl_xor(v, o);
    return v;
}
#define DPP_F(x, ctrl) __builtin_bit_cast(float, __builtin_amdgcn_mov_dpp(__builtin_bit_cast(int, (x)), (ctrl), 0xF, 0xF, true))
__device__ __forceinline__ float row16_sum(float x) {
    x += DPP_F(x, 0xB1);
    x += DPP_F(x, 0x4E);
    x += DPP_F(x, 0x141);
    x += DPP_F(x, 0x140);
    return x;
}
#define XB_TMO      128
#define XB_XCNT(j)  (256  + 64 * (j))
#define XB_XSUB(j)  (1280 + 64 * (j))
#define XB_XGEN(j)  (2304 + 64 * (j))
#define XB_TOP      3328
#define XB_TOPGEN   3392
#define XCD_BAR_WORDS 3456
#define XB_SPIN_CAP (1u << 18)

__device__ __forceinline__ unsigned xb_ld(unsigned* p)              { return __hip_atomic_load(p, __ATOMIC_RELAXED, __HIP_MEMORY_SCOPE_AGENT); }
__device__ __forceinline__ unsigned xb_add(unsigned* p, unsigned v) { return __hip_atomic_fetch_add(p, v, __ATOMIC_RELAXED, __HIP_MEMORY_SCOPE_AGENT); }
__device__ __forceinline__ unsigned xb_xcc_id() { return (unsigned)__builtin_amdgcn_s_getreg((3 << 11) | 20) & 0xFu; }
#define XB_SPIN(cond, bar) do { unsigned _sp = 0; while (cond) { __builtin_amdgcn_s_sleep(1); \
    if ((++_sp & 255u) == 0u) { if (xb_ld(&(bar)[XB_TMO])) break; if (_sp > XB_SPIN_CAP) { atomicAdd(&(bar)[XB_TMO], 1u); break; } } } } while (0)

struct XcdBarrier {
    unsigned* bar; unsigned x;
    volatile LAS unsigned* st;
};

__device__ __forceinline__ XcdBarrier xcd_barrier_post(unsigned* bar, volatile LAS unsigned* st) {
    XcdBarrier b; b.bar = bar; b.x = xb_xcc_id(); b.st = st;
    if (threadIdx.x == 0) (void)xb_add(&bar[XB_XCNT(b.x)], 1u);
    return b;
}
__device__ __forceinline__ void xcd_barrier_complete(unsigned* bar, unsigned x, unsigned& nloc, unsigned& nx) {
    const unsigned G = gridDim.x * gridDim.y * gridDim.z;
    unsigned sum, cnt, mine, sp = 0u;
    for (;;) {
        sum = 0u; cnt = 0u; mine = 0u;
#pragma unroll
        for (unsigned j = 0; j < 16; ++j) { const unsigned c = xb_ld(&bar[XB_XCNT(j)]); sum += c; cnt += (c > 0u) ? 1u : 0u; mine = (j == x) ? c : mine; }
        if (sum == G) break;
        __builtin_amdgcn_s_sleep(1);
        if ((++sp & 255u) == 0u) { if (xb_ld(&bar[XB_TMO])) break; if (sp > XB_SPIN_CAP) { atomicAdd(&bar[XB_TMO], 1u); break; } }
    }
    nloc = mine > 0u ? mine : 1u; nx = cnt > 0u ? cnt : 1u;
}

__device__ __forceinline__ void xcd_barrier(const XcdBarrier& b) {
    asm volatile("s_waitcnt vmcnt(0)" ::: "memory");
    __syncthreads();
    if (threadIdx.x == 0) {
        unsigned* bar = b.bar;
        __builtin_amdgcn_s_waitcnt(0);
        unsigned nloc = b.st[0], nx = b.st[1];
        if (nloc == 0u) { xcd_barrier_complete(bar, b.x, nloc, nx); b.st[0] = nloc; b.st[1] = nx; }
        const unsigned old = xb_add(&bar[XB_XSUB(b.x)], 1u);
        const unsigned gen = old / nloc;
        if (old + 1u == (gen + 1u) * nloc) {
            __builtin_amdgcn_fence(__ATOMIC_RELEASE, "agent");
            asm volatile("s_waitcnt vmcnt(0)" ::: "memory");
            const unsigned og = xb_add(&bar[XB_TOP], 1u);
            const unsigned tg = og / nx;
            if (og + 1u == (tg + 1u) * nx) xb_add(&bar[XB_TOPGEN], 1u);
            else XB_SPIN(xb_ld(&bar[XB_TOPGEN]) == tg, bar);
            __builtin_amdgcn_fence(__ATOMIC_ACQUIRE, "agent");
            xb_add(&bar[XB_XGEN(b.x)], 1u);
            asm volatile("s_waitcnt vmcnt(0)" ::: "memory");
        } else {
            XB_SPIN(xb_ld(&bar[XB_XGEN(b.x)]) == gen, bar);
            __builtin_amdgcn_fence(__ATOMIC_ACQUIRE, "agent");
            asm volatile("s_waitcnt vmcnt(0)" ::: "memory");
        }
    }
    __syncthreads();
}

struct Ctx { LAS unsigned char* lds; int tid, lane, wave, gw, NGW, G, bid; };

__device__ __forceinline__ void transpose_item(const float* W, int ldw, int Kvalid, bf16* WT, int ldt, int drow0, int dcol0, int k0, int n0, LAS float* scr, int lane) {
#pragma unroll 8
    for (int i = 0; i < 32; ++i) { const int kk = 2 * i + (lane >> 5), k = k0 + kk; scr[kk * 33 + (lane & 31)] = (k < Kvalid) ? W[(size_t)k * ldw + n0 + (lane & 31)] : 0.f; }
    LDS_WAIT(); asm volatile("" ::: "memory");
    const int c = lane & 7;
#pragma unroll
    for (int j = 0; j < 4; ++j) { const int n = (lane >> 3) + 8 * j; const LAS float* s = scr + (8 * c) * 33 + n;
        v4u o; o.x = pk2(s[0 * 33], s[1 * 33]); o.y = pk2(s[2 * 33], s[3 * 33]); o.z = pk2(s[4 * 33], s[5 * 33]); o.w = pk2(s[6 * 33], s[7 * 33]);
        *(GAS v4u*)(WT + (size_t)(drow0 + n) * ldt + dcol0 + 8 * c) = o; }
    LDS_WAIT(); asm volatile("" ::: "memory");
}
template <bool GLU = false> __device__ __forceinline__ void transpose_mat(const Ctx& C, const float* W, int K, int N, bf16* WT, int ldt, int row_off, int& base, LAS float* scr) {
    const int nblk = N / 32, nit = ((K + 63) / 64) * nblk;
    int start = (C.gw - base) % C.NGW; if (start < 0) start += C.NGW;
    for (int it = start; it < nit; it += C.NGW) { const int kb = it / nblk, nb = it % nblk, n0 = 32 * nb;
        const int drow = GLU ? (n0 < FF ? (n0 / 128) * 256 + (n0 % 128) : ((n0 - FF) / 128) * 256 + 128 + ((n0 - FF) % 128)) : n0;
        transpose_item(W, N, K, WT, ldt, row_off + drow, 64 * kb, 64 * kb, n0, scr, C.lane); }
    base += nit;
}
__device__ __forceinline__ void zero_rows(const Ctx& C, bf16* WT, int ldt, int r0, int r1) {
    const size_t n16 = (size_t)(r1 - r0) * ldt / 8; GAS v4u* p = (GAS v4u*)(WT + (size_t)r0 * ldt);
    for (size_t i = (size_t)C.bid * 512 + C.tid; i < n16; i += (size_t)C.G * 512) p[i] = (v4u){0u, 0u, 0u, 0u};
}

struct In { const float* p[33]; };

__device__ __forceinline__ void p0_prologue(const Ctx& C, const In& in, unsigned char* ws, float* out) {
    LAS float* scr = (LAS float*)(C.lds + RING_OFF + C.wave * 16384);
    bf16* W1CAT = (bf16*)(ws + WS_W1CAT); bf16* WL2 = (bf16*)(ws + WS_WL2);
    int base = 0;
    transpose_mat(C, in.p[10], D, D, W1CAT, D, 0, base, scr);
    transpose_mat(C, in.p[11], D, D, W1CAT, D, 1024, base, scr);
    transpose_mat(C, in.p[12], D, D, W1CAT, D, 2048, base, scr);
    transpose_mat(C, in.p[15], D, 64, W1CAT, D, 3072, base, scr);
    transpose_mat(C, in.p[18], D, 64, W1CAT, D, 3328, base, scr);
    transpose_mat(C, in.p[20], D, 160, W1CAT, D, 3584, base, scr);
    transpose_mat(C, in.p[13], D, D, (bf16*)(ws + WS_WORW), D, 0, base, scr);
    transpose_mat<true>(C, in.p[29], D, F2, (bf16*)(ws + WS_WUP0), D, 0, base, scr);
    transpose_mat<true>(C, in.p[29] + (size_t)D * F2, D, F2, (bf16*)(ws + WS_WUP1), D, 0, base, scr);
    transpose_mat(C, in.p[32], FF, D, (bf16*)(ws + WS_WDN0), FF, 0, base, scr);
    transpose_mat(C, in.p[32] + (size_t)FF * D, FF, D, (bf16*)(ws + WS_WDN1), FF, 0, base, scr);
    transpose_mat(C, in.p[27], D, NQKV, (bf16*)(ws + WS_WQKV), D, 0, base, scr);
    transpose_mat(C, in.p[28], AW, D, (bf16*)(ws + WS_WOAT), AW, 0, base, scr);
    zero_rows(C, W1CAT, D, 3072 + 64, 3328); zero_rows(C, W1CAT, D, 3328 + 64, 3584); zero_rows(C, W1CAT, D, 3584 + 160, 3840);
    { const float* w2 = in.p[16]; const float* a2 = in.p[19]; const float* g2 = in.p[21];
      for (int idx = C.bid * 512 + C.tid; idx < 48 * 3072; idx += C.G * 512) { const int kc = idx / 3072, n = idx % 3072, k0 = 8 * kc; float v[8];
#pragma unroll
          for (int j = 0; j < 8; ++j) { const int k = k0 + j; float x = 0.f;
              if (n < 1024) { if (k < 64) x = w2[(size_t)k * D + n]; }
              else if (n < 2048) { if (k >= 64 && k < 128) x = a2[(size_t)(k - 64) * D + (n - 1024)]; }
              else { if (k >= 128 && k < 288) x = g2[(size_t)(k - 128) * D + (n - 2048)]; }
              v[j] = x; }
          v4u o; o.x = pk2(v[0], v[1]); o.y = pk2(v[2], v[3]); o.z = pk2(v[4], v[5]); o.w = pk2(v[6], v[7]);
          *(GAS v4u*)(WL2 + (size_t)n * 384 + k0) = o; } }
    { float* rope = (float*)(ws + WS_ROPE);
      for (int idx = C.bid * 512 + C.tid; idx < 2056 * 8; idx += C.G * 512) { const int pos = idx >> 3, i = idx & 7;
          const double c = i == 0 ? 0.15915494309189535 : i == 1 ? 0.03086376340470123 : i == 2 ? 0.005985185712713705 : i == 3 ? 0.001160663641240061 :
                           i == 4 ? 0.00022507907903927653 : i == 5 ? 4.364795279280289e-05 : i == 6 ? 8.464330808241401e-06 : 1.6414262627950345e-06;
          const double rev = (double)pos * c; const float fr = (float)(rev - __builtin_floor(rev));
          rope[2 * idx] = __builtin_amdgcn_cosf(fr); rope[2 * idx + 1] = __builtin_amdgcn_sinf(fr); } }
    { const float* g0 = in.p[8]; const float* mu = in.p[9]; bf16* XM = (bf16*)(ws + WS_XM);
      for (int m = C.gw; m < M; m += C.NGW) {
          const bool pr = m < MP; const int t = pr ? (m & (PT - 1)) : ((m - MP) & (STN - 1)), b = pr ? (m >> 11) : ((m - MP) >> 3);
          const float* xr = pr ? in.p[0] + (size_t)m * D : in.p[1] + (size_t)(m - MP) * D;
          f32x4 v[4], pv[4]; float ss = 0.f, ps = 0.f;
#pragma unroll
          for (int j = 0; j < 4; ++j) { v[j] = *(const GAS f32x4*)(xr + 4 * C.lane + 256 * j); ss += (v[j].x * v[j].x + v[j].y * v[j].y) + (v[j].z * v[j].z + v[j].w * v[j].w); }
          if (t > 0) {
#pragma unroll
              for (int j = 0; j < 4; ++j) { pv[j] = *(const GAS f32x4*)(xr - D + 4 * C.lane + 256 * j); ps += (pv[j].x * pv[j].x + pv[j].y * pv[j].y) + (pv[j].z * pv[j].z + pv[j].w * pv[j].w); }
          } else {
#pragma unroll
              for (int j = 0; j < 4; ++j) pv[j] = pr ? (f32x4){0.f, 0.f, 0.f, 0.f} : *(const GAS f32x4*)(in.p[2] + (size_t)b * D + 4 * C.lane + 256 * j);
          }
          const float rs = 1.0f / sqrtf(wave_sum(ss) * (1.f / D) + NORM_EPS), prs = 1.0f / sqrtf(wave_sum(ps) * (1.f / D) + NORM_EPS);
          const bool last = pr ? (t == PT - 1) : (t == STN - 1);
#pragma unroll
          for (int j = 0; j < 4; ++j) { const int col = 4 * C.lane + 256 * j; const f32x4 g = *(const GAS f32x4*)(g0 + col);
              const f32x4 hn = v[j] * rs * g; const f32x4 hp = t > 0 ? pv[j] * prs * g : pv[j]; const f32x4 xx = hp - hn;
              if (last) *(GAS f32x4*)(out + (pr ? O_PSHIFT : O_SSHIFT) + (size_t)b * D + col) = hn;
#pragma unroll
              for (int i = 0; i < 6; ++i) { const f32x4 mm = *(const GAS f32x4*)(mu + i * D + col); const f32x4 r = hn + xx * mm;
                  const int slot = i == 1 ? 3 : (i == 2 ? 1 : (i == 3 ? 2 : i));
                  v2u o; o.x = pk2(r.x, r.y); o.y = pk2(r.z, r.w); *(GAS v2u*)(XM + (size_t)slot * M * D + (size_t)m * D + col) = o; } }
      } }
}

constexpr int SC_OPS = 0, SC_OPS_BYTES = 16 * 16 * 20 * 4, SC_VV = 2 * SC_OPS_BYTES, SC_VV_BYTES = 16 * 32 * 4, SC_YB = SC_VV + 2 * SC_VV_BYTES, SC_YB_BYTES = 16 * 32 * 4;
template <bool PROMPT> __device__ __forceinline__ void scan_unit(const Ctx& C, const In& in, unsigned char* ws, float* out, int b, int h, int vh) {
    constexpr int T = PROMPT ? PT : STN, NCH = PROMPT ? PT / 16 : 1, NT = PROMPT ? 16 : 8;
    const float* Rb = (const float*)(ws + WS_R); const float* Kb = (const float*)(ws + WS_K); const float* Vb = (const float*)(ws + WS_V);
    const float* Db = (const float*)(ws + WS_DC); const float* Ab = (const float*)(ws + WS_AA); float* Yb = (float*)(ws + WS_Y); float* Bon = (float*)(ws + WS_BONUS);
    const int row = C.tid >> 4, p = C.tid & 15, vrow = 32 * vh + row;
    const size_t tok0 = PROMPT ? (size_t)b * PT : (size_t)MP + (size_t)b * STN;
    const int col = h * 64 + C.lane;
    const float ka = in.p[23][col], kkw = in.p[22][col], rk = in.p[24][col];
    LAS float* OPS = (LAS float*)(C.lds + SC_OPS); LAS float* VV = (LAS float*)(C.lds + SC_VV); LAS float* YB = (LAS float*)(C.lds + SC_YB);
    f32x4 S;
    if (PROMPT) S = (f32x4){0.f, 0.f, 0.f, 0.f};
    else S = *(const GAS f32x4*)(in.p[3] + (((size_t)b * RH + h) * 64 + vrow) * 64 + 4 * p);
    float lr[2], lk[2], lv[2], ld[2], la[2];
#define SC_LOAD(c) do { _Pragma("unroll") for (int s = 0; s < 2; ++s) { const int tl = C.wave + 8 * s; if (tl < NT) { const size_t o = (tok0 + (size_t)(c) * 16 + tl) * D + col; \
        lr[s] = Rb[o]; lk[s] = Kb[o]; lv[s] = Vb[o]; ld[s] = Db[o]; la[s] = Ab[o]; } } } while (0)
#define SC_STORE(c, buf) do { _Pragma("unroll") for (int s = 0; s < 2; ++s) { const int tl = C.wave + 8 * s; if (tl < NT) { \
        const float kp = lk[s] * (1.0f + (la[s] - 1.0f) * ka), kr = lk[s] * kkw; const float n2 = wave_sum(kr * kr); const float kn = kr / fmaxf(sqrtf(n2), 1e-12f); \
        const float bon = wave_sum(lr[s] * kp * rk); \
        LAS float* o = OPS + (buf) * (SC_OPS_BYTES / 4) + ((tl * 16 + (C.lane >> 2)) * 20) + (C.lane & 3); \
        o[0] = kn; o[4] = ld[s]; o[8] = kp; o[12] = lr[s]; o[16] = kn * la[s]; \
        if ((C.lane >> 5) == vh) VV[(buf) * (SC_VV_BYTES / 4) + tl * 32 + (C.lane & 31)] = lv[s]; \
        if (vh == 0 && C.lane == 0) Bon[(tok0 + (size_t)(c) * 16 + tl) * 16 + h] = bon; } } } while (0)
    SC_LOAD(0); SC_STORE(0, 0);
    __syncthreads();
    for (int c = 0; c < NCH; ++c) {
        const int buf = c & 1;
        if (c + 1 < NCH) SC_LOAD(c + 1);
        float ykeep = 0.f;
        const LAS f32x4* op = (const LAS f32x4*)(OPS + buf * (SC_OPS_BYTES / 4) + p * 20);
        const LAS float* vvp = VV + buf * (SC_VV_BYTES / 4) + row;
#pragma unroll
        for (int tl = 0; tl < NT; ++tl) {
            const f32x4 kk = op[tl * 80 + 0], dd = op[tl * 80 + 1], kp = op[tl * 80 + 2], rr = op[tl * 80 + 3], kka = op[tl * 80 + 4]; const float vv = vvp[tl * 32];
            float sk = (S.x * kk.x + S.y * kk.y) + (S.z * kk.z + S.w * kk.w);
            sk = row16_sum(sk);
            S.x = S.x * dd.x + (vv * kp.x - sk * kka.x); S.y = S.y * dd.y + (vv * kp.y - sk * kka.y); S.z = S.z * dd.z + (vv * kp.z - sk * kka.z); S.w = S.w * dd.w + (vv * kp.w - sk * kka.w);
            float y = (S.x * rr.x + S.y * rr.y) + (S.z * rr.z + S.w * rr.w);
            y = row16_sum(y);
            ykeep = (p == tl) ? y : ykeep;
        }
        if (p < NT) YB[buf * (SC_YB_BYTES / 4) + p * 32 + row] = ykeep;
        if (c + 1 < NCH) SC_STORE(c + 1, buf ^ 1);
        __syncthreads();
        { const int tl = C.tid >> 5, rr = C.tid & 31; if (tl < NT) Yb[(tok0 + (size_t)c * 16 + tl) * D + h * 64 + 32 * vh + rr] = YB[buf * (SC_YB_BYTES / 4) + tl * 32 + rr]; }
    }
#undef SC_LOAD
#undef SC_STORE
    *(GAS f32x4*)(out + (PROMPT ? O_PWKV : O_SWKV) + (((size_t)b * RH + h) * 64 + vrow) * 64 + 4 * p) = S;
    __syncthreads();
}
__device__ __forceinline__ void scan_phase(const Ctx& C, const In& in, unsigned char* ws, float* out) {
    for (int u = C.bid; u < PB * RH * 2; u += C.G) scan_unit<true>(C, in, ws, out, u >> 5, (u >> 1) & 15, u & 1);
    for (int u = C.bid; u < SBN * RH * 2; u += C.G) scan_unit<false>(C, in, ws, out, u >> 5, (u >> 1) & 15, u & 1);
}
__device__ __forceinline__ void scan_post_phase(const Ctx& C, const In& in, unsigned char* ws) {
    const float* Yb = (const float*)(ws + WS_Y); const float* Vb = (const float*)(ws + WS_V); const float* Gb = (const float*)(ws + WS_GG); const float* Bon = (const float*)(ws + WS_BONUS);
    bf16* YG = (bf16*)(ws + WS_YG); const float* lg = in.p[25]; const float* lb = in.p[26];
    for (int m = C.gw; m < M; m += C.NGW) {
#pragma unroll
        for (int j = 0; j < 4; ++j) { const int col = 4 * C.lane + 256 * j, head = 4 * j + (C.lane >> 4); const size_t o = (size_t)m * D + col;
            const f32x4 y = *(const GAS f32x4*)(Yb + o); const float mean = row16_sum((y.x + y.y) + (y.z + y.w)) * (1.f / 64.f);
            const f32x4 d = y - mean; const float var = row16_sum((d.x * d.x + d.y * d.y) + (d.z * d.z + d.w * d.w)) * (1.f / 64.f);
            const float rs = 1.0f / sqrtf(var + GN_EPS), bon = Bon[(size_t)m * 16 + head];
            const f32x4 vv = *(const GAS f32x4*)(Vb + o), gg = *(const GAS f32x4*)(Gb + o), g4 = *(const GAS f32x4*)(lg + col), b4 = *(const GAS f32x4*)(lb + col);
            const f32x4 r = (d * rs * g4 + b4 + vv * bon) * gg;
            v2u w; w.x = pk2(r.x, r.y); w.y = pk2(r.z, r.w); *(GAS v2u*)(YG + o) = w; }
    }
}
__device__ __forceinline__ void rowwise_phase(const Ctx& C, const In& in, const float* xin, const float* mo, const float* g1, float* xout, const float* g2, bf16* xn) {
    for (int m = C.gw; m < M; m += C.NGW) {
        const float* xr = xin ? xin + (size_t)m * D : (m < MP ? in.p[0] + (size_t)m * D : in.p[1] + (size_t)(m - MP) * D);
        f32x4 a[4], x[4]; float ss = 0.f;
#pragma unroll
        for (int j = 0; j < 4; ++j) { a[j] = *(const GAS f32x4*)(mo + (size_t)m * D + 4 * C.lane + 256 * j); x[j] = *(const GAS f32x4*)(xr + 4 * C.lane + 256 * j);
            ss += (a[j].x * a[j].x + a[j].y * a[j].y) + (a[j].z * a[j].z + a[j].w * a[j].w); }
        const float rs = 1.0f / sqrtf(wave_sum(ss) * (1.f / D) + NORM_EPS); float s2 = 0.f;
#pragma unroll
        for (int j = 0; j < 4; ++j) { const int col = 4 * C.lane + 256 * j; x[j] = x[j] + a[j] * rs * *(const GAS f32x4*)(g1 + col);
            *(GAS f32x4*)(xout + (size_t)m * D + col) = x[j]; s2 += (x[j].x * x[j].x + x[j].y * x[j].y) + (x[j].z * x[j].z + x[j].w * x[j].w); }
        if (xn) { const float r2 = 1.0f / sqrtf(wave_sum(s2) * (1.f / D) + NORM_EPS);
#pragma unroll
            for (int j = 0; j < 4; ++j) { const int col = 4 * C.lane + 256 * j; const f32x4 r = x[j] * r2 * *(const GAS f32x4*)(g2 + col);
                v2u w; w.x = pk2(r.x, r.y); w.y = pk2(r.z, r.w); *(GAS v2u*)(xn + (size_t)m * D + col) = w; } }
    }
}
__device__ __forceinline__ float gelu_tanh(float x) { const float u = 0.7978845608028654f * (x + 0.044715f * x * x * x); return 0.5f * x * (1.0f + fast_tanh(u)); }
__device__ __forceinline__ void unpack8(const v4u w, float* f) { f[0] = bflo(w.x); f[1] = bfhi(w.x); f[2] = bflo(w.y); f[3] = bfhi(w.y); f[4] = bflo(w.z); f[5] = bfhi(w.z); f[6] = bflo(w.w); f[7] = bfhi(w.w); }
__device__ __forceinline__ void fix_halo(const Ctx& C, unsigned char* ws, const float* cw, const float* cb, const float* sc, int pm) {
    const float* HALO = (const float*)(ws + WS_HID); const float* RAWS = (const float*)(ws + WS_HID + 8 * MiB); bf16* ACT = (bf16*)(ws + WS_ACT);
    if (pm >= 64) {
        for (int idx = C.tid; idx < 64 * (FF / 4); idx += NWAVES * 64) { const int q = idx / (FF / 4), c = (idx % (FF / 4)) * 4, bl = q >> 1, t = q & 1, rs = (pm - 64) * 256 + bl * 8 + t, b = rs >> 3; f32x4 cv[2];
#pragma unroll
            for (int s = 0; s < 2; ++s) { const size_t co = (size_t)s * FF + c;
                const f32x4 h0 = *(const GAS f32x4*)(RAWS + (size_t)rs * F2 + co), s1 = *(const GAS f32x4*)(sc + ((size_t)b * 2 + 1) * F2 + co);
                const f32x4 h1 = t == 0 ? s1 : *(const GAS f32x4*)(RAWS + (size_t)(rs - 1) * F2 + co), h2 = t == 0 ? *(const GAS f32x4*)(sc + ((size_t)b * 2 + 0) * F2 + co) : s1;
                cv[s] = *(const GAS f32x4*)(cb + co) + *(const GAS f32x4*)(cw + co) * h2 + *(const GAS f32x4*)(cw + F2 + co) * h1 + *(const GAS f32x4*)(cw + 2 * F2 + co) * h0; }
            v2u o; o.x = pk2(gelu_tanh(cv[0].x) * cv[1].x, gelu_tanh(cv[0].y) * cv[1].y); o.y = pk2(gelu_tanh(cv[0].z) * cv[1].z, gelu_tanh(cv[0].w) * cv[1].w);
            *(GAS v2u*)(ACT + ((size_t)MP + rs) * FF + c) = o; }
        return;
    }
    if ((pm & 7) == 0) return;
    for (int idx = C.tid; idx < 2 * (FF / 4); idx += NWAVES * 64) { const int r = idx / (FF / 4), c = (idx % (FF / 4)) * 4; f32x4 cv[2];
#pragma unroll
        for (int s = 0; s < 2; ++s) { const size_t co = (size_t)s * FF + c;
            const f32x4 h0 = *(const GAS f32x4*)(HALO + ((size_t)pm * 4 + r) * F2 + co);
            const f32x4 h1 = *(const GAS f32x4*)(HALO + (r == 1 ? ((size_t)pm * 4 + 0) : ((size_t)(pm - 1) * 4 + 3)) * F2 + co);
            const f32x4 h2 = *(const GAS f32x4*)(HALO + ((size_t)(pm - 1) * 4 + (r == 0 ? 2 : 3)) * F2 + co);
            cv[s] = *(const GAS f32x4*)(cb + co) + *(const GAS f32x4*)(cw + co) * h2 + *(const GAS f32x4*)(cw + F2 + co) * h1 + *(const GAS f32x4*)(cw + 2 * F2 + co) * h0; }
        v2u o; o.x = pk2(gelu_tanh(cv[0].x) * cv[1].x, gelu_tanh(cv[0].y) * cv[1].y); o.y = pk2(gelu_tanh(cv[0].z) * cv[1].z, gelu_tanh(cv[0].w) * cv[1].w);
        *(GAS v2u*)(ACT + ((size_t)pm * 256 + r) * FF + c) = o; }
}

constexpr float QSCALE = 0.125f * 1.4426950408889634f;
__device__ __forceinline__ void rope_phase(const Ctx& C, const In& in, unsigned char* ws, float* out) {
    bf16* QKV = (bf16*)(ws + WS_QKV); const float* rope = (const float*)(ws + WS_ROPE);
    for (int m = C.gw; m < M; m += C.NGW) {
        const bool pr = m < MP; const int t = pr ? (m & (PT - 1)) : ((m - MP) & 7), b = pr ? (m >> 11) : ((m - MP) >> 3), pos = pr ? t : PT + t;
        bf16* rowp = QKV + (size_t)m * NQKV;
        f32x4 cs0 = *(const GAS f32x4*)(rope + (size_t)pos * 16), cs1 = *(const GAS f32x4*)(rope + (size_t)pos * 16 + 4), cs2 = *(const GAS f32x4*)(rope + (size_t)pos * 16 + 8), cs3 = *(const GAS f32x4*)(rope + (size_t)pos * 16 + 12);
        const float cc[8] = {cs0.x, cs0.z, cs1.x, cs1.z, cs2.x, cs2.z, cs3.x, cs3.z}, sn[8] = {cs0.y, cs0.w, cs1.y, cs1.w, cs2.y, cs2.w, cs3.y, cs3.w};
#pragma unroll
        for (int it = 0; it < 9; ++it) {
            const int c8 = C.lane + 64 * it, col0 = 8 * c8, s = col0 / 1536, rem = col0 % 1536, g = rem / 512, h = (rem % 512) / 64, e0 = rem % 64;
            const v4u own = *(const GAS v4u*)(rowp + col0);
            const bool rot = (s < 2) && (e0 < 16);
            v4u par = own; if (rot) par = *(const GAS v4u*)(rowp + col0 + (e0 == 0 ? 8 : -8));
            float x[8], y[8], o[8]; unpack8(own, x); unpack8(par, y);
#pragma unroll
            for (int i = 0; i < 8; ++i) o[i] = !rot ? x[i] : (e0 == 0 ? x[i] * cc[i] - y[i] * sn[i] : x[i] * cc[i] + y[i] * sn[i]);
            if (s == 0) {
#pragma unroll
                for (int i = 0; i < 8; ++i) o[i] *= QSCALE; }
            if (s < 2) { v4u w; w.x = pk2(o[0], o[1]); w.y = pk2(o[2], o[3]); w.z = pk2(o[4], o[5]); w.w = pk2(o[6], o[7]); *(GAS v4u*)(rowp + col0) = w; }
            if (s >= 1) {
                const int L = g == 0 ? 128 : (g == 1 ? 512 : 2048); float* dst = nullptr;
                if (pr) { const int j = t - (PT - L); if (j >= 0) dst = out + (g == 0 ? O_PKV128 : (g == 1 ? O_PKV512 : O_PKV2048)) + ((((size_t)b * L + j) * 2 + (s - 1)) * 8 + h) * 64 + e0; }
                else dst = out + (g == 0 ? O_SKV128 : (g == 1 ? O_SKV512 : O_SKV2048)) + ((((size_t)b * 8 + t) * 2 + (s - 1)) * 8 + h) * 64 + e0;
                if (dst) { *(GAS f32x4*)dst = (f32x4){o[0], o[1], o[2], o[3]}; *(GAS f32x4*)(dst + 4) = (f32x4){o[4], o[5], o[6], o[7]}; } }
        }
    }
}

constexpr int AT_RS = 160;
constexpr int AT_K = 0, AT_V = 256 * AT_RS;
typedef short s16x4 __attribute__((ext_vector_type(4)));
__device__ __forceinline__ s16x4 lds_tr16(const LAS unsigned char* p) { return __builtin_bit_cast(s16x4, __builtin_amdgcn_ds_read_tr16_b64_v4i16((LAS s16x4*)p)); }
struct PUnit { int b, h, g, res, n; };
__device__ __forceinline__ PUnit punit(int u) { PUnit r; const int bh = u / 48, j = u % 48; r.b = bh >> 3; r.h = bh & 7;
    if (j < 16) { r.g = 0; r.res = 0; r.n = j; } else if (j < 32) { r.g = 1; r.res = (j - 16) >> 2; r.n = (j - 16) & 3; } else { r.g = 2; r.res = j - 32; r.n = 0; } return r; }
__device__ __forceinline__ void pattn_load(const Ctx& C, const bf16* QKV, const PUnit& u, v4u (&kr)[4], v4u (&vr)[4]) {
    const int Dl = u.g == 0 ? 1 : (u.g == 1 ? 4 : 16);
#pragma unroll
    for (int i = 0; i < 4; ++i) { const int ch = C.tid + 512 * i, kj = ch >> 3, c = ch & 7; int lk = (u.n - 1) * 128 + kj; lk = lk < 0 ? 0 : lk;
        const bf16* rp = QKV + ((size_t)u.b * PT + u.res + Dl * lk) * NQKV + u.h * 64 + c * 8;
        kr[i] = *(const GAS v4u*)(rp + (3 + u.g) * 512); vr[i] = *(const GAS v4u*)(rp + (6 + u.g) * 512); }
}
__device__ __forceinline__ void pattn_store_lds(const Ctx& C, const v4u (&kr)[4], const v4u (&vr)[4]) {
#pragma unroll
    for (int i = 0; i < 4; ++i) { const int ch = C.tid + 512 * i, kj = ch >> 3, c = ch & 7;
        *(LAS v4u*)(C.lds + AT_K + kj * AT_RS + c * 16) = kr[i]; *(LAS v4u*)(C.lds + AT_V + kj * AT_RS + c * 16) = vr[i]; }
}
__device__ __forceinline__ void pattn_compute(const Ctx& C, unsigned char* ws, const PUnit& u) {
    const bf16* QKV = (const bf16*)(ws + WS_QKV); bf16* OG = (bf16*)(ws + WS_OG); float* LSE = (float*)(ws + WS_LSE);
    const int Dl = u.g == 0 ? 1 : (u.g == 1 ? 4 : 16), q16 = C.lane & 15, g4 = C.lane >> 4, qi = 16 * C.wave + q16;
    const size_t qrow = (size_t)u.b * PT + u.res + Dl * (u.n * 128 + qi);
    const bf16* qp = QKV + qrow * NQKV + u.g * 512 + u.h * 64;
    const bf16x8 qf0 = *(const GAS bf16x8*)(qp + 8 * g4), qf1 = *(const GAS bf16x8*)(qp + 32 + 8 * g4);
    f32x4 sc[16];
    const LAS unsigned char* kbase = C.lds + AT_K + q16 * AT_RS + g4 * 16;
#pragma unroll
    for (int T = 0; T < 16; ++T) { const bf16x8 k0 = *(const LAS bf16x8*)(kbase + T * 16 * AT_RS), k1 = *(const LAS bf16x8*)(kbase + T * 16 * AT_RS + 64);
        f32x4 a = __builtin_amdgcn_mfma_f32_16x16x32_bf16(k0, qf0, (f32x4){0.f, 0.f, 0.f, 0.f}, 0, 0, 0); sc[T] = __builtin_amdgcn_mfma_f32_16x16x32_bf16(k1, qf1, a, 0, 0, 0); }
    const int klo = (u.n == 0 && qi < 128) ? 128 : qi; float mx = -1e30f;
#pragma unroll
    for (int T = 0; T < 16; ++T)
#pragma unroll
        for (int j = 0; j < 4; ++j) { const int kj = 16 * T + 4 * g4 + j; const bool ok = kj >= klo && kj <= qi + 128; sc[T][j] = ok ? sc[T][j] : -1e30f; mx = fmaxf(mx, sc[T][j]); }
    mx = fmaxf(mx, __shfl_xor(mx, 16)); mx = fmaxf(mx, __shfl_xor(mx, 32));
    float sum = 0.f;
#pragma unroll
    for (int T = 0; T < 16; ++T)
#pragma unroll
        for (int j = 0; j < 4; ++j) { const float p = __builtin_amdgcn_exp2f(sc[T][j] - mx); sc[T][j] = p; sum += p; }
    sum += __shfl_xor(sum, 16); sum += __shfl_xor(sum, 32);
    f32x4 oa[4] = {(f32x4){0.f, 0.f, 0.f, 0.f}, (f32x4){0.f, 0.f, 0.f, 0.f}, (f32x4){0.f, 0.f, 0.f, 0.f}, (f32x4){0.f, 0.f, 0.f, 0.f}};
    const LAS unsigned char* vbase = C.lds + AT_V + (4 * g4 + (q16 >> 2)) * AT_RS + (q16 & 3) * 8;
#pragma unroll
    for (int s = 0; s < 8; ++s) {
        pg8::u32x4 pw; pw.x = pg8::cvt_pk_bf16(sc[2 * s][0], sc[2 * s][1]); pw.y = pg8::cvt_pk_bf16(sc[2 * s][2], sc[2 * s][3]); pw.z = pg8::cvt_pk_bf16(sc[2 * s + 1][0], sc[2 * s + 1][1]); pw.w = pg8::cvt_pk_bf16(sc[2 * s + 1][2], sc[2 * s + 1][3]);
        const bf16x8 pf = __builtin_bit_cast(bf16x8, pw);
#pragma unroll
        for (int c = 0; c < 4; ++c) { const s16x4 lo = lds_tr16(vbase + (32 * s) * AT_RS + c * 32), hi = lds_tr16(vbase + (32 * s + 16) * AT_RS + c * 32);
            const bf16x8 vf = (bf16x8){lo[0], lo[1], lo[2], lo[3], hi[0], hi[1], hi[2], hi[3]};
            oa[c] = __builtin_amdgcn_mfma_f32_16x16x32_bf16(vf, pf, oa[c], 0, 0, 0); }
    }
    const float inv = 1.0f / sum;
    bf16* op = OG + ((size_t)u.g * M + qrow) * AW + u.h * 64 + 4 * g4;
#pragma unroll
    for (int c = 0; c < 4; ++c) { v2u w; w.x = pk2(oa[c][0] * inv, oa[c][1] * inv); w.y = pk2(oa[c][2] * inv, oa[c][3] * inv); *(GAS v2u*)(op + 16 * c) = w; }
    if (g4 == 0) LSE[((size_t)u.g * M + qrow) * 8 + u.h] = mx + __builtin_amdgcn_logf(sum);
}
__device__ __forceinline__ void sattn_unit(const Ctx& C, const float* cache_g, unsigned char* ws, const float* out, int b, int g, int h) {
    const bf16* QKV = (const bf16*)(ws + WS_QKV); bf16* OG = (bf16*)(ws + WS_OG); float* LSE = (float*)(ws + WS_LSE);
    const int L = g == 0 ? 128 : (g == 1 ? 512 : 2048), Dl = g == 0 ? 1 : (g == 1 ? 4 : 16), i = C.wave, d16 = C.lane & 15, sub = C.lane >> 4;
    const size_t qrow = (size_t)MP + (size_t)b * 8 + i;
    const v2u qw = *(const GAS v2u*)(QKV + qrow * NQKV + g * 512 + h * 64 + 4 * d16);
    const f32x4 q = (f32x4){bflo(qw.x), bfhi(qw.x), bflo(qw.y), bfhi(qw.y)};
    const float* cache = cache_g + (size_t)b * L * 1024 + h * 64 + 4 * d16;
    const float* fresh = out + (g == 0 ? O_SKV128 : (g == 1 ? O_SKV512 : O_SKV2048)) + (size_t)b * 8 * 1024 + h * 64 + 4 * d16;
    float s[33]; float mx = -1e30f;
#pragma unroll
    for (int it = 0; it < 33; ++it) { const int j = 4 * it + sub; const bool ok = j <= 128; const int idx = L + i - Dl * (ok ? j : 0);
        const float* kp = idx >= L ? fresh + (size_t)(idx - L) * 1024 : cache + (size_t)idx * 1024;
        const f32x4 kv = *(const GAS f32x4*)kp;
        float d = (q.x * kv.x + q.y * kv.y) + (q.z * kv.z + q.w * kv.w); d = row16_sum(d);
        s[it] = ok ? d : -1e30f; mx = fmaxf(mx, s[it]); }
    mx = fmaxf(mx, __shfl_xor(mx, 16)); mx = fmaxf(mx, __shfl_xor(mx, 32));
    float sum = 0.f; f32x4 o = (f32x4){0.f, 0.f, 0.f, 0.f};
#pragma unroll
    for (int it = 0; it < 33; ++it) { const int j = 4 * it + sub; const bool ok = j <= 128; const int idx = L + i - Dl * (ok ? j : 0);
        const float* vp = (idx >= L ? fresh + (size_t)(idx - L) * 1024 : cache + (size_t)idx * 1024) + 512;
        const f32x4 vv = *(const GAS f32x4*)vp; const float p = __builtin_amdgcn_exp2f(s[it] - mx); sum += p; o = o + vv * p; }
    sum += __shfl_xor(sum, 16); sum += __shfl_xor(sum, 32);
#pragma unroll
    for (int e = 0; e < 4; ++e) { o[e] += __shfl_xor(o[e], 16); o[e] += __shfl_xor(o[e], 32); }
    if (sub == 0) { const float inv = 1.0f / sum; v2u w; w.x = pk2(o.x * inv, o.y * inv); w.y = pk2(o.z * inv, o.w * inv);
        *(GAS v2u*)(OG + ((size_t)g * M + qrow) * AW + h * 64 + 4 * d16) = w;
        if (d16 == 0) LSE[((size_t)g * M + qrow) * 8 + h] = mx + __builtin_amdgcn_logf(sum); }
}
typedef const __attribute__((address_space(4))) In* KInP;
__device__ __forceinline__ void attn_phase(const Ctx& C, KInP kp, unsigned char* ws, float* out) {
    const bf16* QKV = (const bf16*)(ws + WS_QKV);
    constexpr int NPU = PB * 8 * 48;
    v4u kr[4], vr[4];
    int u = C.bid;
    if (u < NPU) { const PUnit pu = punit(u); pattn_load(C, QKV, pu, kr, vr); }
    for (; u < NPU; u += C.G) {
        const PUnit pu = punit(u);
        pattn_store_lds(C, kr, vr);
        __syncthreads();
        if (u + C.G < NPU) { const PUnit nu = punit(u + C.G); pattn_load(C, QKV, nu, kr, vr); }
        pattn_compute(C, ws, pu);
        __syncthreads();
    }
    for (int su = C.bid; su < SBN * 3 * 8; su += C.G) { const int h = su & 7, b = (su >> 3) & 127, g = su >> 10; const float* cache_g = kp->p[4 + (2 - g)];
        sattn_unit(C, cache_g, ws, out, b, 2 - g, h); }
}
__device__ __forceinline__ void merge_phase(const Ctx& C, unsigned char* ws) {
    const bf16* OG = (const bf16*)(ws + WS_OG); const float* LSE = (const float*)(ws + WS_LSE); bf16* OM = (bf16*)(ws + WS_OM);
    for (int idx = C.bid * 512 + C.tid; idx < M * 64; idx += C.G * 512) { const int m = idx >> 6, c8 = idx & 63, h = c8 >> 3;
        const float l0 = LSE[((size_t)0 * M + m) * 8 + h], l1 = LSE[((size_t)1 * M + m) * 8 + h], l2 = LSE[((size_t)2 * M + m) * 8 + h];
        const float mx = fmaxf(l0, fmaxf(l1, l2)); float w0 = __builtin_amdgcn_exp2f(l0 - mx), w1 = __builtin_amdgcn_exp2f(l1 - mx), w2 = __builtin_amdgcn_exp2f(l2 - mx);
        const float inv = 1.0f / (w0 + w1 + w2); w0 *= inv; w1 *= inv; w2 *= inv;
        float a[8], b[8], c[8];
        unpack8(*(const GAS v4u*)(OG + ((size_t)0 * M + m) * AW + 8 * c8), a); unpack8(*(const GAS v4u*)(OG + ((size_t)1 * M + m) * AW + 8 * c8), b); unpack8(*(const GAS v4u*)(OG + ((size_t)2 * M + m) * AW + 8 * c8), c);
        float o[8];
#pragma unroll
        for (int e = 0; e < 8; ++e) o[e] = w0 * a[e] + w1 * b[e] + w2 * c[e];
        v4u w; w.x = pk2(o[0], o[1]); w.y = pk2(o[2], o[3]); w.z = pk2(o[4], o[5]); w.w = pk2(o[6], o[7]);
        *(GAS v4u*)(OM + (size_t)m * AW + 8 * c8) = w; }
}

#ifndef MK_ONE_LAUNCH
#define MK_ONE_LAUNCH 1
#endif
#ifndef REP_MASK
#define REP_MASK 0
#endif
#ifndef ONLY
#define ONLY -1
#endif
constexpr int N_PHASES = 19;
struct Args { In in; float* out; unsigned char* ws; int ph_lo, ph_hi; };
typedef const __attribute__((address_space(4))) In* KIn;
__device__ __forceinline__ KIn launder_kernarg() { unsigned long long p = (unsigned long long)__builtin_amdgcn_kernarg_segment_ptr(); asm volatile("" : "+s"(p)); return (KIn)p; }
#define IN_LOAD() In in; { KIn kp_ = launder_kernarg(); _Pragma("unroll") for (int i_ = 0; i_ < 33; ++i_) in.p[i_] = kp_->p[i_]; }
#define GEMM_PHASE(EPI, Aoff, Boff, Nn, Kk, ASEL, ...) { pg8::Gemm g{(const bf16*)(ws + (Aoff)), (const bf16*)(ws + (Boff)), M, (Nn), (Kk), (ASEL)}; pg8::StaticOrder S; S.init(M, (Nn), C.G, C.bid); \
        pg8::EPI E{__VA_ARGS__}; pg8::gemm_phase<pg8::EPI, pg8::StaticOrder, true, true>(ring, g, S, E); }
#define DOWN_PHASE(Boff, layer) { IN_LOAD(); pg8::StaticOrder S; S.init(M, D, C.G, C.bid); \
        { pg8::Unit u_; for (int i_ = 0; S.next(i_, u_); ++i_) fix_halo(C, ws, in.p[30] + (size_t)(layer) * 3 * F2, in.p[31] + (size_t)(layer) * F2, in.p[7] + (size_t)(layer) * SBN * 2 * F2, u_.pm); } VM_WAIT(); __syncthreads(); \
        pg8::Gemm g{(const bf16*)(ws + WS_ACT), (const bf16*)(ws + (Boff)), M, D, FF, 0}; pg8::EpiF32 E{(float*)(ws + WS_MO), D}; pg8::gemm_phase<pg8::EpiF32, pg8::StaticOrder, true, true>(ring, g, S, E); }
#define UP_PHASE(Boff, layer) { IN_LOAD(); GEMM_PHASE(EpiConv, WS_XN, Boff, F2, D, 0, (bf16*)(ws + WS_ACT), (float*)(ws + WS_HID), (float*)(ws + WS_HID + 8 * MiB), out + O_PCONV + (size_t)(layer) * PB * 2 * F2, out + O_SCONV + (size_t)(layer) * SBN * 2 * F2, \
        in.p[30] + (size_t)(layer) * 3 * F2, in.p[31] + (size_t)(layer) * F2, (LAS float*)(C.lds + EX_OFF)) }

#define PBODY_0 { IN_LOAD(); p0_prologue(C, in, ws, out); }
#define PBODY_1 GEMM_PHASE(EpiG1, WS_XM, WS_W1CAT, 3840, D, RB16, (float*)(ws + WS_R), (bf16*)(ws + WS_L2A))
#define PBODY_2 { IN_LOAD(); GEMM_PHASE(EpiL2, WS_L2A, WS_WL2, 3072, 384, 0, (float*)(ws + WS_DC), in.p[14], in.p[17]) }
#define PBODY_3 { IN_LOAD(); scan_phase(C, in, ws, out); }
#define PBODY_4 { IN_LOAD(); scan_post_phase(C, in, ws); }
#define PBODY_5 GEMM_PHASE(EpiF32, WS_YG, WS_WORW, D, D, 0, (float*)(ws + WS_MO), D)
#define PBODY_6 { IN_LOAD(); rowwise_phase(C, in, nullptr, (const float*)(ws + WS_MO), in.p[8] + 1 * D, (float*)(ws + WS_X1), in.p[8] + 2 * D, (bf16*)(ws + WS_XN)); }
#define PBODY_7 UP_PHASE(WS_WUP0, 0)
#define PBODY_8 DOWN_PHASE(WS_WDN0, 0)
#define PBODY_9 { IN_LOAD(); rowwise_phase(C, in, (const float*)(ws + WS_X1), (const float*)(ws + WS_MO), in.p[8] + 3 * D, (float*)(ws + WS_X2), in.p[8] + 4 * D, (bf16*)(ws + WS_XN)); }
#define PBODY_10 GEMM_PHASE(EpiBf16, WS_XN, WS_WQKV, NQKV, D, 0, (bf16*)(ws + WS_QKV), NQKV)
#define PBODY_11 { IN_LOAD(); rope_phase(C, in, ws, out); }
#define PBODY_12 { attn_phase(C, launder_kernarg(), ws, out); }
#define PBODY_13 { merge_phase(C, ws); }
#define PBODY_14 GEMM_PHASE(EpiF32, WS_OM, WS_WOAT, D, AW, 0, (float*)(ws + WS_MO), D)
#define PBODY_15 { IN_LOAD(); rowwise_phase(C, in, (const float*)(ws + WS_X2), (const float*)(ws + WS_MO), in.p[8] + 5 * D, (float*)(ws + WS_X3), in.p[8] + 6 * D, (bf16*)(ws + WS_XN)); }
#define PBODY_16 UP_PHASE(WS_WUP1, 1)
#define PBODY_17 DOWN_PHASE(WS_WDN1, 1)
#define PBODY_18 { IN_LOAD(); rowwise_phase(C, in, (const float*)(ws + WS_X3), (const float*)(ws + WS_MO), in.p[8] + 7 * D, out + O_YP, nullptr, nullptr); }

__global__ void __launch_bounds__(NWAVES * 64, 2) fwd(Args args) {
    extern __shared__ __attribute__((aligned(16))) unsigned char lds[];
    Ctx C; C.lds = (LAS unsigned char*)lds; C.tid = threadIdx.x; C.lane = C.tid & 63; C.wave = __builtin_amdgcn_readfirstlane(C.tid >> 6);
    C.G = gridDim.x; C.bid = blockIdx.x; C.gw = C.bid * NWAVES + C.wave; C.NGW = C.G * NWAVES;
    unsigned char* ws = args.ws; float* out = args.out;
    volatile LAS unsigned* MISC = (volatile LAS unsigned*)(C.lds + MISC_OFF);
    for (int u = C.tid; u < (LDS_BYTES - LDSCTL_OFF) / 4; u += NWAVES * 64) ((LAS unsigned*)(C.lds + LDSCTL_OFF))[u] = 0u;
    __syncthreads();
    XcdBarrier bar; bar.bar = (unsigned*)(ws + WS_CTL) + CW_BAR; bar.x = 0; bar.st = nullptr;
    const int lo = args.ph_lo, hi = args.ph_hi;
    if (hi - lo > 1) bar = xcd_barrier_post((unsigned*)(ws + WS_CTL) + CW_BAR, MISC + 8);
    LAS unsigned char* ring = C.lds + RING_OFF;
#define IN(k) ((ONLY < 0 || ONLY == (k)) && lo <= (k) && (k) < hi)
#define PHASE(k) if (IN(k)) PBODY_##k if (IN(k) && ((REP_MASK >> (k)) & 1)) { if (hi - lo > 1) xcd_barrier(bar); PBODY_##k } if (IN(k) && IN((k) + 1)) xcd_barrier(bar);
    PHASE(0) PHASE(1) PHASE(2) PHASE(3) PHASE(4) PHASE(5) PHASE(6) PHASE(7) PHASE(8) PHASE(9) PHASE(10) PHASE(11) PHASE(12) PHASE(13) PHASE(14) PHASE(15) PHASE(16) PHASE(17) PHASE(18)
#undef IN
#undef PHASE
}

extern "C" void kernel_launch(void* const* d_in, const int* in_sizes, int n_in, void* d_out, int out_size, void* d_ws, size_t ws_size, hipStream_t stream) {
    static int grid = 0;
    if (grid == 0) {
        if (n_in != 33 || (size_t)out_size != O_END || ws_size < WS_END) { fprintf(stderr, "kernel_launch: unexpected sizes: n_in %d out %d ws %zu (need %zu)\n", n_in, out_size, ws_size, (size_t)WS_END); grid = -1; return; }
        int dev = 0, cus = 0, per_cu = 0;
        if (hipGetDevice(&dev) != hipSuccess || hipDeviceGetAttribute(&cus, hipDeviceAttributeMultiprocessorCount, dev) != hipSuccess) { grid = -1; return; }
        if (hipFuncSetAttribute((const void*)fwd, hipFuncAttributeMaxDynamicSharedMemorySize, LDS_BYTES) != hipSuccess) { fprintf(stderr, "kernel_launch: hipFuncSetAttribute failed\n"); grid = -1; return; }
        if (hipOccupancyMaxActiveBlocksPerMultiprocessor(&per_cu, (const void*)fwd, NWAVES * 64, LDS_BYTES) != hipSuccess || per_cu < 1) { fprintf(stderr, "kernel_launch: occupancy query says %d\n", per_cu); }
        (void)hipGetLastError();
        grid = cus;
    }
    if (grid < 0) return;
    (void)hipMemsetAsync((char*)d_ws + WS_CTL, 0, CTL_ZERO_BYTES, stream);
    Args a{};
    for (int i = 0; i < 33; ++i) a.in.p[i] = (const float*)d_in[i];
    a.out = (float*)d_out; a.ws = (unsigned char*)d_ws;
#if MK_ONE_LAUNCH
    a.ph_lo = 0; a.ph_hi = N_PHASES;
    hipLaunchKernelGGL(fwd, dim3(grid), dim3(NWAVES * 64), LDS_BYTES, stream, a);
#else
    for (int ph = 0; ph < N_PHASES; ++ph) { a.ph_lo = ph; a.ph_hi = ph + 1; hipLaunchKernelGGL(fwd, dim3(grid), dim3(NWAVES * 64), LDS_BYTES, stream, a); }
#endif
}
```

```cpp
#include <hip/hip_runtime.h>
#include <cstdio>
#include <cstdint>
namespace pg8 {
#define PG8_LAS __attribute__((address_space(3)))
typedef unsigned short bf16_t;
typedef short bf16x8 __attribute__((ext_vector_type(8)));
typedef float f32x4 __attribute__((ext_vector_type(4)));
typedef float f32x2 __attribute__((ext_vector_type(2)));
typedef unsigned u32x4 __attribute__((ext_vector_type(4)));
typedef unsigned u32x2 __attribute__((ext_vector_type(2)));
constexpr int BM = 256, BK = 64, HALF = 128, HTB = HALF * BK * 2  , STAGE_BYTES = 8 * HTB, NXCD = 8, WGM = 8;

__host__ __device__ __forceinline__ int lds_byte(int r, int c) { const int st = (r >> 4) * 2 + (c >> 5), rr = r & 15, cc = c & 31, ob = rr * 64 + cc * 2; return st * 1024 + (ob ^ (((ob >> 9) & 1) << 5)); }
__host__ __device__ __forceinline__ void stage_rc(int b, int& R, int& C) { const int st = b / 1024, sb = b % 1024, swz = sb ^ (((sb >> 9) & 1) << 5); R = (st >> 1) * 16 + swz / 64; C = (st & 1) * 32 + (swz % 64) / 2; }
__host__ __device__ __forceinline__ int perm32(int rho) { const int n = rho >> 4, i = rho & 15; return 8 * (i >> 2) + 4 * n + (i & 3); }

struct Unit { int pm, pn; };
struct Gemm { const bf16_t* A; const bf16_t* Bt; int M, N, K; size_t a_sel_bytes; };

struct StaticOrder {
    int nM, nN, nwg, G, c;
    __host__ __device__ __forceinline__ void init(int M, int N, int G_, int c_) { nM = M / BM; nN = N / BM; nwg = nM * nN; G = G_; c = c_; }
    __host__ __device__ __forceinline__ bool next(int i, Unit& u) const {
        const long L = (long)i * G + c; if (L >= nwg) return false;
        int wgid = (int)L; { const int q = nwg / NXCD, r = nwg % NXCD, xcd = wgid % NXCD, off = wgid / NXCD; wgid = (xcd < r ? xcd * (q + 1) : r * (q + 1) + (xcd - r) * q) + off; }
        const int nig = WGM * nN, gid = wgid / nig, fm = gid * WGM, gsz = (nM - fm) < WGM ? (nM - fm) : WGM;
        u.pm = fm + ((wgid % nig) % gsz); u.pn = (wgid % nig) / gsz; return true;
    }
    __device__ __forceinline__ void a_ready(const Unit&) const {}
    __device__ __forceinline__ void done(const Unit&) const {}
};

__device__ __forceinline__ unsigned cvt_pk_bf16(float lo, float hi) { unsigned r; asm volatile("v_cvt_pk_bf16_f32 %0, %1, %2" : "=v"(r) : "v"(lo), "v"(hi)); return r; }
__device__ __forceinline__ float fast_tanh(float x) { return 1.0f - 2.0f / (1.0f + __expf(2.0f * x)); }
__device__ __forceinline__ float fast_sigmoid(float x) { return 1.0f / (1.0f + __expf(-x)); }

struct EpiF32 {
    static constexpr bool PERM = false, AFTER_DRAIN = false;
    static __device__ __forceinline__ int asel(int) { return 0; }
    float* C; int ldc;
    __device__ __forceinline__ void operator()(const f32x4 (&acc)[2][2][4][2], const Unit& u, int wr, int wc, int fr, int fq) const {
        const int row0 = u.pm * BM + wr * 64 + fr, col0 = u.pn * BM + wc * 32 + 4 * fq;
#pragma unroll
        for (int ai = 0; ai < 2; ++ai)
#pragma unroll
            for (int m = 0; m < 4; ++m) { float* rowp = C + (size_t)(row0 + ai * HALF + m * 16) * ldc + col0;
#pragma unroll
                for (int bj = 0; bj < 2; ++bj)
#pragma unroll
                    for (int n = 0; n < 2; ++n) *(f32x4*)(rowp + bj * HALF + n * 16) = acc[ai][bj][m][n]; }
    }
};
struct EpiBf16 {
    static constexpr bool PERM = true, AFTER_DRAIN = false;
    static __device__ __forceinline__ int asel(int) { return 0; }
    bf16_t* O; int ldc;
    __device__ __forceinline__ void operator()(const f32x4 (&acc)[2][2][4][2], const Unit& u, int wr, int wc, int fr, int fq) const {
        const int row0 = u.pm * BM + wr * 64 + fr, col0 = u.pn * BM + wc * 32 + 8 * fq;
#pragma unroll
        for (int ai = 0; ai < 2; ++ai)
#pragma unroll
            for (int m = 0; m < 4; ++m) { bf16_t* rowp = O + (size_t)(row0 + ai * HALF + m * 16) * ldc + col0;
#pragma unroll
                for (int bj = 0; bj < 2; ++bj) { const f32x4 v0 = acc[ai][bj][m][0], v1 = acc[ai][bj][m][1];
                    u32x4 w; w.x = cvt_pk_bf16(v0[0], v0[1]); w.y = cvt_pk_bf16(v0[2], v0[3]); w.z = cvt_pk_bf16(v1[0], v1[1]); w.w = cvt_pk_bf16(v1[2], v1[3]);
                    *(u32x4*)(rowp + bj * HALF) = w; } }
    }
};
constexpr size_t RKV_STRIDE = (size_t)17408 * 1024;
struct EpiG1 {
    static constexpr bool PERM = false, AFTER_DRAIN = false;
    static __device__ __forceinline__ int asel(int pn) { return pn < 12 ? (pn >> 2) : pn - 9; }
    float* RKV; bf16_t* L2A;
    __device__ __forceinline__ void operator()(const f32x4 (&acc)[2][2][4][2], const Unit& u, int wr, int wc, int fr, int fq) const {
        const int row0 = u.pm * BM + wr * 64 + fr;
        if (u.pn < 12) {
            float* base = RKV + (size_t)(u.pn >> 2) * RKV_STRIDE; const int col0 = (u.pn & 3) * BM + wc * 32 + 4 * fq;
#pragma unroll
            for (int ai = 0; ai < 2; ++ai)
#pragma unroll
                for (int m = 0; m < 4; ++m) { float* rowp = base + (size_t)(row0 + ai * HALF + m * 16) * 1024 + col0;
#pragma unroll
                    for (int bj = 0; bj < 2; ++bj)
#pragma unroll
                        for (int n = 0; n < 2; ++n) *(f32x4*)(rowp + bj * HALF + n * 16) = acc[ai][bj][m][n]; }
        } else {
            const int mode = u.pn - 12, cbase = mode == 0 ? 0 : (mode == 1 ? 64 : 128);
#pragma unroll
            for (int ai = 0; ai < 2; ++ai)
#pragma unroll
                for (int m = 0; m < 4; ++m) { bf16_t* rowp = L2A + (size_t)(row0 + ai * HALF + m * 16) * 384 + cbase;
#pragma unroll
                    for (int bj = 0; bj < 2; ++bj)
#pragma unroll
                        for (int n = 0; n < 2; ++n) { const int lc = bj * HALF + wc * 32 + n * 16 + 4 * fq;
                            if (mode < 2 && lc >= 64) continue;
                            f32x4 v = acc[ai][bj][m][n];
                            if (mode == 0) { v[0] = fast_tanh(v[0]); v[1] = fast_tanh(v[1]); v[2] = fast_tanh(v[2]); v[3] = fast_tanh(v[3]); }
                            if (mode == 2) { v[0] = fast_sigmoid(v[0]); v[1] = fast_sigmoid(v[1]); v[2] = fast_sigmoid(v[2]); v[3] = fast_sigmoid(v[3]); }
                            u32x2 w; w.x = cvt_pk_bf16(v[0], v[1]); w.y = cvt_pk_bf16(v[2], v[3]); *(u32x2*)(rowp + lc) = w; } }
        }
    }
};
struct EpiL2 {
    static constexpr bool PERM = false, AFTER_DRAIN = false;
    static __device__ __forceinline__ int asel(int) { return 0; }
    float* DAG; const float* w0; const float* a0;
    __device__ __forceinline__ void operator()(const f32x4 (&acc)[2][2][4][2], const Unit& u, int wr, int wc, int fr, int fq) const {
        const int row0 = u.pm * BM + wr * 64 + fr, mode = u.pn >> 2, col0 = (u.pn & 3) * BM + wc * 32 + 4 * fq;
        float* base = DAG + (size_t)mode * RKV_STRIDE + (size_t)row0 * 1024 + col0;
        if (mode == 0) {
#pragma unroll
            for (int bj = 0; bj < 2; ++bj)
#pragma unroll
                for (int n = 0; n < 2; ++n) { const f32x4 bv = *(const f32x4*)(w0 + col0 + bj * HALF + n * 16);
#pragma unroll
                    for (int ai = 0; ai < 2; ++ai)
#pragma unroll
                        for (int m = 0; m < 4; ++m) { f32x4 v = acc[ai][bj][m][n] + bv;
#pragma unroll
                            for (int j = 0; j < 4; ++j) { const float z = v[j], sp = fmaxf(-z, 0.f) + __logf(1.0f + __expf(-fabsf(z))); v[j] = __expf(-__expf(-sp - 0.5f)); }
                            *(f32x4*)(base + (size_t)(ai * HALF + m * 16) * 1024 + bj * HALF + n * 16) = v; } }
        } else if (mode == 1) {
#pragma unroll
            for (int bj = 0; bj < 2; ++bj)
#pragma unroll
                for (int n = 0; n < 2; ++n) { const f32x4 bv = *(const f32x4*)(a0 + col0 + bj * HALF + n * 16);
#pragma unroll
                    for (int ai = 0; ai < 2; ++ai)
#pragma unroll
                        for (int m = 0; m < 4; ++m) { f32x4 v = acc[ai][bj][m][n] + bv;
#pragma unroll
                            for (int j = 0; j < 4; ++j) v[j] = fast_sigmoid(v[j]);
                            *(f32x4*)(base + (size_t)(ai * HALF + m * 16) * 1024 + bj * HALF + n * 16) = v; } }
        } else {
#pragma unroll
            for (int ai = 0; ai < 2; ++ai)
#pragma unroll
                for (int m = 0; m < 4; ++m)
#pragma unroll
                    for (int bj = 0; bj < 2; ++bj)
#pragma unroll
                        for (int n = 0; n < 2; ++n) *(f32x4*)(base + (size_t)(ai * HALF + m * 16) * 1024 + bj * HALF + n * 16) = acc[ai][bj][m][n];
        }
    }
};
constexpr int EX_FLOATS_PER_BLK = 2 * 2 * 128;
__device__ __forceinline__ float gelu_tanh_f(float x) { const float u = 0.7978845608028654f * (x + 0.044715f * x * x * x); return 0.5f * x * (1.0f + fast_tanh(u)); }
#define PG8_ROR(x, n) __builtin_bit_cast(float, __builtin_amdgcn_mov_dpp(__builtin_bit_cast(int, (x)), 0x120 + (n), 0xF, 0xF, false))
struct EpiConv {
    static constexpr bool PERM = true, AFTER_DRAIN = false;
    static __device__ __forceinline__ int asel(int) { return 0; }
    bf16_t* ACT; float* HALO; float* RAWS; float* pconv; float* sconv; const float* cw; const float* cb; PG8_LAS float* X;
    __device__ __forceinline__ void operator()(f32x4 (&acc)[2][2][4][2], const Unit& u, int wr, int wc, int fr, int fq) const {
        constexpr int FFc = 2816, F2c = 5632, MPc = 16384;
        const int lcb = wc * 32 + 8 * fq, cg = u.pn * 128 + lcb;
        if (fr >= 14) {
#pragma unroll
            for (int ai = 0; ai < 2; ++ai)
#pragma unroll
                for (int bj = 0; bj < 2; ++bj)
#pragma unroll
                    for (int n = 0; n < 2; ++n) *(PG8_LAS f32x4*)(X + (ai * 2 + wr) * EX_FLOATS_PER_BLK + ((fr - 14) * 2 + bj) * 128 + lcb + 4 * n) = acc[ai][bj][3][n];
        }
        asm volatile("s_waitcnt lgkmcnt(0)" ::: "memory"); __builtin_amdgcn_s_barrier(); asm volatile("" ::: "memory");
        const int row0 = u.pm * BM + wr * 64 + fr;
        if (u.pm >= 64) {
            const int t = fr & 7;
            if (t < 2 || t >= 6) {
#pragma unroll
                for (int ai = 0; ai < 2; ++ai)
#pragma unroll
                    for (int m = 0; m < 4; ++m) { const int rs = row0 + ai * HALF + m * 16 - MPc; float* dst = t < 2 ? RAWS + (size_t)rs * F2c : sconv + ((size_t)(rs >> 3) * 2 + (t - 6)) * F2c;
#pragma unroll
                        for (int bj = 0; bj < 2; ++bj)
#pragma unroll
                            for (int n = 0; n < 2; ++n) *(f32x4*)(dst + bj * FFc + cg + 4 * n) = acc[ai][bj][m][n]; }
            }
        } else {
            if (wr == 0 && fr < 2) {
#pragma unroll
                for (int bj = 0; bj < 2; ++bj)
#pragma unroll
                    for (int n = 0; n < 2; ++n) *(f32x4*)(HALO + ((size_t)u.pm * 4 + fr) * F2c + bj * FFc + cg + 4 * n) = acc[0][bj][0][n]; }
            if (wr == 1 && fr >= 14) {
#pragma unroll
                for (int bj = 0; bj < 2; ++bj)
#pragma unroll
                    for (int n = 0; n < 2; ++n) { *(f32x4*)(HALO + ((size_t)u.pm * 4 + fr - 12) * F2c + bj * FFc + cg + 4 * n) = acc[1][bj][3][n];
                        if ((u.pm & 7) == 7) *(f32x4*)(pconv + ((size_t)(u.pm >> 3) * 2 + (fr - 14)) * F2c + bj * FFc + cg + 4 * n) = acc[1][bj][3][n]; } }
        }
        asm volatile("" ::: "memory"); __builtin_amdgcn_sched_barrier(0);
#pragma unroll
        for (int n = 0; n < 2; ++n)
#pragma unroll
            for (int s = 0; s < 2; ++s) {
                const int c = s * FFc + cg + 4 * n;
                const f32x4 bb = *(const f32x4*)(cb + c), w0 = *(const f32x4*)(cw + c), w1 = *(const f32x4*)(cw + F2c + c), w2 = *(const f32x4*)(cw + 2 * F2c + c);
#pragma unroll
                for (int ai = 0; ai < 2; ++ai) {
                    const int pblk = wr == 1 ? ai * 2 : 1; const bool has_prev = (wr == 1 || ai == 1);
                    f32x4 e1 = *(const PG8_LAS f32x4*)(X + pblk * EX_FLOATS_PER_BLK + (1 * 2 + s) * 128 + lcb + 4 * n), e2 = *(const PG8_LAS f32x4*)(X + pblk * EX_FLOATS_PER_BLK + (0 * 2 + s) * 128 + lcb + 4 * n);
                    if (!has_prev) { e1 = (f32x4){0.f, 0.f, 0.f, 0.f}; e2 = e1; }
                    f32x4 p1, p2;
#pragma unroll
                    for (int m = 0; m < 4; ++m) {
                        const f32x4 a = acc[ai][s][m][n]; f32x4 r1, r2, h1, h2;
                        asm volatile("s_nop 1\n\tv_mov_b32_dpp %0, %8 row_ror:1 row_mask:0xf bank_mask:0xf\n\tv_mov_b32_dpp %1, %9 row_ror:1 row_mask:0xf bank_mask:0xf\n\tv_mov_b32_dpp %2, %10 row_ror:1 row_mask:0xf bank_mask:0xf\n\tv_mov_b32_dpp %3, %11 row_ror:1 row_mask:0xf bank_mask:0xf\n\t"
                                     "v_mov_b32_dpp %4, %8 row_ror:2 row_mask:0xf bank_mask:0xf\n\tv_mov_b32_dpp %5, %9 row_ror:2 row_mask:0xf bank_mask:0xf\n\tv_mov_b32_dpp %6, %10 row_ror:2 row_mask:0xf bank_mask:0xf\n\tv_mov_b32_dpp %7, %11 row_ror:2 row_mask:0xf bank_mask:0xf"
                                     : "=&v"(r1[0]), "=&v"(r1[1]), "=&v"(r1[2]), "=&v"(r1[3]), "=&v"(r2[0]), "=&v"(r2[1]), "=&v"(r2[2]), "=&v"(r2[3]) : "v"(a[0]), "v"(a[1]), "v"(a[2]), "v"(a[3]));
                        if (m == 0) { h1 = fr >= 1 ? r1 : e1; h2 = fr >= 2 ? r2 : (fr == 0 ? e2 : e1); }
                        else { h1 = fr >= 1 ? r1 : p1; h2 = fr >= 2 ? r2 : p2; }
                        p1 = r1; p2 = r2;
                        acc[ai][s][m][n] = bb + w0 * h2 + w1 * h1 + w2 * a;
                        __builtin_amdgcn_sched_barrier(0);
                    }
                }
                asm volatile("" ::: "memory"); __builtin_amdgcn_sched_barrier(0);
            }
#pragma unroll
        for (int ai = 0; ai < 2; ++ai)
#pragma unroll
            for (int m = 0; m < 4; ++m) { const int row = row0 + ai * HALF + m * 16; u32x4 o;
                { const f32x4 g = acc[ai][0][m][0], v = acc[ai][1][m][0]; o.x = cvt_pk_bf16(gelu_tanh_f(g[0]) * v[0], gelu_tanh_f(g[1]) * v[1]); o.y = cvt_pk_bf16(gelu_tanh_f(g[2]) * v[2], gelu_tanh_f(g[3]) * v[3]); }
                { const f32x4 g = acc[ai][0][m][1], v = acc[ai][1][m][1]; o.z = cvt_pk_bf16(gelu_tanh_f(g[0]) * v[0], gelu_tanh_f(g[1]) * v[1]); o.w = cvt_pk_bf16(gelu_tanh_f(g[2]) * v[2], gelu_tanh_f(g[3]) * v[3]); }
                *(u32x4*)(ACT + (size_t)row * FFc + cg) = o; }
    }
};
template <class Epi, class Sched, bool ALIGN_EPI = false, bool SP2 = false>
__device__ __forceinline__ void gemm_phase(PG8_LAS unsigned char* lds, const Gemm g, const Sched& S, const Epi& E) {
    const int tid = threadIdx.x, wid = __builtin_amdgcn_readfirstlane(tid >> 6), lane = tid & 63, wr = wid >> 2, wc = wid & 3, fr = lane & 15, fq = lane >> 4;
    int K = g.K; asm volatile("" : "+s"(K));
    const int nt = K / BK;
    unsigned voffA[2], voffB[2];
#pragma unroll
    for (int i = 0; i < 2; ++i) { int R, C; stage_rc(tid * 16 + i * 8192, R, C); const int Rb = Epi::PERM ? ((R & ~31) + perm32(R & 31)) : R;
        voffA[i] = (unsigned)(R * K + C) * 2u; voffB[i] = (unsigned)(Rb * K + C) * 2u; }
    const size_t kstep = (size_t)(BK * 2);
    const size_t hstep = (size_t)HALF * K * 2;
    const size_t tstep = 2 * hstep;
    const unsigned ldsw = (unsigned)wid * 1024u;
    const int aoff = lds_byte(wr * 64 + fr, fq * 8), boff = lds_byte(wc * 32 + fr, fq * 8);
#define PG8_SA(b, h) (((b) * 2 + (h)) * HTB)
#define PG8_SB(b, h) ((4 + (b) * 2 + (h)) * HTB)
#define PG8_STAGE(bufoff, gbase, voff) do { _Pragma("unroll") for (int _i = 0; _i < 2; ++_i) \
        __builtin_amdgcn_global_load_lds((const unsigned*)((const char*)(gbase) + (voff)[_i]), (PG8_LAS unsigned*)(lds + (bufoff) + ldsw + _i * 8192), 16, 0, 0); } while (0)
#define PG8_LDA(dst, b, h) do { _Pragma("unroll") for (int m = 0; m < 4; ++m) _Pragma("unroll") for (int k = 0; k < 2; ++k) dst[m][k] = *(const PG8_LAS bf16x8*)(lds + PG8_SA(b, h) + aoff + m * 2048 + k * 1024); } while (0)
#define PG8_LDB(dst, b, h) do { _Pragma("unroll") for (int n = 0; n < 2; ++n) _Pragma("unroll") for (int k = 0; k < 2; ++k) dst[n][k] = *(const PG8_LAS bf16x8*)(lds + PG8_SB(b, h) + boff + n * 2048 + k * 1024); } while (0)
#define PG8_MMA(ai, bj, At, Bt) do { __builtin_amdgcn_s_setprio(1); _Pragma("unroll") for (int m = 0; m < 4; ++m) _Pragma("unroll") for (int n = 0; n < 2; ++n) _Pragma("unroll") for (int k = 0; k < 2; ++k) \
        acc[ai][bj][m][n] = __builtin_amdgcn_mfma_f32_16x16x32_bf16(Bt[n][k], At[m][k], acc[ai][bj][m][n], 0, 0, 0); __builtin_amdgcn_s_setprio(0); } while (0)
#define PG8_WAIT_V(n) asm volatile("s_waitcnt vmcnt(" #n ")" ::: "memory")
#define PG8_WAIT_L(n) asm volatile("s_waitcnt lgkmcnt(" #n ")" ::: "memory")
#define PG8_BAR __builtin_amdgcn_s_barrier()
#define PG8_SCHED __builtin_amdgcn_sched_barrier(0)
    Unit cur, nxt; int ui = 0;
    if (!S.next(0, cur)) return;
    f32x4 acc[2][2][4][2];
#pragma unroll
    for (int a = 0; a < 2; ++a)
#pragma unroll
        for (int b = 0; b < 2; ++b)
#pragma unroll
            for (int m = 0; m < 4; ++m)
#pragma unroll
                for (int n = 0; n < 2; ++n) acc[a][b][m][n] = (f32x4){0.f, 0.f, 0.f, 0.f};
    bf16x8 At[4][2], B0[2][2], B1[2][2];
    const char* cA = (const char*)g.A + (size_t)Epi::asel(cur.pn) * g.a_sel_bytes + (size_t)cur.pm * tstep; const char* cB = (const char*)g.Bt + (size_t)cur.pn * tstep;
    S.a_ready(cur);
    if constexpr (SP2) {
        PG8_STAGE(PG8_SB(0, 0), cB, voffB); PG8_STAGE(PG8_SB(0, 1), cB + hstep, voffB); PG8_STAGE(PG8_SA(0, 0), cA, voffA); PG8_STAGE(PG8_SA(0, 1), cA + hstep, voffA);
        if (wr == 1) PG8_BAR;
        PG8_WAIT_V(2); PG8_BAR;
        PG8_STAGE(PG8_SB(1, 0), cB + kstep, voffB); PG8_STAGE(PG8_SA(1, 0), cA + kstep, voffA); PG8_STAGE(PG8_SB(1, 1), cB + hstep + kstep, voffB);
        PG8_WAIT_V(6); PG8_BAR;
    } else {
        PG8_STAGE(PG8_SB(0, 0), cB, voffB); PG8_STAGE(PG8_SA(0, 0), cA, voffA); PG8_STAGE(PG8_SB(0, 1), cB + hstep, voffB); PG8_STAGE(PG8_SA(0, 1), cA + hstep, voffA);
        if (wr == 1) PG8_BAR;
        PG8_WAIT_V(4); PG8_BAR;
        PG8_STAGE(PG8_SB(1, 0), cB + kstep, voffB); PG8_STAGE(PG8_SA(1, 0), cA + kstep, voffA); PG8_STAGE(PG8_SB(1, 1), cB + hstep + kstep, voffB);
        PG8_WAIT_V(6); PG8_BAR;
    }
    for (;;) {
        const bool has_next = S.next(ui + 1, nxt);
        const char* nA = has_next ? (const char*)g.A + (size_t)Epi::asel(nxt.pn) * g.a_sel_bytes + (size_t)nxt.pm * tstep : cA; const char* nB = has_next ? (const char*)g.Bt + (size_t)nxt.pn * tstep : cB;
        for (int t = 0; t < nt; t += 2) {
            const bool last = (t == nt - 2);
            const char* a1 = cA + (size_t)(t + 1) * kstep;
            const char* a2 = last ? nA : cA + (size_t)(t + 2) * kstep; const char* b2 = last ? nB : cB + (size_t)(t + 2) * kstep;
            const char* a3 = a2 + kstep; const char* b3 = b2 + kstep;
            if (last && has_next) S.a_ready(nxt);
            if constexpr (SP2) {
            PG8_LDB(B0, 0, 0); PG8_LDB(B1, 0, 1); PG8_SCHED; PG8_LDA(At, 0, 0); PG8_STAGE(PG8_SA(1, 1), a1 + hstep, voffA);
            PG8_WAIT_V(8); PG8_WAIT_L(0); PG8_BAR; PG8_MMA(0, 0, At, B0); PG8_MMA(0, 1, At, B1); PG8_BAR; PG8_SCHED;
            PG8_LDA(At, 0, 1); PG8_STAGE(PG8_SB(0, 0), b2, voffB); PG8_STAGE(PG8_SB(0, 1), b2 + hstep, voffB); PG8_STAGE(PG8_SA(0, 0), a2, voffA);
            PG8_WAIT_V(8); PG8_WAIT_L(0); PG8_BAR; PG8_MMA(1, 0, At, B0); PG8_MMA(1, 1, At, B1); PG8_BAR; PG8_SCHED;
            PG8_LDB(B0, 1, 0); PG8_LDB(B1, 1, 1); PG8_SCHED; PG8_LDA(At, 1, 0); PG8_STAGE(PG8_SA(0, 1), a2 + hstep, voffA);
            PG8_WAIT_V(8); PG8_WAIT_L(0); PG8_BAR; PG8_MMA(0, 0, At, B0); PG8_MMA(0, 1, At, B1); PG8_BAR; PG8_SCHED;
            PG8_LDA(At, 1, 1); PG8_STAGE(PG8_SB(1, 0), b3, voffB); PG8_STAGE(PG8_SB(1, 1), b3 + hstep, voffB); PG8_STAGE(PG8_SA(1, 0), a3, voffA);
            PG8_WAIT_V(8); PG8_WAIT_L(0); PG8_BAR; PG8_MMA(1, 0, At, B0); PG8_MMA(1, 1, At, B1); PG8_BAR; PG8_SCHED;
            } else {
            PG8_LDB(B0, 0, 0); PG8_SCHED; PG8_LDA(At, 0, 0); PG8_STAGE(PG8_SA(1, 1), a1 + hstep, voffA);
            PG8_WAIT_L(8); PG8_BAR; PG8_WAIT_L(0); PG8_MMA(0, 0, At, B0); PG8_BAR; PG8_SCHED;
            PG8_LDB(B1, 0, 1); PG8_STAGE(PG8_SB(0, 0), b2, voffB);
            PG8_BAR; PG8_WAIT_L(0); PG8_MMA(0, 1, At, B1); PG8_BAR;
            PG8_LDA(At, 0, 1); PG8_STAGE(PG8_SA(0, 0), a2, voffA);
            PG8_BAR; PG8_WAIT_L(0); PG8_MMA(1, 0, At, B0); PG8_BAR; PG8_SCHED;
            PG8_STAGE(PG8_SB(0, 1), b2 + hstep, voffB);
            PG8_WAIT_V(6); PG8_BAR; PG8_MMA(1, 1, At, B1); PG8_BAR;
            PG8_LDB(B0, 1, 0); PG8_SCHED; PG8_LDA(At, 1, 0); PG8_STAGE(PG8_SA(0, 1), a2 + hstep, voffA);
            PG8_WAIT_L(8); PG8_BAR; PG8_WAIT_L(0); PG8_MMA(0, 0, At, B0); PG8_BAR; PG8_SCHED;
            PG8_LDB(B1, 1, 1); PG8_STAGE(PG8_SB(1, 0), b3, voffB);
            PG8_BAR; PG8_WAIT_L(0); PG8_MMA(0, 1, At, B1); PG8_BAR;
            PG8_LDA(At, 1, 1); PG8_STAGE(PG8_SA(1, 0), a3, voffA);
            PG8_BAR; PG8_WAIT_L(0); PG8_MMA(1, 0, At, B0); PG8_BAR; PG8_SCHED;
            PG8_STAGE(PG8_SB(1, 1), b3 + hstep, voffB);
            PG8_WAIT_V(6); PG8_BAR; PG8_MMA(1, 1, At, B1); PG8_BAR;
            }
        }
        if constexpr (ALIGN_EPI) { if (wr == 0) PG8_BAR; }
        if constexpr (!Epi::AFTER_DRAIN) { E(acc, cur, wr, wc, fr, fq); S.done(cur); }
        if (!has_next) break;
#pragma unroll
        for (int a = 0; a < 2; ++a)
#pragma unroll
            for (int b = 0; b < 2; ++b)
#pragma unroll
                for (int m = 0; m < 4; ++m)
#pragma unroll
                    for (int n = 0; n < 2; ++n) acc[a][b][m][n] = (f32x4){0.f, 0.f, 0.f, 0.f};
        cur = nxt; cA = nA; cB = nB; ++ui;
        if constexpr (ALIGN_EPI) { if (wr == 1) PG8_BAR; }
    }
    PG8_WAIT_V(0);
    if constexpr (!ALIGN_EPI) { if (wr == 0) PG8_BAR; }
    PG8_BAR;
    if constexpr (Epi::AFTER_DRAIN) { E.fused(acc, cur, wr, wc, fr, fq, lds, wid, lane); S.done(cur); }
#undef PG8_SA
#undef PG8_SB
#undef PG8_STAGE
#undef PG8_LDA
#undef PG8_LDB
#undef PG8_MMA
#undef PG8_WAIT_V
#undef PG8_WAIT_L
#undef PG8_BAR
#undef PG8_SCHED
}
}
using pg8::fast_tanh; using pg8::fast_sigmoid;

constexpr int D = 1024, PB = 8, PT = 2048, SBN = 128, STN = 8;
constexpr int MP = PB * PT, MS = SBN * STN, M = MP + MS;
constexpr int RH = 16, FF = 2816, F2 = 5632, AH = 8, AW = 512, NQKV = 4608;
constexpr float NORM_EPS = 1e-6f, GN_EPS = 64e-5f;
constexpr size_t O_YP = 0, O_YS = O_YP + (size_t)MP * D, O_PSHIFT = O_YS + (size_t)MS * D, O_PWKV = O_PSHIFT + (size_t)PB * D,
    O_PKV128 = O_PWKV + (size_t)PB * RH * 64 * 64, O_PKV512 = O_PKV128 + (size_t)PB * 128 * 1024, O_PKV2048 = O_PKV512 + (size_t)PB * 512 * 1024,
    O_PCONV = O_PKV2048 + (size_t)PB * 2048 * 1024, O_SSHIFT = O_PCONV + (size_t)2 * PB * 2 * F2, O_SWKV = O_SSHIFT + (size_t)SBN * D,
    O_SKV128 = O_SWKV + (size_t)SBN * RH * 64 * 64, O_SKV512 = O_SKV128 + (size_t)SBN * 8 * 1024, O_SKV2048 = O_SKV512 + (size_t)SBN * 8 * 1024,
    O_SCONV = O_SKV2048 + (size_t)SBN * 8 * 1024, O_END = O_SCONV + (size_t)2 * SBN * 2 * F2;
static_assert(O_END == 55107584, "output size");
constexpr size_t MiB = 1u << 20;
constexpr size_t WS_CTL = 0, CTL_ZERO_BYTES = 1 * MiB;
constexpr size_t WS_ROPE = 1 * MiB;
constexpr size_t WS_W1CAT = 2 * MiB, WS_WL2 = 10 * MiB, WS_WORW = 13 * MiB, WS_WUP0 = 15 * MiB, WS_WDN0 = 26 * MiB, WS_WQKV = 32 * MiB, WS_WOAT = 41 * MiB, WS_WUP1 = 42 * MiB, WS_WDN1 = 53 * MiB;
constexpr size_t RB16 = (size_t)M * D * 2, RF32 = (size_t)M * D * 4;
constexpr size_t WS_XM = 64 * MiB;
constexpr size_t WS_R = WS_XM + 6 * RB16, WS_K = WS_R + RF32, WS_V = WS_K + RF32, WS_DC = WS_V + RF32, WS_AA = WS_DC + RF32, WS_GG = WS_AA + RF32;
constexpr size_t WS_L2A = WS_GG + RF32;
constexpr size_t WS_Y = WS_L2A + 13 * MiB, WS_BONUS = WS_Y + RF32, WS_YG = WS_BONUS + 2 * MiB, WS_MO = WS_YG + RB16;
constexpr size_t WS_X1 = WS_MO + RF32, WS_X2 = WS_X1 + RF32, WS_X3 = WS_X2 + RF32, WS_XN = WS_X3 + RF32;
constexpr size_t WS_HID = WS_XN + RB16;
constexpr size_t WS_ACT = WS_HID + (size_t)M * F2 * 2;
constexpr size_t WS_QKV = WS_ACT + (size_t)M * FF * 2;
constexpr size_t WS_OG = WS_QKV + (size_t)M * NQKV * 2;
constexpr size_t WS_LSE = WS_OG + (size_t)3 * M * AW * 2;
constexpr size_t WS_OM = WS_LSE + 2 * MiB;
constexpr size_t WS_END = WS_OM + (size_t)M * AW * 2 + MiB;
static_assert(WS_W1CAT + (size_t)3840 * 1024 * 2 <= WS_WL2 && WS_WL2 + (size_t)3072 * 384 * 2 <= WS_WORW && WS_WUP0 + (size_t)F2 * D * 2 <= WS_WDN0 && WS_WDN0 + (size_t)D * FF * 2 <= WS_WQKV &&
              WS_WQKV + (size_t)NQKV * D * 2 <= WS_WOAT && WS_WUP1 + (size_t)F2 * D * 2 <= WS_WDN1 && WS_WDN1 + (size_t)D * FF * 2 <= WS_XM && (size_t)M * 384 * 2 <= 13 * MiB && (size_t)3 * M * 8 * 4 <= 2 * MiB, "ws map");
constexpr int CW_TMO = 0, CW_BAR = 4096;

constexpr int NWAVES = 8;
constexpr int RING_OFF = 0, RING_BYTES = 131072;
constexpr int LDSCTL_OFF = RING_BYTES, MISC_OFF = LDSCTL_OFF + 320;
constexpr int EX_OFF = MISC_OFF + 128;
constexpr int LDS_BYTES = 147456;

#define GAS __attribute__((address_space(1)))
#define LAS __attribute__((address_space(3)))
typedef unsigned short bf16;
typedef unsigned v4u __attribute__((ext_vector_type(4)));
typedef unsigned v2u __attribute__((ext_vector_type(2)));
typedef float f32x4 __attribute__((ext_vector_type(4)));
typedef float f32x2 __attribute__((ext_vector_type(2)));
typedef short bf16x8 __attribute__((ext_vector_type(8)));
typedef GAS unsigned gu32;
#define RLX_AGENT __ATOMIC_RELAXED, __HIP_MEMORY_SCOPE_AGENT
#define LDS_WAIT() asm volatile("s_waitcnt lgkmcnt(0)" ::: "memory")
#define VM_WAIT() asm volatile("s_waitcnt vmcnt(0)" ::: "memory")
__device__ __forceinline__ unsigned f2bf(float f) { unsigned u = __builtin_bit_cast(unsigned, f); return (u + 0x7fffu + ((u >> 16) & 1u)) >> 16; }
__device__ __forceinline__ unsigned pk2(float lo, float hi) { return f2bf(lo) | (f2bf(hi) << 16); }
__device__ __forceinline__ float bflo(unsigned w) { return __builtin_bit_cast(float, w << 16); }
__device__ __forceinline__ float bfhi(unsigned w) { return __builtin_bit_cast(float, w & 0xffff0000u); }
__device__ __forceinline__ float wave_sum(float v) {
#pragma unroll
    for (int o = 1; o < 64; o <<= 1) v += __shfl_xor(v, o);
    return v;
}
#define DPP_F(x, ctrl) __builtin_bit_cast(float, __builtin_amdgcn_mov_dpp(__builtin_bit_cast(int, (x)), (ctrl), 0xF, 0xF, true))
__device__ __forceinline__ float row16_sum(float x) {
    x += DPP_F(x, 0xB1);
    x += DPP_F(x, 0x4E);
    x += DPP_F(x, 0x141);
    x += DPP_F(x, 0x140);
    return x;
}
#define XB_TMO      128
#define XB_XCNT(j)  (256  + 64 * (j))
#define XB_XSUB(j)  (1280 + 64 * (j))
#define XB_XGEN(j)  (2304 + 64 * (j))
#define XB_TOP      3328
#define XB_TOPGEN   3392
#define XCD_BAR_WORDS 3456
#define XB_SPIN_CAP (1u << 18)

__device__ __forceinline__ unsigned xb_ld(unsigned* p)              { return __hip_atomic_load(p, __ATOMIC_RELAXED, __HIP_MEMORY_SCOPE_AGENT); }
__device__ __forceinline__ unsigned xb_add(unsigned* p, unsigned v) { return __hip_atomic_fetch_add(p, v, __ATOMIC_RELAXED, __HIP_MEMORY_SCOPE_AGENT); }
__device__ __forceinline__ unsigned xb_xcc_id() { return (unsigned)__builtin_amdgcn_s_getreg((3 << 11) | 20) & 0xFu; }
#define XB_SPIN(cond, bar) do { unsigned _sp = 0; while (cond) { __builtin_amdgcn_s_sleep(1); \
    if ((++_sp & 255u) == 0u) { if (xb_ld(&(bar)[XB_TMO])) break; if (_sp > XB_SPIN_CAP) { atomicAdd(&(bar)[XB_TMO], 1u); break; } } } } while (0)

struct XcdBarrier {
    unsigned* bar; unsigned x;
    volatile LAS unsigned* st;
};

__device__ __forceinline__ XcdBarrier xcd_barrier_post(unsigned* bar, volatile LAS unsigned* st) {
    XcdBarrier b; b.bar = bar; b.x = xb_xcc_id(); b.st = st;
    if (threadIdx.x == 0) (void)xb_add(&bar[XB_XCNT(b.x)], 1u);
    return b;
}
__device__ __forceinline__ void xcd_barrier_complete(unsigned* bar, unsigned x, unsigned& nloc, unsigned& nx) {
    const unsigned G = gridDim.x * gridDim.y * gridDim.z;
    unsigned sum, cnt, mine, sp = 0u;
    for (;;) {
        sum = 0u; cnt = 0u; mine = 0u;
#pragma unroll
        for (unsigned j = 0; j < 16; ++j) { const unsigned c = xb_ld(&bar[XB_XCNT(j)]); sum += c; cnt += (c > 0u) ? 1u : 0u; mine = (j == x) ? c : mine; }
        if (sum == G) break;
        __builtin_amdgcn_s_sleep(1);
        if ((++sp & 255u) == 0u) { if (xb_ld(&bar[XB_TMO])) break; if (sp > XB_SPIN_CAP) { atomicAdd(&bar[XB_TMO], 1u); break; } }
    }
    nloc = mine > 0u ? mine : 1u; nx = cnt > 0u ? cnt : 1u;
}

__device__ __forceinline__ void xcd_barrier(const XcdBarrier& b) {
    asm volatile("s_waitcnt vmcnt(0)" ::: "memory");
    __syncthreads();
    if (threadIdx.x == 0) {
        unsigned* bar = b.bar;
        __builtin_amdgcn_s_waitcnt(0);
        unsigned nloc = b.st[0], nx = b.st[1];
        if (nloc == 0u) { xcd_barrier_complete(bar, b.x, nloc, nx); b.st[0] = nloc; b.st[1] = nx; }
        const unsigned old = xb_add(&bar[XB_XSUB(b.x)], 1u);
        const unsigned gen = old / nloc;
        if (old + 1u == (gen + 1u) * nloc) {
            __builtin_amdgcn_fence(__ATOMIC_RELEASE, "agent");
            asm volatile("s_waitcnt vmcnt(0)" ::: "memory");
            const unsigned og = xb_add(&bar[XB_TOP], 1u);
            const unsigned tg = og / nx;
            if (og + 1u == (tg + 1u) * nx) xb_add(&bar[XB_TOPGEN], 1u);
            else XB_SPIN(xb_ld(&bar[XB_TOPGEN]) == tg, bar);
            __builtin_amdgcn_fence(__ATOMIC_ACQUIRE, "agent");
            xb_add(&bar[XB_XGEN(b.x)], 1u);
            asm volatile("s_waitcnt vmcnt(0)" ::: "memory");
        } else {
            XB_SPIN(xb_ld(&bar[XB_XGEN(b.x)]) == gen, bar);
            __builtin_amdgcn_fence(__ATOMIC_ACQUIRE, "agent");
            asm volatile("s_waitcnt vmcnt(0)" ::: "memory");
        }
    }
    __syncthreads();
}

struct Ctx { LAS unsigned char* lds; int tid, lane, wave, gw, NGW, G, bid; };

__device__ __forceinline__ void transpose_item(const float* W, int ldw, int Kvalid, bf16* WT, int ldt, int drow0, int dcol0, int k0, int n0, LAS float* scr, int lane) {
#pragma unroll 8
    for (int i = 0; i < 32; ++i) { const int kk = 2 * i + (lane >> 5), k = k0 + kk; scr[kk * 33 + (lane & 31)] = (k < Kvalid) ? W[(size_t)k * ldw + n0 + (lane & 31)] : 0.f; }
    LDS_WAIT(); asm volatile("" ::: "memory");
    const int c = lane & 7;
#pragma unroll
    for (int j = 0; j < 4; ++j) { const int n = (lane >> 3) + 8 * j; const LAS float* s = scr + (8 * c) * 33 + n;
        v4u o; o.x = pk2(s[0 * 33], s[1 * 33]); o.y = pk2(s[2 * 33], s[3 * 33]); o.z = pk2(s[4 * 33], s[5 * 33]); o.w = pk2(s[6 * 33], s[7 * 33]);
        *(GAS v4u*)(WT + (size_t)(drow0 + n) * ldt + dcol0 + 8 * c) = o; }
    LDS_WAIT(); asm volatile("" ::: "memory");
}
template <bool GLU = false> __device__ __forceinline__ void transpose_mat(const Ctx& C, const float* W, int K, int N, bf16* WT, int ldt, int row_off, int& base, LAS float* scr) {
    const int nblk = N / 32, nit = ((K + 63) / 64) * nblk;
    int start = (C.gw - base) % C.NGW; if (start < 0) start += C.NGW;
    for (int it = start; it < nit; it += C.NGW) { const int kb = it / nblk, nb = it % nblk, n0 = 32 * nb;
        const int drow = GLU ? (n0 < FF ? (n0 / 128) * 256 + (n0 % 128) : ((n0 - FF) / 128) * 256 + 128 + ((n0 - FF) % 128)) : n0;
        transpose_item(W, N, K, WT, ldt, row_off + drow, 64 * kb, 64 * kb, n0, scr, C.lane); }
    base += nit;
}
__device__ __forceinline__ void zero_rows(const Ctx& C, bf16* WT, int ldt, int r0, int r1) {
    const size_t n16 = (size_t)(r1 - r0) * ldt / 8; GAS v4u* p = (GAS v4u*)(WT + (size_t)r0 * ldt);
    for (size_t i = (size_t)C.bid * 512 + C.tid; i < n16; i += (size_t)C.G * 512) p[i] = (v4u){0u, 0u, 0u, 0u};
}

struct In { const float* p[33]; };

__device__ __forceinline__ void p0_prologue(const Ctx& C, const In& in, unsigned char* ws, float* out) {
    LAS float* scr = (LAS float*)(C.lds + RING_OFF + C.wave * 16384);
    bf16* W1CAT = (bf16*)(ws + WS_W1CAT); bf16* WL2 = (bf16*)(ws + WS_WL2);
    int base = 0;
    transpose_mat(C, in.p[10], D, D, W1CAT, D, 0, base, scr);
    transpose_mat(C, in.p[11], D, D, W1CAT, D, 1024, base, scr);
    transpose_mat(C, in.p[12], D, D, W1CAT, D, 2048, base, scr);
    transpose_mat(C, in.p[15], D, 64, W1CAT, D, 3072, base, scr);
    transpose_mat(C, in.p[18], D, 64, W1CAT, D, 3328, base, scr);
    transpose_mat(C, in.p[20], D, 160, W1CAT, D, 3584, base, scr);
    transpose_mat(C, in.p[13], D, D, (bf16*)(ws + WS_WORW), D, 0, base, scr);
    transpose_mat<true>(C, in.p[29], D, F2, (bf16*)(ws + WS_WUP0), D, 0, base, scr);
    transpose_mat<true>(C, in.p[29] + (size_t)D * F2, D, F2, (bf16*)(ws + WS_WUP1), D, 0, base, scr);
    transpose_mat(C, in.p[32], FF, D, (bf16*)(ws + WS_WDN0), FF, 0, base, scr);
    transpose_mat(C, in.p[32] + (size_t)FF * D, FF, D, (bf16*)(ws + WS_WDN1), FF, 0, base, scr);
    transpose_mat(C, in.p[27], D, NQKV, (bf16*)(ws + WS_WQKV), D, 0, base, scr);
    transpose_mat(C, in.p[28], AW, D, (bf16*)(ws + WS_WOAT), AW, 0, base, scr);
    zero_rows(C, W1CAT, D, 3072 + 64, 3328); zero_rows(C, W1CAT, D, 3328 + 64, 3584); zero_rows(C, W1CAT, D, 3584 + 160, 3840);
    { const float* w2 = in.p[16]; const float* a2 = in.p[19]; const float* g2 = in.p[21];
      for (int idx = C.bid * 512 + C.tid; idx < 48 * 3072; idx += C.G * 512) { const int kc = idx / 3072, n = idx % 3072, k0 = 8 * kc; float v[8];
#pragma unroll
          for (int j = 0; j < 8; ++j) { const int k = k0 + j; float x = 0.f;
              if (n < 1024) { if (k < 64) x = w2[(size_t)k * D + n]; }
              else if (n < 2048) { if (k >= 64 && k < 128) x = a2[(size_t)(k - 64) * D + (n - 1024)]; }
              else { if (k >= 128 && k < 288) x = g2[(size_t)(k - 128) * D + (n - 2048)]; }
              v[j] = x; }
          v4u o; o.x = pk2(v[0], v[1]); o.y = pk2(v[2], v[3]); o.z = pk2(v[4], v[5]); o.w = pk2(v[6], v[7]);
          *(GAS v4u*)(WL2 + (size_t)n * 384 + k0) = o; } }
    { float* rope = (float*)(ws + WS_ROPE);
      for (int idx = C.bid * 512 + C.tid; idx < 2056 * 8; idx += C.G * 512) { const int pos = idx >> 3, i = idx & 7;
          const double c = i == 0 ? 0.15915494309189535 : i == 1 ? 0.03086376340470123 : i == 2 ? 0.005985185712713705 : i == 3 ? 0.001160663641240061 :
                           i == 4 ? 0.00022507907903927653 : i == 5 ? 4.364795279280289e-05 : i == 6 ? 8.464330808241401e-06 : 1.6414262627950345e-06;
          const double rev = (double)pos * c; const float fr = (float)(rev - __builtin_floor(rev));
          rope[2 * idx] = __builtin_amdgcn_cosf(fr); rope[2 * idx + 1] = __builtin_amdgcn_sinf(fr); } }
    { const float* g0 = in.p[8]; const float* mu = in.p[9]; bf16* XM = (bf16*)(ws + WS_XM);
      for (int m = C.gw; m < M; m += C.NGW) {
          const bool pr = m < MP; const int t = pr ? (m & (PT - 1)) : ((m - MP) & (STN - 1)), b = pr ? (m >> 11) : ((m - MP) >> 3);
          const float* xr = pr ? in.p[0] + (size_t)m * D : in.p[1] + (size_t)(m - MP) * D;
          f32x4 v[4], pv[4]; float ss = 0.f, ps = 0.f;
#pragma unroll
          for (int j = 0; j < 4; ++j) { v[j] = *(const GAS f32x4*)(xr + 4 * C.lane + 256 * j); ss += (v[j].x * v[j].x + v[j].y * v[j].y) + (v[j].z * v[j].z + v[j].w * v[j].w); }
          if (t > 0) {
#pragma unroll
              for (int j = 0; j < 4; ++j) { pv[j] = *(const GAS f32x4*)(xr - D + 4 * C.lane + 256 * j); ps += (pv[j].x * pv[j].x + pv[j].y * pv[j].y) + (pv[j].z * pv[j].z + pv[j].w * pv[j].w); }
          } else {
#pragma unroll
              for (int j = 0; j < 4; ++j) pv[j] = pr ? (f32x4){0.f, 0.f, 0.f, 0.f} : *(const GAS f32x4*)(in.p[2] + (size_t)b * D + 4 * C.lane + 256 * j);
          }
          const float rs = 1.0f / sqrtf(wave_sum(ss) * (1.f / D) + NORM_EPS), prs = 1.0f / sqrtf(wave_sum(ps) * (1.f / D) + NORM_EPS);
          const bool last = pr ? (t == PT - 1) : (t == STN - 1);
#pragma unroll
          for (int j = 0; j < 4; ++j) { const int col = 4 * C.lane + 256 * j; const f32x4 g = *(const GAS f32x4*)(g0 + col);
              const f32x4 hn = v[j] * rs * g; const f32x4 hp = t > 0 ? pv[j] * prs * g : pv[j]; const f32x4 xx = hp - hn;
              if (last) *(GAS f32x4*)(out + (pr ? O_PSHIFT : O_SSHIFT) + (size_t)b * D + col) = hn;
#pragma unroll
              for (int i = 0; i < 6; ++i) { const f32x4 mm = *(const GAS f32x4*)(mu + i * D + col); const f32x4 r = hn + xx * mm;
                  const int slot = i == 1 ? 3 : (i == 2 ? 1 : (i == 3 ? 2 : i));
                  v2u o; o.x = pk2(r.x, r.y); o.y = pk2(r.z, r.w); *(GAS v2u*)(XM + (size_t)slot * M * D + (size_t)m * D + col) = o; } }
      } }
}

constexpr int SC_OPS = 0, SC_OPS_BYTES = 16 * 16 * 20 * 4, SC_VV = 2 * SC_OPS_BYTES, SC_VV_BYTES = 16 * 32 * 4, SC_YB = SC_VV + 2 * SC_VV_BYTES, SC_YB_BYTES = 16 * 32 * 4;
template <bool PROMPT> __device__ __forceinline__ void scan_unit(const Ctx& C, const In& in, unsigned char* ws, float* out, int b, int h, int vh) {
    constexpr int T = PROMPT ? PT : STN, NCH = PROMPT ? PT / 16 : 1, NT = PROMPT ? 16 : 8;
    const float* Rb = (const float*)(ws + WS_R); const float* Kb = (const float*)(ws + WS_K); const float* Vb = (const float*)(ws + WS_V);
    const float* Db = (const float*)(ws + WS_DC); const float* Ab = (const float*)(ws + WS_AA); float* Yb = (float*)(ws + WS_Y); float* Bon = (float*)(ws + WS_BONUS);
    const int row = C.tid >> 4, p = C.tid & 15, vrow = 32 * vh + row;
    const size_t tok0 = PROMPT ? (size_t)b * PT : (size_t)MP + (size_t)b * STN;
    const int col = h * 64 + C.lane;
    const float ka = in.p[23][col], kkw = in.p[22][col], rk = in.p[24][col];
    LAS float* OPS = (LAS float*)(C.lds + SC_OPS); LAS float* VV = (LAS float*)(C.lds + SC_VV); LAS float* YB = (LAS float*)(C.lds + SC_YB);
    f32x4 S;
    if (PROMPT) S = (f32x4){0.f, 0.f, 0.f, 0.f};
    else S = *(const GAS f32x4*)(in.p[3] + (((size_t)b * RH + h) * 64 + vrow) * 64 + 4 * p);
    float lr[2], lk[2], lv[2], ld[2], la[2];
#define SC_LOAD(c) do { _Pragma("unroll") for (int s = 0; s < 2; ++s) { const int tl = C.wave + 8 * s; if (tl < NT) { const size_t o = (tok0 + (size_t)(c) * 16 + tl) * D + col; \
        lr[s] = Rb[o]; lk[s] = Kb[o]; lv[s] = Vb[o]; ld[s] = Db[o]; la[s] = Ab[o]; } } } while (0)
#define SC_STORE(c, buf) do { _Pragma("unroll") for (int s = 0; s < 2; ++s) { const int tl = C.wave + 8 * s; if (tl < NT) { \
        const float kp = lk[s] * (1.0f + (la[s] - 1.0f) * ka), kr = lk[s] * kkw; const float n2 = wave_sum(kr * kr); const float kn = kr / fmaxf(sqrtf(n2), 1e-12f); \
        const float bon = wave_sum(lr[s] * kp * rk); \
        LAS float* o = OPS + (buf) * (SC_OPS_BYTES / 4) + ((tl * 16 + (C.lane >> 2)) * 20) + (C.lane & 3); \
        o[0] = kn; o[4] = ld[s]; o[8] = kp; o[12] = lr[s]; o[16] = kn * la[s]; \
        if ((C.lane >> 5) == vh) VV[(buf) * (SC_VV_BYTES / 4) + tl * 32 + (C.lane & 31)] = lv[s]; \
        if (vh == 0 && C.lane == 0) Bon[(tok0 + (size_t)(c) * 16 + tl) * 16 + h] = bon; } } } while (0)
    SC_LOAD(0); SC_STORE(0, 0);
    __syncthreads();
    for (int c = 0; c < NCH; ++c) {
        const int buf = c & 1;
        if (c + 1 < NCH) SC_LOAD(c + 1);
        float ykeep = 0.f;
        const LAS f32x4* op = (const LAS f32x4*)(OPS + buf * (SC_OPS_BYTES / 4) + p * 20);
        const LAS float* vvp = VV + buf * (SC_VV_BYTES / 4) + row;
#pragma unroll
        for (int tl = 0; tl < NT; ++tl) {
            const f32x4 kk = op[tl * 80 + 0], dd = op[tl * 80 + 1], kp = op[tl * 80 + 2], rr = op[tl * 80 + 3], kka = op[tl * 80 + 4]; const float vv = vvp[tl * 32];
            float sk = (S.x * kk.x + S.y * kk.y) + (S.z * kk.z + S.w * kk.w);
            sk = row16_sum(sk);
            S.x = S.x * dd.x + (vv * kp.x - sk * kka.x); S.y = S.y * dd.y + (vv * kp.y - sk * kka.y); S.z = S.z * dd.z + (vv * kp.z - sk * kka.z); S.w = S.w * dd.w + (vv * kp.w - sk * kka.w);
            float y = (S.x * rr.x + S.y * rr.y) + (S.z * rr.z + S.w * rr.w);
            y = row16_sum(y);
            ykeep = (p == tl) ? y : ykeep;
        }
        if (p < NT) YB[buf * (SC_YB_BYTES / 4) + p * 32 + row] = ykeep;
        if (c + 1 < NCH) SC_STORE(c + 1, buf ^ 1);
        __syncthreads();
        { const int tl = C.tid >> 5, rr = C.tid & 31; if (tl < NT) Yb[(tok0 + (size_t)c * 16 + tl) * D + h * 64 + 32 * vh + rr] = YB[buf * (SC_YB_BYTES / 4) + tl * 32 + rr]; }
    }
#undef SC_LOAD
#undef SC_STORE
    *(GAS f32x4*)(out + (PROMPT ? O_PWKV : O_SWKV) + (((size_t)b * RH + h) * 64 + vrow) * 64 + 4 * p) = S;
    __syncthreads();
}
__device__ __forceinline__ void scan_phase(const Ctx& C, const In& in, unsigned char* ws, float* out) {
    for (int u = C.bid; u < PB * RH * 2; u += C.G) scan_unit<true>(C, in, ws, out, u >> 5, (u >> 1) & 15, u & 1);
    for (int u = C.bid; u < SBN * RH * 2; u += C.G) scan_unit<false>(C, in, ws, out, u >> 5, (u >> 1) & 15, u & 1);
}
__device__ __forceinline__ void scan_post_phase(const Ctx& C, const In& in, unsigned char* ws) {
    const float* Yb = (const float*)(ws + WS_Y); const float* Vb = (const float*)(ws + WS_V); const float* Gb = (const float*)(ws + WS_GG); const float* Bon = (const float*)(ws + WS_BONUS);
    bf16* YG = (bf16*)(ws + WS_YG); const float* lg = in.p[25]; const float* lb = in.p[26];
    for (int m = C.gw; m < M; m += C.NGW) {
#pragma unroll
        for (int j = 0; j < 4; ++j) { const int col = 4 * C.lane + 256 * j, head = 4 * j + (C.lane >> 4); const size_t o = (size_t)m * D + col;
            const f32x4 y = *(const GAS f32x4*)(Yb + o); const float mean = row16_sum((y.x + y.y) + (y.z + y.w)) * (1.f / 64.f);
            const f32x4 d = y - mean; const float var = row16_sum((d.x * d.x + d.y * d.y) + (d.z * d.z + d.w * d.w)) * (1.f / 64.f);
            const float rs = 1.0f / sqrtf(var + GN_EPS), bon = Bon[(size_t)m * 16 + head];
            const f32x4 vv = *(const GAS f32x4*)(Vb + o), gg = *(const GAS f32x4*)(Gb + o), g4 = *(const GAS f32x4*)(lg + col), b4 = *(const GAS f32x4*)(lb + col);
            const f32x4 r = (d * rs * g4 + b4 + vv * bon) * gg;
            v2u w; w.x = pk2(r.x, r.y); w.y = pk2(r.z, r.w); *(GAS v2u*)(YG + o) = w; }
    }
}
__device__ __forceinline__ void rowwise_phase(const Ctx& C, const In& in, const float* xin, const float* mo, const float* g1, float* xout, const float* g2, bf16* xn) {
    for (int m = C.gw; m < M; m += C.NGW) {
        const float* xr = xin ? xin + (size_t)m * D : (m < MP ? in.p[0] + (size_t)m * D : in.p[1] + (size_t)(m - MP) * D);
        f32x4 a[4], x[4]; float ss = 0.f;
#pragma unroll
        for (int j = 0; j < 4; ++j) { a[j] = *(const GAS f32x4*)(mo + (size_t)m * D + 4 * C.lane + 256 * j); x[j] = *(const GAS f32x4*)(xr + 4 * C.lane + 256 * j);
            ss += (a[j].x * a[j].x + a[j].y * a[j].y) + (a[j].z * a[j].z + a[j].w * a[j].w); }
        const float rs = 1.0f / sqrtf(wave_sum(ss) * (1.f / D) + NORM_EPS); float s2 = 0.f;
#pragma unroll
        for (int j = 0; j < 4; ++j) { const int col = 4 * C.lane + 256 * j; x[j] = x[j] + a[j] * rs * *(const GAS f32x4*)(g1 + col);
            *(GAS f32x4*)(xout + (size_t)m * D + col) = x[j]; s2 += (x[j].x * x[j].x + x[j].y * x[j].y) + (x[j].z * x[j].z + x[j].w * x[j].w); }
        if (xn) { const float r2 = 1.0f / sqrtf(wave_sum(s2) * (1.f / D) + NORM_EPS);
#pragma unroll
            for (int j = 0; j < 4; ++j) { const int col = 4 * C.lane + 256 * j; const f32x4 r = x[j] * r2 * *(const GAS f32x4*)(g2 + col);
                v2u w; w.x = pk2(r.x, r.y); w.y = pk2(r.z, r.w); *(GAS v2u*)(xn + (size_t)m * D + col) = w; } }
    }
}
__device__ __forceinline__ float gelu_tanh(float x) { const float u = 0.7978845608028654f * (x + 0.044715f * x * x * x); return 0.5f * x * (1.0f + fast_tanh(u)); }
__device__ __forceinline__ void unpack8(const v4u w, float* f) { f[0] = bflo(w.x); f[1] = bfhi(w.x); f[2] = bflo(w.y); f[3] = bfhi(w.y); f[4] = bflo(w.z); f[5] = bfhi(w.z); f[6] = bflo(w.w); f[7] = bfhi(w.w); }
__device__ __forceinline__ void fixup_phase(const Ctx& C, unsigned char* ws, const float* cw, const float* cb, const float* sc) {
    const float* HALO = (const float*)(ws + WS_HID); const float* RAWS = (const float*)(ws + WS_HID + 8 * MiB); bf16* ACT = (bf16*)(ws + WS_ACT);
    constexpr int NC4 = FF / 4, NPROMPT = 56 * 2 * NC4, NSAMPLE = SBN * 2 * NC4;
    for (int idx = C.bid * 512 + C.tid; idx < NPROMPT + NSAMPLE; idx += C.G * 512) {
        const float *p0[2], *p1[2], *p2[2]; int c; size_t orow;
        if (idx < NPROMPT) { const int q = idx / NC4, r = q & 1, pi = q >> 1, pm = (pi / 7) * 8 + 1 + (pi % 7); c = (idx % NC4) * 4; orow = (size_t)pm * 256 + r;
#pragma unroll
            for (int s = 0; s < 2; ++s) { const size_t co = (size_t)s * FF + c; p0[s] = HALO + ((size_t)pm * 4 + r) * F2 + co;
                p1[s] = HALO + (r == 1 ? ((size_t)pm * 4 + 0) : ((size_t)(pm - 1) * 4 + 3)) * F2 + co; p2[s] = HALO + ((size_t)(pm - 1) * 4 + (r == 0 ? 2 : 3)) * F2 + co; }
        } else { const int q = (idx - NPROMPT) / NC4, t = q & 1, b = q >> 1, rs = b * 8 + t; c = ((idx - NPROMPT) % NC4) * 4; orow = (size_t)MP + rs;
#pragma unroll
            for (int s = 0; s < 2; ++s) { const size_t co = (size_t)s * FF + c; p0[s] = RAWS + (size_t)rs * F2 + co;
                p1[s] = t == 0 ? sc + ((size_t)b * 2 + 1) * F2 + co : RAWS + (size_t)(rs - 1) * F2 + co; p2[s] = sc + ((size_t)b * 2 + t) * F2 + co; }
        }
        f32x4 cv[2];
#pragma unroll
        for (int s = 0; s < 2; ++s) { const size_t co = (size_t)s * FF + c; const f32x4 h0 = *(const GAS f32x4*)p0[s], h1 = *(const GAS f32x4*)p1[s], h2 = *(const GAS f32x4*)p2[s];
            cv[s] = *(const GAS f32x4*)(cb + co) + *(const GAS f32x4*)(cw + co) * h2 + *(const GAS f32x4*)(cw + F2 + co) * h1 + *(const GAS f32x4*)(cw + 2 * F2 + co) * h0; }
        v2u o; o.x = pk2(gelu_tanh(cv[0].x) * cv[1].x, gelu_tanh(cv[0].y) * cv[1].y); o.y = pk2(gelu_tanh(cv[0].z) * cv[1].z, gelu_tanh(cv[0].w) * cv[1].w);
        *(GAS v2u*)(ACT + orow * FF + c) = o; }
}

constexpr float QSCALE = 0.125f * 1.4426950408889634f;
__device__ __forceinline__ void rope_phase(const Ctx& C, const In& in, unsigned char* ws, float* out) {
    bf16* QKV = (bf16*)(ws + WS_QKV); const float* rope = (const float*)(ws + WS_ROPE);
    for (int m = C.gw; m < M; m += C.NGW) {
        const bool pr = m < MP; const int t = pr ? (m & (PT - 1)) : ((m - MP) & 7), b = pr ? (m >> 11) : ((m - MP) >> 3), pos = pr ? t : PT + t;
        bf16* rowp = QKV + (size_t)m * NQKV;
        f32x4 cs0 = *(const GAS f32x4*)(rope + (size_t)pos * 16), cs1 = *(const GAS f32x4*)(rope + (size_t)pos * 16 + 4), cs2 = *(const GAS f32x4*)(rope + (size_t)pos * 16 + 8), cs3 = *(const GAS f32x4*)(rope + (size_t)pos * 16 + 12);
        const float cc[8] = {cs0.x, cs0.z, cs1.x, cs1.z, cs2.x, cs2.z, cs3.x, cs3.z}, sn[8] = {cs0.y, cs0.w, cs1.y, cs1.w, cs2.y, cs2.w, cs3.y, cs3.w};
#pragma unroll
        for (int it = 0; it < 9; ++it) {
            const int c8 = C.lane + 64 * it, col0 = 8 * c8, s = col0 / 1536, rem = col0 % 1536, g = rem / 512, h = (rem % 512) / 64, e0 = rem % 64;
            const v4u own = *(const GAS v4u*)(rowp + col0);
            const bool rot = (s < 2) && (e0 < 16);
            v4u par = own; if (rot) par = *(const GAS v4u*)(rowp + col0 + (e0 == 0 ? 8 : -8));
            float x[8], y[8], o[8]; unpack8(own, x); unpack8(par, y);
#pragma unroll
            for (int i = 0; i < 8; ++i) o[i] = !rot ? x[i] : (e0 == 0 ? x[i] * cc[i] - y[i] * sn[i] : x[i] * cc[i] + y[i] * sn[i]);
            if (s == 0) {
#pragma unroll
                for (int i = 0; i < 8; ++i) o[i] *= QSCALE; }
            if (s < 2) { v4u w; w.x = pk2(o[0], o[1]); w.y = pk2(o[2], o[3]); w.z = pk2(o[4], o[5]); w.w = pk2(o[6], o[7]); *(GAS v4u*)(rowp + col0) = w; }
            if (s >= 1) {
                const int L = g == 0 ? 128 : (g == 1 ? 512 : 2048); float* dst = nullptr;
                if (pr) { const int j = t - (PT - L); if (j >= 0) dst = out + (g == 0 ? O_PKV128 : (g == 1 ? O_PKV512 : O_PKV2048)) + ((((size_t)b * L + j) * 2 + (s - 1)) * 8 + h) * 64 + e0; }
                else dst = out + (g == 0 ? O_SKV128 : (g == 1 ? O_SKV512 : O_SKV2048)) + ((((size_t)b * 8 + t) * 2 + (s - 1)) * 8 + h) * 64 + e0;
                if (dst) { *(GAS f32x4*)dst = (f32x4){o[0], o[1], o[2], o[3]}; *(GAS f32x4*)(dst + 4) = (f32x4){o[4], o[5], o[6], o[7]}; } }
        }
    }
}

constexpr int AT_RS = 160;
constexpr int AT_K = 0, AT_V = 256 * AT_RS;
typedef short s16x4 __attribute__((ext_vector_type(4)));
__device__ __forceinline__ s16x4 lds_tr16(const LAS unsigned char* p) { return __builtin_bit_cast(s16x4, __builtin_amdgcn_ds_read_tr16_b64_v4i16((LAS s16x4*)p)); }
struct PUnit { int b, h, g, res, n; };
__device__ __forceinline__ PUnit punit(int u) { PUnit r; const int bh = u / 48, j = u % 48; r.b = bh >> 3; r.h = bh & 7;
    if (j < 16) { r.g = 0; r.res = 0; r.n = j; } else if (j < 32) { r.g = 1; r.res = (j - 16) >> 2; r.n = (j - 16) & 3; } else { r.g = 2; r.res = j - 32; r.n = 0; } return r; }
__device__ __forceinline__ void pattn_load(const Ctx& C, const bf16* QKV, const PUnit& u, v4u (&kr)[4], v4u (&vr)[4]) {
    const int Dl = u.g == 0 ? 1 : (u.g == 1 ? 4 : 16);
#pragma unroll
    for (int i = 0; i < 4; ++i) { const int ch = C.tid + 512 * i, kj = ch >> 3, c = ch & 7; int lk = (u.n - 1) * 128 + kj; lk = lk < 0 ? 0 : lk;
        const bf16* rp = QKV + ((size_t)u.b * PT + u.res + Dl * lk) * NQKV + u.h * 64 + c * 8;
        kr[i] = *(const GAS v4u*)(rp + (3 + u.g) * 512); vr[i] = *(const GAS v4u*)(rp + (6 + u.g) * 512); }
}
__device__ __forceinline__ void pattn_store_lds(const Ctx& C, const v4u (&kr)[4], const v4u (&vr)[4]) {
#pragma unroll
    for (int i = 0; i < 4; ++i) { const int ch = C.tid + 512 * i, kj = ch >> 3, c = ch & 7;
        *(LAS v4u*)(C.lds + AT_K + kj * AT_RS + c * 16) = kr[i]; *(LAS v4u*)(C.lds + AT_V + kj * AT_RS + c * 16) = vr[i]; }
}
__device__ __forceinline__ void pattn_compute(const Ctx& C, unsigned char* ws, const PUnit& u) {
    const bf16* QKV = (const bf16*)(ws + WS_QKV); bf16* OG = (bf16*)(ws + WS_OG); float* LSE = (float*)(ws + WS_LSE);
    const int Dl = u.g == 0 ? 1 : (u.g == 1 ? 4 : 16), q16 = C.lane & 15, g4 = C.lane >> 4, qi = 16 * C.wave + q16;
    const size_t qrow = (size_t)u.b * PT + u.res + Dl * (u.n * 128 + qi);
    const bf16* qp = QKV + qrow * NQKV + u.g * 512 + u.h * 64;
    const bf16x8 qf0 = *(const GAS bf16x8*)(qp + 8 * g4), qf1 = *(const GAS bf16x8*)(qp + 32 + 8 * g4);
    f32x4 sc[16];
    const LAS unsigned char* kbase = C.lds + AT_K + q16 * AT_RS + g4 * 16;
#pragma unroll
    for (int T = 0; T < 16; ++T) { const bf16x8 k0 = *(const LAS bf16x8*)(kbase + T * 16 * AT_RS), k1 = *(const LAS bf16x8*)(kbase + T * 16 * AT_RS + 64);
        f32x4 a = __builtin_amdgcn_mfma_f32_16x16x32_bf16(k0, qf0, (f32x4){0.f, 0.f, 0.f, 0.f}, 0, 0, 0); sc[T] = __builtin_amdgcn_mfma_f32_16x16x32_bf16(k1, qf1, a, 0, 0, 0); }
    const int klo = (u.n == 0 && qi < 128) ? 128 : qi; float mx = -1e30f;
#pragma unroll
    for (int T = 0; T < 16; ++T)
#pragma unroll
        for (int j = 0; j < 4; ++j) { const int kj = 16 * T + 4 * g4 + j; const bool ok = kj >= klo && kj <= qi + 128; sc[T][j] = ok ? sc[T][j] : -1e30f; mx = fmaxf(mx, sc[T][j]); }
    mx = fmaxf(mx, __shfl_xor(mx, 16)); mx = fmaxf(mx, __shfl_xor(mx, 32));
    float sum = 0.f;
#pragma unroll
    for (int T = 0; T < 16; ++T)
#pragma unroll
        for (int j = 0; j < 4; ++j) { const float p = __builtin_amdgcn_exp2f(sc[T][j] - mx); sc[T][j] = p; sum += p; }
    sum += __shfl_xor(sum, 16); sum += __shfl_xor(sum, 32);
    f32x4 oa[4] = {(f32x4){0.f, 0.f, 0.f, 0.f}, (f32x4){0.f, 0.f, 0.f, 0.f}, (f32x4){0.f, 0.f, 0.f, 0.f}, (f32x4){0.f, 0.f, 0.f, 0.f}};
    const LAS unsigned char* vbase = C.lds + AT_V + (4 * g4 + (q16 >> 2)) * AT_RS + (q16 & 3) * 8;
#pragma unroll
    for (int s = 0; s < 8; ++s) {
        pg8::u32x4 pw; pw.x = pg8::cvt_pk_bf16(sc[2 * s][0], sc[2 * s][1]); pw.y = pg8::cvt_pk_bf16(sc[2 * s][2], sc[2 * s][3]); pw.z = pg8::cvt_pk_bf16(sc[2 * s + 1][0], sc[2 * s + 1][1]); pw.w = pg8::cvt_pk_bf16(sc[2 * s + 1][2], sc[2 * s + 1][3]);
        const bf16x8 pf = __builtin_bit_cast(bf16x8, pw);
#pragma unroll
        for (int c = 0; c < 4; ++c) { const s16x4 lo = lds_tr16(vbase + (32 * s) * AT_RS + c * 32), hi = lds_tr16(vbase + (32 * s + 16) * AT_RS + c * 32);
            const bf16x8 vf = (bf16x8){lo[0], lo[1], lo[2], lo[3], hi[0], hi[1], hi[2], hi[3]};
            oa[c] = __builtin_amdgcn_mfma_f32_16x16x32_bf16(vf, pf, oa[c], 0, 0, 0); }
    }
    const float inv = 1.0f / sum;
    bf16* op = OG + ((size_t)u.g * M + qrow) * AW + u.h * 64 + 4 * g4;
#pragma unroll
    for (int c = 0; c < 4; ++c) { v2u w; w.x = pk2(oa[c][0] * inv, oa[c][1] * inv); w.y = pk2(oa[c][2] * inv, oa[c][3] * inv); *(GAS v2u*)(op + 16 * c) = w; }
    if (g4 == 0) LSE[((size_t)u.g * M + qrow) * 8 + u.h] = mx + __builtin_amdgcn_logf(sum);
}
__device__ __forceinline__ void sattn_unit(const Ctx& C, const float* cache_g, unsigned char* ws, const float* out, int b, int g, int h) {
    const bf16* QKV = (const bf16*)(ws + WS_QKV); bf16* OG = (bf16*)(ws + WS_OG); float* LSE = (float*)(ws + WS_LSE);
    const int L = g == 0 ? 128 : (g == 1 ? 512 : 2048), Dl = g == 0 ? 1 : (g == 1 ? 4 : 16), i = C.wave, d16 = C.lane & 15, sub = C.lane >> 4;
    const size_t qrow = (size_t)MP + (size_t)b * 8 + i;
    const v2u qw = *(const GAS v2u*)(QKV + qrow * NQKV + g * 512 + h * 64 + 4 * d16);
    const f32x4 q = (f32x4){bflo(qw.x), bfhi(qw.x), bflo(qw.y), bfhi(qw.y)};
    const float* cache = cache_g + (size_t)b * L * 1024 + h * 64 + 4 * d16;
    const float* fresh = out + (g == 0 ? O_SKV128 : (g == 1 ? O_SKV512 : O_SKV2048)) + (size_t)b * 8 * 1024 + h * 64 + 4 * d16;
    float s[33]; float mx = -1e30f;
#pragma unroll
    for (int it = 0; it < 33; ++it) { const int j = 4 * it + sub; const bool ok = j <= 128; const int idx = L + i - Dl * (ok ? j : 0);
        const float* kp = idx >= L ? fresh + (size_t)(idx - L) * 1024 : cache + (size_t)idx * 1024;
        const f32x4 kv = *(const GAS f32x4*)kp;
        float d = (q.x * kv.x + q.y * kv.y) + (q.z * kv.z + q.w * kv.w); d = row16_sum(d);
        s[it] = ok ? d : -1e30f; mx = fmaxf(mx, s[it]); }
    mx = fmaxf(mx, __shfl_xor(mx, 16)); mx = fmaxf(mx, __shfl_xor(mx, 32));
    float sum = 0.f; f32x4 o = (f32x4){0.f, 0.f, 0.f, 0.f};
#pragma unroll
    for (int it = 0; it < 33; ++it) { const int j = 4 * it + sub; const bool ok = j <= 128; const int idx = L + i - Dl * (ok ? j : 0);
        const float* vp = (idx >= L ? fresh + (size_t)(idx - L) * 1024 : cache + (size_t)idx * 1024) + 512;
        const f32x4 vv = *(const GAS f32x4*)vp; const float p = __builtin_amdgcn_exp2f(s[it] - mx); sum += p; o = o + vv * p; }
    sum += __shfl_xor(sum, 16); sum += __shfl_xor(sum, 32);
#pragma unroll
    for (int e = 0; e < 4; ++e) { o[e] += __shfl_xor(o[e], 16); o[e] += __shfl_xor(o[e], 32); }
    if (sub == 0) { const float inv = 1.0f / sum; v2u w; w.x = pk2(o.x * inv, o.y * inv); w.y = pk2(o.z * inv, o.w * inv);
        *(GAS v2u*)(OG + ((size_t)g * M + qrow) * AW + h * 64 + 4 * d16) = w;
        if (d16 == 0) LSE[((size_t)g * M + qrow) * 8 + h] = mx + __builtin_amdgcn_logf(sum); }
}
typedef const __attribute__((address_space(4))) In* KInP;
__device__ __forceinline__ void attn_phase(const Ctx& C, KInP kp, unsigned char* ws, float* out) {
    const bf16* QKV = (const bf16*)(ws + WS_QKV);
    constexpr int NPU = PB * 8 * 48;
    v4u kr[4], vr[4];
    int u = C.bid;
    if (u < NPU) { const PUnit pu = punit(u); pattn_load(C, QKV, pu, kr, vr); }
    for (; u < NPU; u += C.G) {
        const PUnit pu = punit(u);
        pattn_store_lds(C, kr, vr);
        __syncthreads();
        if (u + C.G < NPU) { const PUnit nu = punit(u + C.G); pattn_load(C, QKV, nu, kr, vr); }
        pattn_compute(C, ws, pu);
        __syncthreads();
    }
    for (int su = C.bid; su < SBN * 3 * 8; su += C.G) { const int h = su & 7, b = (su >> 3) & 127, g = su >> 10; const float* cache_g = kp->p[4 + (2 - g)];
        sattn_unit(C, cache_g, ws, out, b, 2 - g, h); }
}
__device__ __forceinline__ void merge_phase(const Ctx& C, unsigned char* ws) {
    const bf16* OG = (const bf16*)(ws + WS_OG); const float* LSE = (const float*)(ws + WS_LSE); bf16* OM = (bf16*)(ws + WS_OM);
    for (int idx = C.bid * 512 + C.tid; idx < M * 64; idx += C.G * 512) { const int m = idx >> 6, c8 = idx & 63, h = c8 >> 3;
        const float l0 = LSE[((size_t)0 * M + m) * 8 + h], l1 = LSE[((size_t)1 * M + m) * 8 + h], l2 = LSE[((size_t)2 * M + m) * 8 + h];
        const float mx = fmaxf(l0, fmaxf(l1, l2)); float w0 = __builtin_amdgcn_exp2f(l0 - mx), w1 = __builtin_amdgcn_exp2f(l1 - mx), w2 = __builtin_amdgcn_exp2f(l2 - mx);
        const float inv = 1.0f / (w0 + w1 + w2); w0 *= inv; w1 *= inv; w2 *= inv;
        float a[8], b[8], c[8];
        unpack8(*(const GAS v4u*)(OG + ((size_t)0 * M + m) * AW + 8 * c8), a); unpack8(*(const GAS v4u*)(OG + ((size_t)1 * M + m) * AW + 8 * c8), b); unpack8(*(const GAS v4u*)(OG + ((size_t)2 * M + m) * AW + 8 * c8), c);
        float o[8];
#pragma unroll
        for (int e = 0; e < 8; ++e) o[e] = w0 * a[e] + w1 * b[e] + w2 * c[e];
        v4u w; w.x = pk2(o[0], o[1]); w.y = pk2(o[2], o[3]); w.z = pk2(o[4], o[5]); w.w = pk2(o[6], o[7]);
        *(GAS v4u*)(OM + (size_t)m * AW + 8 * c8) = w; }
}

#ifndef MK_ONE_LAUNCH
#define MK_ONE_LAUNCH 1
#endif
#ifndef REP_MASK
#define REP_MASK 0
#endif
#ifndef ONLY
#define ONLY -1
#endif
constexpr int N_PHASES = 21;
struct Args { In in; float* out; unsigned char* ws; int ph_lo, ph_hi; };
typedef const __attribute__((address_space(4))) In* KIn;
__device__ __forceinline__ KIn launder_kernarg() { unsigned long long p = (unsigned long long)__builtin_amdgcn_kernarg_segment_ptr(); asm volatile("" : "+s"(p)); return (KIn)p; }
#define IN_LOAD() In in; { KIn kp_ = launder_kernarg(); _Pragma("unroll") for (int i_ = 0; i_ < 33; ++i_) in.p[i_] = kp_->p[i_]; }
#define GEMM_PHASE(EPI, Aoff, Boff, Nn, Kk, ASEL, ...) { pg8::Gemm g{(const bf16*)(ws + (Aoff)), (const bf16*)(ws + (Boff)), M, (Nn), (Kk), (ASEL)}; pg8::StaticOrder S; S.init(M, (Nn), C.G, C.bid); \
        pg8::EPI E{__VA_ARGS__}; pg8::gemm_phase<pg8::EPI, pg8::StaticOrder, true, true>(ring, g, S, E); }
#define DOWN_PHASE(Boff, layer) GEMM_PHASE(EpiF32, WS_ACT, Boff, D, FF, 0, (float*)(ws + WS_MO), D)
#define FIX_PHASE(layer) { IN_LOAD(); fixup_phase(C, ws, in.p[30] + (size_t)(layer) * 3 * F2, in.p[31] + (size_t)(layer) * F2, in.p[7] + (size_t)(layer) * SBN * 2 * F2); }
#define UP_PHASE(Boff, layer) { IN_LOAD(); GEMM_PHASE(EpiConv, WS_XN, Boff, F2, D, 0, (bf16*)(ws + WS_ACT), (float*)(ws + WS_HID), (float*)(ws + WS_HID + 8 * MiB), out + O_PCONV + (size_t)(layer) * PB * 2 * F2, out + O_SCONV + (size_t)(layer) * SBN * 2 * F2, \
        in.p[30] + (size_t)(layer) * 3 * F2, in.p[31] + (size_t)(layer) * F2, (LAS float*)(C.lds + EX_OFF)) }

#define PBODY_0 { IN_LOAD(); p0_prologue(C, in, ws, out); }
#define PBODY_1 GEMM_PHASE(EpiG1, WS_XM, WS_W1CAT, 3840, D, RB16, (float*)(ws + WS_R), (bf16*)(ws + WS_L2A))
#define PBODY_2 { IN_LOAD(); GEMM_PHASE(EpiL2, WS_L2A, WS_WL2, 3072, 384, 0, (float*)(ws + WS_DC), in.p[14], in.p[17]) }
#define PBODY_3 { IN_LOAD(); scan_phase(C, in, ws, out); }
#define PBODY_4 { IN_LOAD(); scan_post_phase(C, in, ws); }
#define PBODY_5 GEMM_PHASE(EpiF32, WS_YG, WS_WORW, D, D, 0, (float*)(ws + WS_MO), D)
#define PBODY_6 { IN_LOAD(); rowwise_phase(C, in, nullptr, (const float*)(ws + WS_MO), in.p[8] + 1 * D, (float*)(ws + WS_X1), in.p[8] + 2 * D, (bf16*)(ws + WS_XN)); }
#define PBODY_7 UP_PHASE(WS_WUP0, 0)
#define PBODY_8 FIX_PHASE(0)
#define PBODY_9 DOWN_PHASE(WS_WDN0, 0)
#define PBODY_10 { IN_LOAD(); rowwise_phase(C, in, (const float*)(ws + WS_X1), (const float*)(ws + WS_MO), in.p[8] + 3 * D, (float*)(ws + WS_X2), in.p[8] + 4 * D, (bf16*)(ws + WS_XN)); }
#define PBODY_11 GEMM_PHASE(EpiBf16, WS_XN, WS_WQKV, NQKV, D, 0, (bf16*)(ws + WS_QKV), NQKV)
#define PBODY_12 { IN_LOAD(); rope_phase(C, in, ws, out); }
#define PBODY_13 { attn_phase(C, launder_kernarg(), ws, out); }
#define PBODY_14 { merge_phase(C, ws); }
#define PBODY_15 GEMM_PHASE(EpiF32, WS_OM, WS_WOAT, D, AW, 0, (float*)(ws + WS_MO), D)
#define PBODY_16 { IN_LOAD(); rowwise_phase(C, in, (const float*)(ws + WS_X2), (const float*)(ws + WS_MO), in.p[8] + 5 * D, (float*)(ws + WS_X3), in.p[8] + 6 * D, (bf16*)(ws + WS_XN)); }
#define PBODY_17 UP_PHASE(WS_WUP1, 1)
#define PBODY_18 FIX_PHASE(1)
#define PBODY_19 DOWN_PHASE(WS_WDN1, 1)
#define PBODY_20 { IN_LOAD(); rowwise_phase(C, in, (const float*)(ws + WS_X3), (const float*)(ws + WS_MO), in.p[8] + 7 * D, out + O_YP, nullptr, nullptr); }

__global__ void __launch_bounds__(NWAVES * 64, 2) fwd(Args args) {
    extern __shared__ __attribute__((aligned(16))) unsigned char lds[];
    Ctx C; C.lds = (LAS unsigned char*)lds; C.tid = threadIdx.x; C.lane = C.tid & 63; C.wave = __builtin_amdgcn_readfirstlane(C.tid >> 6);
    C.G = gridDim.x; C.bid = blockIdx.x; C.gw = C.bid * NWAVES + C.wave; C.NGW = C.G * NWAVES;
    unsigned char* ws = args.ws; float* out = args.out;
    volatile LAS unsigned* MISC = (volatile LAS unsigned*)(C.lds + MISC_OFF);
    for (int u = C.tid; u < (LDS_BYTES - LDSCTL_OFF) / 4; u += NWAVES * 64) ((LAS unsigned*)(C.lds + LDSCTL_OFF))[u] = 0u;
    __syncthreads();
    XcdBarrier bar; bar.bar = (unsigned*)(ws + WS_CTL) + CW_BAR; bar.x = 0; bar.st = nullptr;
    const int lo = args.ph_lo, hi = args.ph_hi;
    if (hi - lo > 1) bar = xcd_barrier_post((unsigned*)(ws + WS_CTL) + CW_BAR, MISC + 8);
    LAS unsigned char* ring = C.lds + RING_OFF;
#define IN(k) ((ONLY < 0 || ONLY == (k)) && lo <= (k) && (k) < hi)
#define PHASE(k) if (IN(k)) PBODY_##k if (IN(k) && ((REP_MASK >> (k)) & 1)) { if (hi - lo > 1) xcd_barrier(bar); PBODY_##k } if (IN(k) && IN((k) + 1)) xcd_barrier(bar);
    PHASE(0) PHASE(1) PHASE(2) PHASE(3) PHASE(4) PHASE(5) PHASE(6) PHASE(7) PHASE(8) PHASE(9) PHASE(10) PHASE(11) PHASE(12) PHASE(13) PHASE(14) PHASE(15) PHASE(16) PHASE(17) PHASE(18) PHASE(19) PHASE(20)
#undef IN
#undef PHASE
}

extern "C" void kernel_launch(void* const* d_in, const int* in_sizes, int n_in, void* d_out, int out_size, void* d_ws, size_t ws_size, hipStream_t stream) {
    static int grid = 0;
    if (grid == 0) {
        if (n_in != 33 || (size_t)out_size != O_END || ws_size < WS_END) { fprintf(stderr, "kernel_launch: unexpected sizes: n_in %d out %d ws %zu (need %zu)\n", n_in, out_size, ws_size, (size_t)WS_END); grid = -1; return; }
        int dev = 0, cus = 0, per_cu = 0;
        if (hipGetDevice(&dev) != hipSuccess || hipDeviceGetAttribute(&cus, hipDeviceAttributeMultiprocessorCount, dev) != hipSuccess) { grid = -1; return; }
        if (hipFuncSetAttribute((const void*)fwd, hipFuncAttributeMaxDynamicSharedMemorySize, LDS_BYTES) != hipSuccess) { fprintf(stderr, "kernel_launch: hipFuncSetAttribute failed\n"); grid = -1; return; }
        if (hipOccupancyMaxActiveBlocksPerMultiprocessor(&per_cu, (const void*)fwd, NWAVES * 64, LDS_BYTES) != hipSuccess || per_cu < 1) { fprintf(stderr, "kernel_launch: occupancy query says %d\n", per_cu); }
        (void)hipGetLastError();
        grid = cus;
    }
    if (grid < 0) return;
    (void)hipMemsetAsync((char*)d_ws + WS_CTL, 0, CTL_ZERO_BYTES, stream);
    Args a{};
    for (int i = 0; i < 33; ++i) a.in.p[i] = (const float*)d_in[i];
    a.out = (float*)d_out; a.ws = (unsigned char*)d_ws;
#if MK_ONE_LAUNCH
    a.ph_lo = 0; a.ph_hi = N_PHASES;
    hipLaunchKernelGGL(fwd, dim3(grid), dim3(NWAVES * 64), LDS_BYTES, stream, a);
#else
    for (int ph = 0; ph < N_PHASES; ++ph) { a.ph_lo = ph; a.ph_hi = ph + 1; hipLaunchKernelGGL(fwd, dim3(grid), dim3(NWAVES * 64), LDS_BYTES, stream, a); }
#endif
}
```

```cpp
#include <hip/hip_runtime.h>
#include <cstdio>
#include <cstdint>
namespace pg8 {
#define PG8_LAS __attribute__((address_space(3)))
typedef unsigned short bf16_t;
typedef short bf16x8 __attribute__((ext_vector_type(8)));
typedef float f32x4 __attribute__((ext_vector_type(4)));
typedef float f32x2 __attribute__((ext_vector_type(2)));
typedef unsigned u32x4 __attribute__((ext_vector_type(4)));
typedef unsigned u32x2 __attribute__((ext_vector_type(2)));
constexpr int BM = 256, BK = 64, HALF = 128, HTB = HALF * BK * 2  , STAGE_BYTES = 8 * HTB, NXCD = 8, WGM = 8;

__host__ __device__ __forceinline__ int lds_byte(int r, int c) { const int st = (r >> 4) * 2 + (c >> 5), rr = r & 15, cc = c & 31, ob = rr * 64 + cc * 2; return st * 1024 + (ob ^ (((ob >> 9) & 1) << 5)); }
__host__ __device__ __forceinline__ void stage_rc(int b, int& R, int& C) { const int st = b / 1024, sb = b % 1024, swz = sb ^ (((sb >> 9) & 1) << 5); R = (st >> 1) * 16 + swz / 64; C = (st & 1) * 32 + (swz % 64) / 2; }
__host__ __device__ __forceinline__ int perm32(int rho) { const int n = rho >> 4, i = rho & 15; return 8 * (i >> 2) + 4 * n + (i & 3); }

struct Unit { int pm, pn; };
struct Gemm { const bf16_t* A; const bf16_t* Bt; int M, N, K; size_t a_sel_bytes; };

struct StaticOrder {
    int nM, nN, nwg, G, c;
    __host__ __device__ __forceinline__ void init(int M, int N, int G_, int c_) { nM = M / BM; nN = N / BM; nwg = nM * nN; G = G_; c = c_; }
    __host__ __device__ __forceinline__ bool next(int i, Unit& u) const {
        const long L = (long)i * G + c; if (L >= nwg) return false;
        int wgid = (int)L; { const int q = nwg / NXCD, r = nwg % NXCD, xcd = wgid % NXCD, off = wgid / NXCD; wgid = (xcd < r ? xcd * (q + 1) : r * (q + 1) + (xcd - r) * q) + off; }
        const int nig = WGM * nN, gid = wgid / nig, fm = gid * WGM, gsz = (nM - fm) < WGM ? (nM - fm) : WGM;
        u.pm = fm + ((wgid % nig) % gsz); u.pn = (wgid % nig) / gsz; return true;
    }
    __device__ __forceinline__ void a_ready(const Unit&) const {}
    __device__ __forceinline__ void done(const Unit&) const {}
};

__device__ __forceinline__ unsigned cvt_pk_bf16(float lo, float hi) { unsigned r; asm volatile("v_cvt_pk_bf16_f32 %0, %1, %2" : "=v"(r) : "v"(lo), "v"(hi)); return r; }
__device__ __forceinline__ float fast_tanh(float x) { return 1.0f - 2.0f / (1.0f + __expf(2.0f * x)); }
__device__ __forceinline__ float fast_sigmoid(float x) { return 1.0f / (1.0f + __expf(-x)); }

struct EpiF32 {
    static constexpr bool PERM = false, AFTER_DRAIN = false;
    static __device__ __forceinline__ int asel(int) { return 0; }
    float* C; int ldc;
    __device__ __forceinline__ void operator()(const f32x4 (&acc)[2][2][4][2], const Unit& u, int wr, int wc, int fr, int fq) const {
        const int row0 = u.pm * BM + wr * 64 + fr, col0 = u.pn * BM + wc * 32 + 4 * fq;
#pragma unroll
        for (int ai = 0; ai < 2; ++ai)
#pragma unroll
            for (int m = 0; m < 4; ++m) { float* rowp = C + (size_t)(row0 + ai * HALF + m * 16) * ldc + col0;
#pragma unroll
                for (int bj = 0; bj < 2; ++bj)
#pragma unroll
                    for (int n = 0; n < 2; ++n) *(f32x4*)(rowp + bj * HALF + n * 16) = acc[ai][bj][m][n]; }
    }
};
struct EpiBf16 {
    static constexpr bool PERM = true, AFTER_DRAIN = false;
    static __device__ __forceinline__ int asel(int) { return 0; }
    bf16_t* O; int ldc;
    __device__ __forceinline__ void operator()(const f32x4 (&acc)[2][2][4][2], const Unit& u, int wr, int wc, int fr, int fq) const {
        const int row0 = u.pm * BM + wr * 64 + fr, col0 = u.pn * BM + wc * 32 + 8 * fq;
#pragma unroll
        for (int ai = 0; ai < 2; ++ai)
#pragma unroll
            for (int m = 0; m < 4; ++m) { bf16_t* rowp = O + (size_t)(row0 + ai * HALF + m * 16) * ldc + col0;
#pragma unroll
                for (int bj = 0; bj < 2; ++bj) { const f32x4 v0 = acc[ai][bj][m][0], v1 = acc[ai][bj][m][1];
                    u32x4 w; w.x = cvt_pk_bf16(v0[0], v0[1]); w.y = cvt_pk_bf16(v0[2], v0[3]); w.z = cvt_pk_bf16(v1[0], v1[1]); w.w = cvt_pk_bf16(v1[2], v1[3]);
                    *(u32x4*)(rowp + bj * HALF) = w; } }
    }
};
constexpr size_t RKV_STRIDE = (size_t)17408 * 1024;
struct EpiG1 {
    static constexpr bool PERM = false, AFTER_DRAIN = false;
    static __device__ __forceinline__ int asel(int pn) { return pn < 12 ? (pn >> 2) : pn - 9; }
    float* RKV; bf16_t* L2A;
    __device__ __forceinline__ void operator()(const f32x4 (&acc)[2][2][4][2], const Unit& u, int wr, int wc, int fr, int fq) const {
        const int row0 = u.pm * BM + wr * 64 + fr;
        if (u.pn < 12) {
            float* base = RKV + (size_t)(u.pn >> 2) * RKV_STRIDE; const int col0 = (u.pn & 3) * BM + wc * 32 + 4 * fq;
#pragma unroll
            for (int ai = 0; ai < 2; ++ai)
#pragma unroll
                for (int m = 0; m < 4; ++m) { float* rowp = base + (size_t)(row0 + ai * HALF + m * 16) * 1024 + col0;
#pragma unroll
                    for (int bj = 0; bj < 2; ++bj)
#pragma unroll
                        for (int n = 0; n < 2; ++n) *(f32x4*)(rowp + bj * HALF + n * 16) = acc[ai][bj][m][n]; }
        } else {
            const int mode = u.pn - 12, cbase = mode == 0 ? 0 : (mode == 1 ? 64 : 128);
#pragma unroll
            for (int ai = 0; ai < 2; ++ai)
#pragma unroll
                for (int m = 0; m < 4; ++m) { bf16_t* rowp = L2A + (size_t)(row0 + ai * HALF + m * 16) * 384 + cbase;
#pragma unroll
                    for (int bj = 0; bj < 2; ++bj)
#pragma unroll
                        for (int n = 0; n < 2; ++n) { const int lc = bj * HALF + wc * 32 + n * 16 + 4 * fq;
                            if (mode < 2 && lc >= 64) continue;
                            f32x4 v = acc[ai][bj][m][n];
                            if (mode == 0) { v[0] = fast_tanh(v[0]); v[1] = fast_tanh(v[1]); v[2] = fast_tanh(v[2]); v[3] = fast_tanh(v[3]); }
                            if (mode == 2) { v[0] = fast_sigmoid(v[0]); v[1] = fast_sigmoid(v[1]); v[2] = fast_sigmoid(v[2]); v[3] = fast_sigmoid(v[3]); }
                            u32x2 w; w.x = cvt_pk_bf16(v[0], v[1]); w.y = cvt_pk_bf16(v[2], v[3]); *(u32x2*)(rowp + lc) = w; } }
        }
    }
};
struct EpiL2 {
    static constexpr bool PERM = false, AFTER_DRAIN = false;
    static __device__ __forceinline__ int asel(int) { return 0; }
    float* DAG; const float* w0; const float* a0;
    __device__ __forceinline__ void operator()(const f32x4 (&acc)[2][2][4][2], const Unit& u, int wr, int wc, int fr, int fq) const {
        const int row0 = u.pm * BM + wr * 64 + fr, mode = u.pn >> 2, col0 = (u.pn & 3) * BM + wc * 32 + 4 * fq;
        float* base = DAG + (size_t)mode * RKV_STRIDE + (size_t)row0 * 1024 + col0;
        if (mode == 0) {
#pragma unroll
            for (int bj = 0; bj < 2; ++bj)
#pragma unroll
                for (int n = 0; n < 2; ++n) { const f32x4 bv = *(const f32x4*)(w0 + col0 + bj * HALF + n * 16);
#pragma unroll
                    for (int ai = 0; ai < 2; ++ai)
#pragma unroll
                        for (int m = 0; m < 4; ++m) { f32x4 v = acc[ai][bj][m][n] + bv;
#pragma unroll
                            for (int j = 0; j < 4; ++j) { const float z = v[j], sp = fmaxf(-z, 0.f) + __logf(1.0f + __expf(-fabsf(z))); v[j] = __expf(-__expf(-sp - 0.5f)); }
                            *(f32x4*)(base + (size_t)(ai * HALF + m * 16) * 1024 + bj * HALF + n * 16) = v; } }
        } else if (mode == 1) {
#pragma unroll
            for (int bj = 0; bj < 2; ++bj)
#pragma unroll
                for (int n = 0; n < 2; ++n) { const f32x4 bv = *(const f32x4*)(a0 + col0 + bj * HALF + n * 16);
#pragma unroll
                    for (int ai = 0; ai < 2; ++ai)
#pragma unroll
                        for (int m = 0; m < 4; ++m) { f32x4 v = acc[ai][bj][m][n] + bv;
#pragma unroll
                            for (int j = 0; j < 4; ++j) v[j] = fast_sigmoid(v[j]);
                            *(f32x4*)(base + (size_t)(ai * HALF + m * 16) * 1024 + bj * HALF + n * 16) = v; } }
        } else {
#pragma unroll
            for (int ai = 0; ai < 2; ++ai)
#pragma unroll
                for (int m = 0; m < 4; ++m)
#pragma unroll
                    for (int bj = 0; bj < 2; ++bj)
#pragma unroll
                        for (int n = 0; n < 2; ++n) *(f32x4*)(base + (size_t)(ai * HALF + m * 16) * 1024 + bj * HALF + n * 16) = acc[ai][bj][m][n];
        }
    }
};
constexpr int EX_FLOATS_PER_BLK = 2 * 2 * 128;
__device__ __forceinline__ float gelu_tanh_f(float x) { const float u = 0.7978845608028654f * (x + 0.044715f * x * x * x); return 0.5f * x * (1.0f + fast_tanh(u)); }
#define PG8_ROR(x, n) __builtin_bit_cast(float, __builtin_amdgcn_mov_dpp(__builtin_bit_cast(int, (x)), 0x120 + (n), 0xF, 0xF, false))
struct EpiConv {
    static constexpr bool PERM = true, AFTER_DRAIN = false;
    static __device__ __forceinline__ int asel(int) { return 0; }
    bf16_t* ACT; float* HALO; float* RAWS; float* pconv; float* sconv; const float* cw; const float* cb; PG8_LAS float* X;
    __device__ __forceinline__ void operator()(f32x4 (&acc)[2][2][4][2], const Unit& u, int wr, int wc, int fr, int fq) const {
        constexpr int FFc = 2816, F2c = 5632, MPc = 16384;
        const int lcb = wc * 32 + 8 * fq, cg = u.pn * 128 + lcb;
        if (fr >= 14) {
#pragma unroll
            for (int ai = 0; ai < 2; ++ai)
#pragma unroll
                for (int bj = 0; bj < 2; ++bj)
#pragma unroll
                    for (int n = 0; n < 2; ++n) *(PG8_LAS f32x4*)(X + (ai * 2 + wr) * EX_FLOATS_PER_BLK + ((fr - 14) * 2 + bj) * 128 + lcb + 4 * n) = acc[ai][bj][3][n];
        }
        asm volatile("s_waitcnt lgkmcnt(0)" ::: "memory"); __builtin_amdgcn_s_barrier(); asm volatile("" ::: "memory");
        const int row0 = u.pm * BM + wr * 64 + fr;
        if (u.pm >= 64) {
            const int t = fr & 7;
            if (t < 2 || t >= 6) {
#pragma unroll
                for (int ai = 0; ai < 2; ++ai)
#pragma unroll
                    for (int m = 0; m < 4; ++m) { const int rs = row0 + ai * HALF + m * 16 - MPc; float* dst = t < 2 ? RAWS + (size_t)rs * F2c : sconv + ((size_t)(rs >> 3) * 2 + (t - 6)) * F2c;
#pragma unroll
                        for (int bj = 0; bj < 2; ++bj)
#pragma unroll
                            for (int n = 0; n < 2; ++n) *(f32x4*)(dst + bj * FFc + cg + 4 * n) = acc[ai][bj][m][n]; }
            }
        } else {
            if (wr == 0 && fr < 2) {
#pragma unroll
                for (int bj = 0; bj < 2; ++bj)
#pragma unroll
                    for (int n = 0; n < 2; ++n) *(f32x4*)(HALO + ((size_t)u.pm * 4 + fr) * F2c + bj * FFc + cg + 4 * n) = acc[0][bj][0][n]; }
            if (wr == 1 && fr >= 14) {
#pragma unroll
                for (int bj = 0; bj < 2; ++bj)
#pragma unroll
                    for (int n = 0; n < 2; ++n) { *(f32x4*)(HALO + ((size_t)u.pm * 4 + fr - 12) * F2c + bj * FFc + cg + 4 * n) = acc[1][bj][3][n];
                        if ((u.pm & 7) == 7) *(f32x4*)(pconv + ((size_t)(u.pm >> 3) * 2 + (fr - 14)) * F2c + bj * FFc + cg + 4 * n) = acc[1][bj][3][n]; } }
        }
        asm volatile("" ::: "memory"); __builtin_amdgcn_sched_barrier(0);
#pragma unroll
        for (int n = 0; n < 2; ++n)
#pragma unroll
            for (int s = 0; s < 2; ++s) {
                const int c = s * FFc + cg + 4 * n;
                const f32x4 bb = *(const f32x4*)(cb + c), w0 = *(const f32x4*)(cw + c), w1 = *(const f32x4*)(cw + F2c + c), w2 = *(const f32x4*)(cw + 2 * F2c + c);
#pragma unroll
                for (int ai = 0; ai < 2; ++ai) {
                    const int pblk = wr == 1 ? ai * 2 : 1; const bool has_prev = (wr == 1 || ai == 1);
                    f32x4 e1 = *(const PG8_LAS f32x4*)(X + pblk * EX_FLOATS_PER_BLK + (1 * 2 + s) * 128 + lcb + 4 * n), e2 = *(const PG8_LAS f32x4*)(X + pblk * EX_FLOATS_PER_BLK + (0 * 2 + s) * 128 + lcb + 4 * n);
                    if (!has_prev) { e1 = (f32x4){0.f, 0.f, 0.f, 0.f}; e2 = e1; }
                    f32x4 p1, p2;
#pragma unroll
                    for (int m = 0; m < 4; ++m) {
                        const f32x4 a = acc[ai][s][m][n]; f32x4 r1, r2, h1, h2;
                        asm volatile("s_nop 1\n\tv_mov_b32_dpp %0, %8 row_ror:1 row_mask:0xf bank_mask:0xf\n\tv_mov_b32_dpp %1, %9 row_ror:1 row_mask:0xf bank_mask:0xf\n\tv_mov_b32_dpp %2, %10 row_ror:1 row_mask:0xf bank_mask:0xf\n\tv_mov_b32_dpp %3, %11 row_ror:1 row_mask:0xf bank_mask:0xf\n\t"
                                     "v_mov_b32_dpp %4, %8 row_ror:2 row_mask:0xf bank_mask:0xf\n\tv_mov_b32_dpp %5, %9 row_ror:2 row_mask:0xf bank_mask:0xf\n\tv_mov_b32_dpp %6, %10 row_ror:2 row_mask:0xf bank_mask:0xf\n\tv_mov_b32_dpp %7, %11 row_ror:2 row_mask:0xf bank_mask:0xf"
                                     : "=&v"(r1[0]), "=&v"(r1[1]), "=&v"(r1[2]), "=&v"(r1[3]), "=&v"(r2[0]), "=&v"(r2[1]), "=&v"(r2[2]), "=&v"(r2[3]) : "v"(a[0]), "v"(a[1]), "v"(a[2]), "v"(a[3]));
                        if (m == 0) { h1 = fr >= 1 ? r1 : e1; h2 = fr >= 2 ? r2 : (fr == 0 ? e2 : e1); }
                        else { h1 = fr >= 1 ? r1 : p1; h2 = fr >= 2 ? r2 : p2; }
                        p1 = r1; p2 = r2;
                        acc[ai][s][m][n] = bb + w0 * h2 + w1 * h1 + w2 * a;
                        __builtin_amdgcn_sched_barrier(0);
                    }
                }
                asm volatile("" ::: "memory"); __builtin_amdgcn_sched_barrier(0);
            }
#pragma unroll
        for (int ai = 0; ai < 2; ++ai)
#pragma unroll
            for (int m = 0; m < 4; ++m) { const int row = row0 + ai * HALF + m * 16; u32x4 o;
                { const f32x4 g = acc[ai][0][m][0], v = acc[ai][1][m][0]; o.x = cvt_pk_bf16(gelu_tanh_f(g[0]) * v[0], gelu_tanh_f(g[1]) * v[1]); o.y = cvt_pk_bf16(gelu_tanh_f(g[2]) * v[2], gelu_tanh_f(g[3]) * v[3]); }
                { const f32x4 g = acc[ai][0][m][1], v = acc[ai][1][m][1]; o.z = cvt_pk_bf16(gelu_tanh_f(g[0]) * v[0], gelu_tanh_f(g[1]) * v[1]); o.w = cvt_pk_bf16(gelu_tanh_f(g[2]) * v[2], gelu_tanh_f(g[3]) * v[3]); }
                *(u32x4*)(ACT + (size_t)row * FFc + cg) = o; }
    }
};
template <class Epi, class Sched, bool ALIGN_EPI = false, bool SP2 = false>
__device__ __forceinline__ void gemm_phase(PG8_LAS unsigned char* lds, const Gemm g, const Sched& S, const Epi& E) {
    const int tid = threadIdx.x, wid = __builtin_amdgcn_readfirstlane(tid >> 6), lane = tid & 63, wr = wid >> 2, wc = wid & 3, fr = lane & 15, fq = lane >> 4;
    int K = g.K; asm volatile("" : "+s"(K));
    const int nt = K / BK;
    unsigned voffA[2], voffB[2];
#pragma unroll
    for (int i = 0; i < 2; ++i) { int R, C; stage_rc(tid * 16 + i * 8192, R, C); const int Rb = Epi::PERM ? ((R & ~31) + perm32(R & 31)) : R;
        voffA[i] = (unsigned)(R * K + C) * 2u; voffB[i] = (unsigned)(Rb * K + C) * 2u; }
    const size_t kstep = (size_t)(BK * 2);
    const size_t hstep = (size_t)HALF * K * 2;
    const size_t tstep = 2 * hstep;
    const unsigned ldsw = (unsigned)wid * 1024u;
    const int aoff = lds_byte(wr * 64 + fr, fq * 8), boff = lds_byte(wc * 32 + fr, fq * 8);
#define PG8_SA(b, h) (((b) * 2 + (h)) * HTB)
#define PG8_SB(b, h) ((4 + (b) * 2 + (h)) * HTB)
#define PG8_STAGE(bufoff, gbase, voff) do { _Pragma("unroll") for (int _i = 0; _i < 2; ++_i) \
        __builtin_amdgcn_global_load_lds((const unsigned*)((const char*)(gbase) + (voff)[_i]), (PG8_LAS unsigned*)(lds + (bufoff) + ldsw + _i * 8192), 16, 0, 0); } while (0)
#define PG8_LDA(dst, b, h) do { _Pragma("unroll") for (int m = 0; m < 4; ++m) _Pragma("unroll") for (int k = 0; k < 2; ++k) dst[m][k] = *(const PG8_LAS bf16x8*)(lds + PG8_SA(b, h) + aoff + m * 2048 + k * 1024); } while (0)
#define PG8_LDB(dst, b, h) do { _Pragma("unroll") for (int n = 0; n < 2; ++n) _Pragma("unroll") for (int k = 0; k < 2; ++k) dst[n][k] = *(const PG8_LAS bf16x8*)(lds + PG8_SB(b, h) + boff + n * 2048 + k * 1024); } while (0)
#define PG8_MMA(ai, bj, At, Bt) do { __builtin_amdgcn_s_setprio(1); _Pragma("unroll") for (int m = 0; m < 4; ++m) _Pragma("unroll") for (int n = 0; n < 2; ++n) _Pragma("unroll") for (int k = 0; k < 2; ++k) \
        acc[ai][bj][m][n] = __builtin_amdgcn_mfma_f32_16x16x32_bf16(Bt[n][k], At[m][k], acc[ai][bj][m][n], 0, 0, 0); __builtin_amdgcn_s_setprio(0); } while (0)
#define PG8_WAIT_V(n) asm volatile("s_waitcnt vmcnt(" #n ")" ::: "memory")
#define PG8_WAIT_L(n) asm volatile("s_waitcnt lgkmcnt(" #n ")" ::: "memory")
#define PG8_BAR __builtin_amdgcn_s_barrier()
#define PG8_SCHED __builtin_amdgcn_sched_barrier(0)
    Unit cur, nxt; int ui = 0;
    if (!S.next(0, cur)) return;
    f32x4 acc[2][2][4][2];
#pragma unroll
    for (int a = 0; a < 2; ++a)
#pragma unroll
        for (int b = 0; b < 2; ++b)
#pragma unroll
            for (int m = 0; m < 4; ++m)
#pragma unroll
                for (int n = 0; n < 2; ++n) acc[a][b][m][n] = (f32x4){0.f, 0.f, 0.f, 0.f};
    bf16x8 At[4][2], B0[2][2], B1[2][2];
    const char* cA = (const char*)g.A + (size_t)Epi::asel(cur.pn) * g.a_sel_bytes + (size_t)cur.pm * tstep; const char* cB = (const char*)g.Bt + (size_t)cur.pn * tstep;
    S.a_ready(cur);
    if constexpr (SP2) {
        PG8_STAGE(PG8_SB(0, 0), cB, voffB); PG8_STAGE(PG8_SB(0, 1), cB + hstep, voffB); PG8_STAGE(PG8_SA(0, 0), cA, voffA); PG8_STAGE(PG8_SA(0, 1), cA + hstep, voffA);
        if (wr == 1) PG8_BAR;
        PG8_WAIT_V(2); PG8_BAR;
        PG8_STAGE(PG8_SB(1, 0), cB + kstep, voffB); PG8_STAGE(PG8_SA(1, 0), cA + kstep, voffA); PG8_STAGE(PG8_SB(1, 1), cB + hstep + kstep, voffB);
        PG8_WAIT_V(6); PG8_BAR;
    } else {
        PG8_STAGE(PG8_SB(0, 0), cB, voffB); PG8_STAGE(PG8_SA(0, 0), cA, voffA); PG8_STAGE(PG8_SB(0, 1), cB + hstep, voffB); PG8_STAGE(PG8_SA(0, 1), cA + hstep, voffA);
        if (wr == 1) PG8_BAR;
        PG8_WAIT_V(4); PG8_BAR;
        PG8_STAGE(PG8_SB(1, 0), cB + kstep, voffB); PG8_STAGE(PG8_SA(1, 0), cA + kstep, voffA); PG8_STAGE(PG8_SB(1, 1), cB + hstep + kstep, voffB);
        PG8_WAIT_V(6); PG8_BAR;
    }
    for (;;) {
        const bool has_next = S.next(ui + 1, nxt);
        const char* nA = has_next ? (const char*)g.A + (size_t)Epi::asel(nxt.pn) * g.a_sel_bytes + (size_t)nxt.pm * tstep : cA; const char* nB = has_next ? (const char*)g.Bt + (size_t)nxt.pn * tstep : cB;
        for (int t = 0; t < nt; t += 2) {
            const bool last = (t == nt - 2);
            const char* a1 = cA + (size_t)(t + 1) * kstep;
            const char* a2 = last ? nA : cA + (size_t)(t + 2) * kstep; const char* b2 = last ? nB : cB + (size_t)(t + 2) * kstep;
            const char* a3 = a2 + kstep; const char* b3 = b2 + kstep;
            if (last && has_next) S.a_ready(nxt);
            if constexpr (SP2) {
            PG8_LDB(B0, 0, 0); PG8_LDB(B1, 0, 1); PG8_SCHED; PG8_LDA(At, 0, 0); PG8_STAGE(PG8_SA(1, 1), a1 + hstep, voffA);
            PG8_WAIT_V(8); PG8_WAIT_L(0); PG8_BAR; PG8_MMA(0, 0, At, B0); PG8_MMA(0, 1, At, B1); PG8_BAR; PG8_SCHED;
            PG8_LDA(At, 0, 1); PG8_STAGE(PG8_SB(0, 0), b2, voffB); PG8_STAGE(PG8_SB(0, 1), b2 + hstep, voffB); PG8_STAGE(PG8_SA(0, 0), a2, voffA);
            PG8_WAIT_V(8); PG8_WAIT_L(0); PG8_BAR; PG8_MMA(1, 0, At, B0); PG8_MMA(1, 1, At, B1); PG8_BAR; PG8_SCHED;
            PG8_LDB(B0, 1, 0); PG8_LDB(B1, 1, 1); PG8_SCHED; PG8_LDA(At, 1, 0); PG8_STAGE(PG8_SA(0, 1), a2 + hstep, voffA);
            PG8_WAIT_V(8); PG8_WAIT_L(0); PG8_BAR; PG8_MMA(0, 0, At, B0); PG8_MMA(0, 1, At, B1); PG8_BAR; PG8_SCHED;
            PG8_LDA(At, 1, 1); PG8_STAGE(PG8_SB(1, 0), b3, voffB); PG8_STAGE(PG8_SB(1, 1), b3 + hstep, voffB); PG8_STAGE(PG8_SA(1, 0), a3, voffA);
            PG8_WAIT_V(8); PG8_WAIT_L(0); PG8_BAR; PG8_MMA(1, 0, At, B0); PG8_MMA(1, 1, At, B1); PG8_BAR; PG8_SCHED;
            } else {
            PG8_LDB(B0, 0, 0); PG8_SCHED; PG8_LDA(At, 0, 0); PG8_STAGE(PG8_SA(1, 1), a1 + hstep, voffA);
            PG8_WAIT_L(8); PG8_BAR; PG8_WAIT_L(0); PG8_MMA(0, 0, At, B0); PG8_BAR; PG8_SCHED;
            PG8_LDB(B1, 0, 1); PG8_STAGE(PG8_SB(0, 0), b2, voffB);
            PG8_BAR; PG8_WAIT_L(0); PG8_MMA(0, 1, At, B1); PG8_BAR;
            PG8_LDA(At, 0, 1); PG8_STAGE(PG8_SA(0, 0), a2, voffA);
            PG8_BAR; PG8_WAIT_L(0); PG8_MMA(1, 0, At, B0); PG8_BAR; PG8_SCHED;
            PG8_STAGE(PG8_SB(0, 1), b2 + hstep, voffB);
            PG8_WAIT_V(6); PG8_BAR; PG8_MMA(1, 1, At, B1); PG8_BAR;
            PG8_LDB(B0, 1, 0); PG8_SCHED; PG8_LDA(At, 1, 0); PG8_STAGE(PG8_SA(0, 1), a2 + hstep, voffA);
            PG8_WAIT_L(8); PG8_BAR; PG8_WAIT_L(0); PG8_MMA(0, 0, At, B0); PG8_BAR; PG8_SCHED;
            PG8_LDB(B1, 1, 1); PG8_STAGE(PG8_SB(1, 0), b3, voffB);
            PG8_BAR; PG8_WAIT_L(0); PG8_MMA(0, 1, At, B1); PG8_BAR;
            PG8_LDA(At, 1, 1); PG8_STAGE(PG8_SA(1, 0), a3, voffA);
            PG8_BAR; PG8_WAIT_L(0); PG8_MMA(1, 0, At, B0); PG8_BAR; PG8_SCHED;
            PG8_STAGE(PG8_SB(1, 1), b3 + hstep, voffB);
            PG8_WAIT_V(6); PG8_BAR; PG8_MMA(1, 1, At, B1); PG8_BAR;
            }
        }
        if constexpr (ALIGN_EPI) { if (wr == 0) PG8_BAR; }
        if constexpr (!Epi::AFTER_DRAIN) { E(acc, cur, wr, wc, fr, fq); S.done(cur); }
        if (!has_next) break;
#pragma unroll
        for (int a = 0; a < 2; ++a)
#pragma unroll
            for (int b = 0; b < 2; ++b)
#pragma unroll
                for (int m = 0; m < 4; ++m)
#pragma unroll
                    for (int n = 0; n < 2; ++n) acc[a][b][m][n] = (f32x4){0.f, 0.f, 0.f, 0.f};
        cur = nxt; cA = nA; cB = nB; ++ui;
        if constexpr (ALIGN_EPI) { if (wr == 1) PG8_BAR; }
    }
    PG8_WAIT_V(0);
    if constexpr (!ALIGN_EPI) { if (wr == 0) PG8_BAR; }
    PG8_BAR;
    if constexpr (Epi::AFTER_DRAIN) { E.fused(acc, cur, wr, wc, fr, fq, lds, wid, lane); S.done(cur); }
#undef PG8_SA
#undef PG8_SB
#undef PG8_STAGE
#undef PG8_LDA
#undef PG8_LDB
#undef PG8_MMA
#undef PG8_WAIT_V
#undef PG8_WAIT_L
#undef PG8_BAR
#undef PG8_SCHED
}
}
using pg8::fast_tanh; using pg8::fast_sigmoid;

constexpr int D = 1024, PB = 8, PT = 2048, SBN = 128, STN = 8;
constexpr int MP = PB * PT, MS = SBN * STN, M = MP + MS;
constexpr int RH = 16, FF = 2816, F2 = 5632, AH = 8, AW = 512, NQKV = 4608;
constexpr float NORM_EPS = 1e-6f, GN_EPS = 64e-5f;
constexpr size_t O_YP = 0, O_YS = O_YP + (size_t)MP * D, O_PSHIFT = O_YS + (size_t)MS * D, O_PWKV = O_PSHIFT + (size_t)PB * D,
    O_PKV128 = O_PWKV + (size_t)PB * RH * 64 * 64, O_PKV512 = O_PKV128 + (size_t)PB * 128 * 1024, O_PKV2048 = O_PKV512 + (size_t)PB * 512 * 1024,
    O_PCONV = O_PKV2048 + (size_t)PB * 2048 * 1024, O_SSHIFT = O_PCONV + (size_t)2 * PB * 2 * F2, O_SWKV = O_SSHIFT + (size_t)SBN * D,
    O_SKV128 = O_SWKV + (size_t)SBN * RH * 64 * 64, O_SKV512 = O_SKV128 + (size_t)SBN * 8 * 1024, O_SKV2048 = O_SKV512 + (size_t)SBN * 8 * 1024,
    O_SCONV = O_SKV2048 + (size_t)SBN * 8 * 1024, O_END = O_SCONV + (size_t)2 * SBN * 2 * F2;
static_assert(O_END == 55107584, "output size");
constexpr size_t MiB = 1u << 20;
constexpr size_t WS_CTL = 0, CTL_ZERO_BYTES = 1 * MiB;
constexpr size_t WS_ROPE = 1 * MiB;
constexpr size_t WS_W1CAT = 2 * MiB, WS_WL2 = 10 * MiB, WS_WORW = 13 * MiB, WS_WUP0 = 15 * MiB, WS_WDN0 = 26 * MiB, WS_WQKV = 32 * MiB, WS_WOAT = 41 * MiB, WS_WUP1 = 42 * MiB, WS_WDN1 = 53 * MiB;
constexpr size_t RB16 = (size_t)M * D * 2, RF32 = (size_t)M * D * 4;
constexpr size_t WS_XM = 64 * MiB;
constexpr size_t WS_R = WS_XM + 6 * RB16, WS_K = WS_R + RF32, WS_V = WS_K + RF32, WS_DC = WS_V + RF32, WS_AA = WS_DC + RF32, WS_GG = WS_AA + RF32;
constexpr size_t WS_L2A = WS_GG + RF32;
constexpr size_t WS_Y = WS_L2A + 13 * MiB, WS_BONUS = WS_Y + RF32, WS_YG = WS_BONUS + 2 * MiB, WS_MO = WS_YG + RB16;
constexpr size_t WS_X1 = WS_MO + RF32, WS_X2 = WS_X1 + RF32, WS_X3 = WS_X2 + RF32, WS_XN = WS_X3 + RF32;
constexpr size_t WS_HID = WS_XN + RB16;
constexpr size_t WS_ACT = WS_HID + (size_t)M * F2 * 2;
constexpr size_t WS_QKV = WS_ACT + (size_t)M * FF * 2;
constexpr size_t WS_OG = WS_QKV + (size_t)M * NQKV * 2;
constexpr size_t WS_LSE = WS_OG + (size_t)3 * M * AW * 2;
constexpr size_t WS_OM = WS_LSE + 2 * MiB;
constexpr size_t WS_END = WS_OM + (size_t)M * AW * 2 + MiB;
static_assert(WS_W1CAT + (size_t)3840 * 1024 * 2 <= WS_WL2 && WS_WL2 + (size_t)3072 * 384 * 2 <= WS_WORW && WS_WUP0 + (size_t)F2 * D * 2 <= WS_WDN0 && WS_WDN0 + (size_t)D * FF * 2 <= WS_WQKV &&
              WS_WQKV + (size_t)NQKV * D * 2 <= WS_WOAT && WS_WUP1 + (size_t)F2 * D * 2 <= WS_WDN1 && WS_WDN1 + (size_t)D * FF * 2 <= WS_XM && (size_t)M * 384 * 2 <= 13 * MiB && (size_t)3 * M * 8 * 4 <= 2 * MiB, "ws map");
constexpr int CW_TMO = 0, CW_BAR = 4096;

constexpr int NWAVES = 8;
constexpr int RING_OFF = 0, RING_BYTES = 131072;
constexpr int LDSCTL_OFF = RING_BYTES, MISC_OFF = LDSCTL_OFF + 320;
constexpr int EX_OFF = MISC_OFF + 128;
constexpr int LDS_BYTES = 147456;

#define GAS __attribute__((address_space(1)))
#define LAS __attribute__((address_space(3)))
typedef unsigned short bf16;
typedef unsigned v4u __attribute__((ext_vector_type(4)));
typedef unsigned v2u __attribute__((ext_vector_type(2)));
typedef float f32x4 __attribute__((ext_vector_type(4)));
typedef float f32x2 __attribute__((ext_vector_type(2)));
typedef short bf16x8 __attribute__((ext_vector_type(8)));
typedef GAS unsigned gu32;
#define RLX_AGENT __ATOMIC_RELAXED, __HIP_MEMORY_SCOPE_AGENT
#define LDS_WAIT() asm volatile("s_waitcnt lgkmcnt(0)" ::: "memory")
#define VM_WAIT() asm volatile("s_waitcnt vmcnt(0)" ::: "memory")
__device__ __forceinline__ unsigned f2bf(float f) { unsigned u = __builtin_bit_cast(unsigned, f); return (u + 0x7fffu + ((u >> 16) & 1u)) >> 16; }
__device__ __forceinline__ unsigned pk2(float lo, float hi) { return f2bf(lo) | (f2bf(hi) << 16); }
__device__ __forceinline__ float bflo(unsigned w) { return __builtin_bit_cast(float, w << 16); }
__device__ __forceinline__ float bfhi(unsigned w) { return __builtin_bit_cast(float, w & 0xffff0000u); }
__device__ __forceinline__ float wave_sum(float v) {
#pragma unroll
    for (int o = 1; o < 64; o <<= 1) v += __shfl_xor(v, o);
    return v;
}
#define DPP_F(x, ctrl) __builtin_bit_cast(float, __builtin_amdgcn_mov_dpp(__builtin_bit_cast(int, (x)), (ctrl), 0xF, 0xF, true))
__device__ __forceinline__ float row16_sum(float x) {
    x += DPP_F(x, 0xB1);
    x += DPP_F(x, 0x4E);
    x += DPP_F(x, 0x141);
    x += DPP_F(x, 0x140);
    return x;
}
#define XB_TMO      128
#define XB_XCNT(j)  (256  + 64 * (j))
#define XB_XSUB(j)  (1280 + 64 * (j))
#define XB_XGEN(j)  (2304 + 64 * (j))
#define XB_TOP      3328
#define XB_TOPGEN   3392
#define XCD_BAR_WORDS 3456
#define XB_SPIN_CAP (1u << 18)

__device__ __forceinline__ unsigned xb_ld(unsigned* p)              { return __hip_atomic_load(p, __ATOMIC_RELAXED, __HIP_MEMORY_SCOPE_AGENT); }
__device__ __forceinline__ unsigned xb_add(unsigned* p, unsigned v) { return __hip_atomic_fetch_add(p, v, __ATOMIC_RELAXED, __HIP_MEMORY_SCOPE_AGENT); }
__device__ __forceinline__ unsigned xb_xcc_id() { return (unsigned)__builtin_amdgcn_s_getreg((3 << 11) | 20) & 0xFu; }
#define XB_SPIN(cond, bar) do { unsigned _sp = 0; while (cond) { __builtin_amdgcn_s_sleep(1); \
    if ((++_sp & 255u) == 0u) { if (xb_ld(&(bar)[XB_TMO])) break; if (_sp > XB_SPIN_CAP) { atomicAdd(&(bar)[XB_TMO], 1u); break; } } } } while (0)

struct XcdBarrier {
    unsigned* bar; unsigned x;
    volatile LAS unsigned* st;
};

__device__ __forceinline__ XcdBarrier xcd_barrier_post(unsigned* bar, volatile LAS unsigned* st) {
    XcdBarrier b; b.bar = bar; b.x = xb_xcc_id(); b.st = st;
    if (threadIdx.x == 0) (void)xb_add(&bar[XB_XCNT(b.x)], 1u);
    return b;
}
__device__ __forceinline__ void xcd_barrier_complete(unsigned* bar, unsigned x, unsigned& nloc, unsigned& nx) {
    const unsigned G = gridDim.x * gridDim.y * gridDim.z;
    unsigned sum, cnt, mine, sp = 0u;
    for (;;) {
        sum = 0u; cnt = 0u; mine = 0u;
#pragma unroll
        for (unsigned j = 0; j < 16; ++j) { const unsigned c = xb_ld(&bar[XB_XCNT(j)]); sum += c; cnt += (c > 0u) ? 1u : 0u; mine = (j == x) ? c : mine; }
        if (sum == G) break;
        __builtin_amdgcn_s_sleep(1);
        if ((++sp & 255u) == 0u) { if (xb_ld(&bar[XB_TMO])) break; if (sp > XB_SPIN_CAP) { atomicAdd(&bar[XB_TMO], 1u); break; } }
    }
    nloc = mine > 0u ? mine : 1u; nx = cnt > 0u ? cnt : 1u;
}

__device__ __forceinline__ void xcd_barrier(const XcdBarrier& b) {
    asm volatile("s_waitcnt vmcnt(0)" ::: "memory");
    __syncthreads();
    if (threadIdx.x == 0) {
        unsigned* bar = b.bar;
        __builtin_amdgcn_s_waitcnt(0);
        unsigned nloc = b.st[0], nx = b.st[1];
        if (nloc == 0u) { xcd_barrier_complete(bar, b.x, nloc, nx); b.st[0] = nloc; b.st[1] = nx; }
        const unsigned old = xb_add(&bar[XB_XSUB(b.x)], 1u);
        const unsigned gen = old / nloc;
        if (old + 1u == (gen + 1u) * nloc) {
            __builtin_amdgcn_fence(__ATOMIC_RELEASE, "agent");
            asm volatile("s_waitcnt vmcnt(0)" ::: "memory");
            const unsigned og = xb_add(&bar[XB_TOP], 1u);
            const unsigned tg = og / nx;
            if (og + 1u == (tg + 1u) * nx) xb_add(&bar[XB_TOPGEN], 1u);
            else XB_SPIN(xb_ld(&bar[XB_TOPGEN]) == tg, bar);
            __builtin_amdgcn_fence(__ATOMIC_ACQUIRE, "agent");
            xb_add(&bar[XB_XGEN(b.x)], 1u);
            asm volatile("s_waitcnt vmcnt(0)" ::: "memory");
        } else {
            XB_SPIN(xb_ld(&bar[XB_XGEN(b.x)]) == gen, bar);
            __builtin_amdgcn_fence(__ATOMIC_ACQUIRE, "agent");
            asm volatile("s_waitcnt vmcnt(0)" ::: "memory");
        }
    }
    __syncthreads();
}

struct Ctx { LAS unsigned char* lds; int tid, lane, wave, gw, NGW, G, bid; };

__device__ __forceinline__ void transpose_item(const float* W, int ldw, int Kvalid, bf16* WT, int ldt, int drow0, int dcol0, int k0, int n0, LAS float* scr, int lane) {
#pragma unroll 8
    for (int i = 0; i < 32; ++i) { const int kk = 2 * i + (lane >> 5), k = k0 + kk; scr[kk * 33 + (lane & 31)] = (k < Kvalid) ? W[(size_t)k * ldw + n0 + (lane & 31)] : 0.f; }
    LDS_WAIT(); asm volatile("" ::: "memory");
    const int c = lane & 7;
#pragma unroll
    for (int j = 0; j < 4; ++j) { const int n = (lane >> 3) + 8 * j; const LAS float* s = scr + (8 * c) * 33 + n;
        v4u o; o.x = pk2(s[0 * 33], s[1 * 33]); o.y = pk2(s[2 * 33], s[3 * 33]); o.z = pk2(s[4 * 33], s[5 * 33]); o.w = pk2(s[6 * 33], s[7 * 33]);
        *(GAS v4u*)(WT + (size_t)(drow0 + n) * ldt + dcol0 + 8 * c) = o; }
    LDS_WAIT(); asm volatile("" ::: "memory");
}
template <bool GLU = false> __device__ __forceinline__ void transpose_mat(const Ctx& C, const float* W, int K, int N, bf16* WT, int ldt, int row_off, int& base, LAS float* scr) {
    const int nblk = N / 32, nit = ((K + 63) / 64) * nblk;
    int start = (C.gw - base) % C.NGW; if (start < 0) start += C.NGW;
    for (int it = start; it < nit; it += C.NGW) { const int kb = it / nblk, nb = it % nblk, n0 = 32 * nb;
        const int drow = GLU ? (n0 < FF ? (n0 / 128) * 256 + (n0 % 128) : ((n0 - FF) / 128) * 256 + 128 + ((n0 - FF) % 128)) : n0;
        transpose_item(W, N, K, WT, ldt, row_off + drow, 64 * kb, 64 * kb, n0, scr, C.lane); }
    base += nit;
}
__device__ __forceinline__ void zero_rows(const Ctx& C, bf16* WT, int ldt, int r0, int r1) {
    const size_t n16 = (size_t)(r1 - r0) * ldt / 8; GAS v4u* p = (GAS v4u*)(WT + (size_t)r0 * ldt);
    for (size_t i = (size_t)C.bid * 512 + C.tid; i < n16; i += (size_t)C.G * 512) p[i] = (v4u){0u, 0u, 0u, 0u};
}

struct In { const float* p[33]; };

__device__ __forceinline__ void p0_prologue(const Ctx& C, const In& in, unsigned char* ws, float* out) {
    LAS float* scr = (LAS float*)(C.lds + RING_OFF + C.wave * 16384);
    bf16* W1CAT = (bf16*)(ws + WS_W1CAT); bf16* WL2 = (bf16*)(ws + WS_WL2);
    int base = 0;
    transpose_mat(C, in.p[10], D, D, W1CAT, D, 0, base, scr);
    transpose_mat(C, in.p[11], D, D, W1CAT, D, 1024, base, scr);
    transpose_mat(C, in.p[12], D, D, W1CAT, D, 2048, base, scr);
    transpose_mat(C, in.p[15], D, 64, W1CAT, D, 3072, base, scr);
    transpose_mat(C, in.p[18], D, 64, W1CAT, D, 3328, base, scr);
    transpose_mat(C, in.p[20], D, 160, W1CAT, D, 3584, base, scr);
    transpose_mat(C, in.p[13], D, D, (bf16*)(ws + WS_WORW), D, 0, base, scr);
    transpose_mat<true>(C, in.p[29], D, F2, (bf16*)(ws + WS_WUP0), D, 0, base, scr);
    transpose_mat<true>(C, in.p[29] + (size_t)D * F2, D, F2, (bf16*)(ws + WS_WUP1), D, 0, base, scr);
    transpose_mat(C, in.p[32], FF, D, (bf16*)(ws + WS_WDN0), FF, 0, base, scr);
    transpose_mat(C, in.p[32] + (size_t)FF * D, FF, D, (bf16*)(ws + WS_WDN1), FF, 0, base, scr);
    transpose_mat(C, in.p[27], D, NQKV, (bf16*)(ws + WS_WQKV), D, 0, base, scr);
    transpose_mat(C, in.p[28], AW, D, (bf16*)(ws + WS_WOAT), AW, 0, base, scr);
    zero_rows(C, W1CAT, D, 3072 + 64, 3328); zero_rows(C, W1CAT, D, 3328 + 64, 3584); zero_rows(C, W1CAT, D, 3584 + 160, 3840);
    { const float* w2 = in.p[16]; const float* a2 = in.p[19]; const float* g2 = in.p[21];
      for (int idx = C.bid * 512 + C.tid; idx < 48 * 3072; idx += C.G * 512) { const int kc = idx / 3072, n = idx % 3072, k0 = 8 * kc; float v[8];
#pragma unroll
          for (int j = 0; j < 8; ++j) { const int k = k0 + j; float x = 0.f;
              if (n < 1024) { if (k < 64) x = w2[(size_t)k * D + n]; }
              else if (n < 2048) { if (k >= 64 && k < 128) x = a2[(size_t)(k - 64) * D + (n - 1024)]; }
              else { if (k >= 128 && k < 288) x = g2[(size_t)(k - 128) * D + (n - 2048)]; }
              v[j] = x; }
          v4u o; o.x = pk2(v[0], v[1]); o.y = pk2(v[2], v[3]); o.z = pk2(v[4], v[5]); o.w = pk2(v[6], v[7]);
          *(GAS v4u*)(WL2 + (size_t)n * 384 + k0) = o; } }
    { float* rope = (float*)(ws + WS_ROPE);
      for (int idx = C.bid * 512 + C.tid; idx < 2056 * 8; idx += C.G * 512) { const int pos = idx >> 3, i = idx & 7;
          const double c = i == 0 ? 0.15915494309189535 : i == 1 ? 0.03086376340470123 : i == 2 ? 0.005985185712713705 : i == 3 ? 0.001160663641240061 :
                           i == 4 ? 0.00022507907903927653 : i == 5 ? 4.364795279280289e-05 : i == 6 ? 8.464330808241401e-06 : 1.6414262627950345e-06;
          const double rev = (double)pos * c; const float fr = (float)(rev - __builtin_floor(rev));
          rope[2 * idx] = __builtin_amdgcn_cosf(fr); rope[2 * idx + 1] = __builtin_amdgcn_sinf(fr); } }
    { const float* g0 = in.p[8]; const float* mu = in.p[9]; bf16* XM = (bf16*)(ws + WS_XM);
      for (int m = C.gw; m < M; m += C.NGW) {
          const bool pr = m < MP; const int t = pr ? (m & (PT - 1)) : ((m - MP) & (STN - 1)), b = pr ? (m >> 11) : ((m - MP) >> 3);
          const float* xr = pr ? in.p[0] + (size_t)m * D : in.p[1] + (size_t)(m - MP) * D;
          f32x4 v[4], pv[4]; float ss = 0.f, ps = 0.f;
#pragma unroll
          for (int j = 0; j < 4; ++j) { v[j] = *(const GAS f32x4*)(xr + 4 * C.lane + 256 * j); ss += (v[j].x * v[j].x + v[j].y * v[j].y) + (v[j].z * v[j].z + v[j].w * v[j].w); }
          if (t > 0) {
#pragma unroll
              for (int j = 0; j < 4; ++j) { pv[j] = *(const GAS f32x4*)(xr - D + 4 * C.lane + 256 * j); ps += (pv[j].x * pv[j].x + pv[j].y * pv[j].y) + (pv[j].z * pv[j].z + pv[j].w * pv[j].w); }
          } else {
#pragma unroll
              for (int j = 0; j < 4; ++j) pv[j] = pr ? (f32x4){0.f, 0.f, 0.f, 0.f} : *(const GAS f32x4*)(in.p[2] + (size_t)b * D + 4 * C.lane + 256 * j);
          }
          const float rs = 1.0f / sqrtf(wave_sum(ss) * (1.f / D) + NORM_EPS), prs = 1.0f / sqrtf(wave_sum(ps) * (1.f / D) + NORM_EPS);
          const bool last = pr ? (t == PT - 1) : (t == STN - 1);
#pragma unroll
          for (int j = 0; j < 4; ++j) { const int col = 4 * C.lane + 256 * j; const f32x4 g = *(const GAS f32x4*)(g0 + col);
              const f32x4 hn = v[j] * rs * g; const f32x4 hp = t > 0 ? pv[j] * prs * g : pv[j]; const f32x4 xx = hp - hn;
              if (last) *(GAS f32x4*)(out + (pr ? O_PSHIFT : O_SSHIFT) + (size_t)b * D + col) = hn;
#pragma unroll
              for (int i = 0; i < 6; ++i) { const f32x4 mm = *(const GAS f32x4*)(mu + i * D + col); const f32x4 r = hn + xx * mm;
                  const int slot = i == 1 ? 3 : (i == 2 ? 1 : (i == 3 ? 2 : i));
                  v2u o; o.x = pk2(r.x, r.y); o.y = pk2(r.z, r.w); *(GAS v2u*)(XM + (size_t)slot * M * D + (size_t)m * D + col) = o; } }
      } }
}

constexpr int SC_OPS = 0, SC_OPS_BYTES = 16 * 16 * 20 * 4, SC_VV = 2 * SC_OPS_BYTES, SC_VV_BYTES = 16 * 32 * 4, SC_YB = SC_VV + 2 * SC_VV_BYTES, SC_YB_BYTES = 16 * 32 * 4;
struct ScanItem { size_t tok; int b, h, vh, nt; bool prompt, first, last, valid; };
__device__ __forceinline__ ScanItem scan_item(int q, int bid, int G) {
    ScanItem it; const int npu = (PB * RH * 2 - bid + G - 1) / G, npi = npu > 0 ? npu * 128 : 0;
    if (q < npi) { const int u = bid + (q >> 7) * G, c = q & 127; it.b = u >> 5; it.h = (u >> 1) & 15; it.vh = u & 1; it.tok = (size_t)it.b * PT + 16 * c; it.nt = 16; it.prompt = true; it.first = c == 0; it.last = c == 127; it.valid = true; }
    else { const int su = bid + (q - npi) * G; it.valid = su < SBN * RH * 2; it.b = su >> 5; it.h = (su >> 1) & 15; it.vh = su & 1; it.tok = (size_t)MP + (size_t)it.b * STN; it.nt = 8; it.prompt = false; it.first = true; it.last = true; }
    return it;
}
__device__ __forceinline__ void scan_phase(const Ctx& C, const In& in, unsigned char* ws, float* out) {
    const float* Rb = (const float*)(ws + WS_R); const float* Kb = (const float*)(ws + WS_K); const float* Vb = (const float*)(ws + WS_V);
    const float* Db = (const float*)(ws + WS_DC); const float* Ab = (const float*)(ws + WS_AA); float* Yb = (float*)(ws + WS_Y); float* Bon = (float*)(ws + WS_BONUS);
    const int row = C.tid >> 4, p = C.tid & 15;
    LAS float* OPS = (LAS float*)(C.lds + SC_OPS); LAS float* VV = (LAS float*)(C.lds + SC_VV); LAS float* YB = (LAS float*)(C.lds + SC_YB);
    const bool stg = C.tid < 256, stv = C.tid >= 256 && C.tid < 384; const int vt = (C.tid - 256) >> 3, vq = (C.tid - 256) & 7;
    f32x4 lr, lk, ld, la, lv, Snext; lr = lk = ld = la = lv = Snext = (f32x4){0.f, 0.f, 0.f, 0.f};
#define SC_FETCH(it) do { if ((it).valid) { \
        if (stg && row < (it).nt) { const size_t o = ((it).tok + row) * D + (it).h * 64 + 4 * p; lr = *(const GAS f32x4*)(Rb + o); lk = *(const GAS f32x4*)(Kb + o); ld = *(const GAS f32x4*)(Db + o); la = *(const GAS f32x4*)(Ab + o); } \
        if (stv && vt < (it).nt) lv = *(const GAS f32x4*)(Vb + ((it).tok + vt) * D + (it).h * 64 + 32 * (it).vh + 4 * vq); \
        if ((it).first && !(it).prompt) Snext = *(const GAS f32x4*)(in.p[3] + ((((size_t)(it).b * RH + (it).h) * 64 + 32 * (it).vh + row) * 64 + 4 * p)); } } while (0)
#define SC_STAGE(it, buf) do { if ((it).valid) { \
        if (stg && row < (it).nt) { const int col = (it).h * 64 + 4 * p; const f32x4 ka = *(const GAS f32x4*)(in.p[23] + col), kw = *(const GAS f32x4*)(in.p[22] + col), rk = *(const GAS f32x4*)(in.p[24] + col); \
            const f32x4 kp = lk * (1.0f + (la - 1.0f) * ka), kr = lk * kw; const float n2 = row16_sum((kr.x * kr.x + kr.y * kr.y) + (kr.z * kr.z + kr.w * kr.w)); \
            const f32x4 kn = kr * (1.0f / fmaxf(sqrtf(n2), 1e-12f)); const f32x4 rb = lr * kp * rk; const float bon = row16_sum((rb.x + rb.y) + (rb.z + rb.w)); \
            LAS f32x4* o = (LAS f32x4*)(OPS + (buf) * (SC_OPS_BYTES / 4) + (row * 16 + p) * 20); o[0] = kn; o[1] = ld; o[2] = kp; o[3] = lr; o[4] = kn * la; \
            if ((it).vh == 0 && p == 0) Bon[((it).tok + row) * 16 + (it).h] = bon; } \
        if (stv && vt < (it).nt) *(LAS f32x4*)(VV + (buf) * (SC_VV_BYTES / 4) + vt * 32 + 4 * vq) = lv; } } while (0)
#define SC_STEP(tl) do { const f32x4 kk = op[(tl) * 80 + 0], dd = op[(tl) * 80 + 1], kp = op[(tl) * 80 + 2], rr = op[(tl) * 80 + 3], kka = op[(tl) * 80 + 4]; const float vv = vvp[(tl) * 32]; \
        float sk = (S.x * kk.x + S.y * kk.y) + (S.z * kk.z + S.w * kk.w); sk = row16_sum(sk); \
        S.x = S.x * dd.x + (vv * kp.x - sk * kka.x); S.y = S.y * dd.y + (vv * kp.y - sk * kka.y); S.z = S.z * dd.z + (vv * kp.z - sk * kka.z); S.w = S.w * dd.w + (vv * kp.w - sk * kka.w); \
        float y = (S.x * rr.x + S.y * rr.y) + (S.z * rr.z + S.w * rr.w); y = row16_sum(y); ykeep = (p == (tl)) ? y : ykeep; } while (0)
    ScanItem cur = scan_item(0, C.bid, C.G);
    if (!cur.valid) return;
    SC_FETCH(cur); SC_STAGE(cur, 0);
    f32x4 S = cur.prompt ? (f32x4){0.f, 0.f, 0.f, 0.f} : Snext;
    __syncthreads();
    for (int q = 0; cur.valid; ++q) {
        const int buf = q & 1; const ScanItem nxt = scan_item(q + 1, C.bid, C.G);
        SC_FETCH(nxt);
        float ykeep = 0.f;
        const LAS f32x4* op = (const LAS f32x4*)(OPS + buf * (SC_OPS_BYTES / 4) + p * 20); const LAS float* vvp = VV + buf * (SC_VV_BYTES / 4) + row;
        SC_STEP(0); SC_STEP(1); SC_STEP(2); SC_STEP(3); SC_STEP(4); SC_STEP(5); SC_STEP(6); SC_STEP(7);
        if (cur.nt == 16) { SC_STEP(8); SC_STEP(9); SC_STEP(10); SC_STEP(11); SC_STEP(12); SC_STEP(13); SC_STEP(14); SC_STEP(15); }
        if (p < cur.nt) YB[buf * (SC_YB_BYTES / 4) + p * 32 + row] = ykeep;
        if (cur.last) *(GAS f32x4*)(out + (cur.prompt ? O_PWKV : O_SWKV) + ((((size_t)cur.b * RH + cur.h) * 64 + 32 * cur.vh + row) * 64 + 4 * p)) = S;
        SC_STAGE(nxt, buf ^ 1);
        if (nxt.valid && nxt.first) S = nxt.prompt ? (f32x4){0.f, 0.f, 0.f, 0.f} : Snext;
        __syncthreads();
        { const int tl = C.tid >> 5, rr = C.tid & 31; if (tl < cur.nt) Yb[(cur.tok + tl) * D + cur.h * 64 + 32 * cur.vh + rr] = YB[buf * (SC_YB_BYTES / 4) + tl * 32 + rr]; }
        cur = nxt;
    }
#undef SC_FETCH
#undef SC_STAGE
#undef SC_STEP
}
__device__ __forceinline__ void scan_post_phase(const Ctx& C, const In& in, unsigned char* ws) {
    const float* Yb = (const float*)(ws + WS_Y); const float* Vb = (const float*)(ws + WS_V); const float* Gb = (const float*)(ws + WS_GG); const float* Bon = (const float*)(ws + WS_BONUS);
    bf16* YG = (bf16*)(ws + WS_YG); const float* lg = in.p[25]; const float* lb = in.p[26];
    for (int m = C.gw; m < M; m += C.NGW) {
#pragma unroll
        for (int j = 0; j < 4; ++j) { const int col = 4 * C.lane + 256 * j, head = 4 * j + (C.lane >> 4); const size_t o = (size_t)m * D + col;
            const f32x4 y = *(const GAS f32x4*)(Yb + o); const float mean = row16_sum((y.x + y.y) + (y.z + y.w)) * (1.f / 64.f);
            const f32x4 d = y - mean; const float var = row16_sum((d.x * d.x + d.y * d.y) + (d.z * d.z + d.w * d.w)) * (1.f / 64.f);
            const float rs = 1.0f / sqrtf(var + GN_EPS), bon = Bon[(size_t)m * 16 + head];
            const f32x4 vv = *(const GAS f32x4*)(Vb + o), gg = *(const GAS f32x4*)(Gb + o), g4 = *(const GAS f32x4*)(lg + col), b4 = *(const GAS f32x4*)(lb + col);
            const f32x4 r = (d * rs * g4 + b4 + vv * bon) * gg;
            v2u w; w.x = pk2(r.x, r.y); w.y = pk2(r.z, r.w); *(GAS v2u*)(YG + o) = w; }
    }
}
__device__ __forceinline__ void rowwise_phase(const Ctx& C, const In& in, const float* xin, const float* mo, const float* g1, float* xout, const float* g2, bf16* xn) {
    for (int m = C.gw; m < M; m += C.NGW) {
        const float* xr = xin ? xin + (size_t)m * D : (m < MP ? in.p[0] + (size_t)m * D : in.p[1] + (size_t)(m - MP) * D);
        f32x4 a[4], x[4]; float ss = 0.f;
#pragma unroll
        for (int j = 0; j < 4; ++j) { a[j] = *(const GAS f32x4*)(mo + (size_t)m * D + 4 * C.lane + 256 * j); x[j] = *(const GAS f32x4*)(xr + 4 * C.lane + 256 * j);
            ss += (a[j].x * a[j].x + a[j].y * a[j].y) + (a[j].z * a[j].z + a[j].w * a[j].w); }
        const float rs = 1.0f / sqrtf(wave_sum(ss) * (1.f / D) + NORM_EPS); float s2 = 0.f;
#pragma unroll
        for (int j = 0; j < 4; ++j) { const int col = 4 * C.lane + 256 * j; x[j] = x[j] + a[j] * rs * *(const GAS f32x4*)(g1 + col);
            *(GAS f32x4*)(xout + (size_t)m * D + col) = x[j]; s2 += (x[j].x * x[j].x + x[j].y * x[j].y) + (x[j].z * x[j].z + x[j].w * x[j].w); }
        if (xn) { const float r2 = 1.0f / sqrtf(wave_sum(s2) * (1.f / D) + NORM_EPS);
#pragma unroll
            for (int j = 0; j < 4; ++j) { const int col = 4 * C.lane + 256 * j; const f32x4 r = x[j] * r2 * *(const GAS f32x4*)(g2 + col);
                v2u w; w.x = pk2(r.x, r.y); w.y = pk2(r.z, r.w); *(GAS v2u*)(xn + (size_t)m * D + col) = w; } }
    }
}
__device__ __forceinline__ float gelu_tanh(float x) { const float u = 0.7978845608028654f * (x + 0.044715f * x * x * x); return 0.5f * x * (1.0f + fast_tanh(u)); }
__device__ __forceinline__ void unpack8(const v4u w, float* f) { f[0] = bflo(w.x); f[1] = bfhi(w.x); f[2] = bflo(w.y); f[3] = bfhi(w.y); f[4] = bflo(w.z); f[5] = bfhi(w.z); f[6] = bflo(w.w); f[7] = bfhi(w.w); }
__device__ __forceinline__ void fixup_phase(const Ctx& C, unsigned char* ws, const float* cw, const float* cb, const float* sc) {
    const float* HALO = (const float*)(ws + WS_HID); const float* RAWS = (const float*)(ws + WS_HID + 8 * MiB); bf16* ACT = (bf16*)(ws + WS_ACT);
    constexpr int NC4 = FF / 4, NPROMPT = 56 * 2 * NC4, NSAMPLE = SBN * 2 * NC4;
    for (int idx = C.bid * 512 + C.tid; idx < NPROMPT + NSAMPLE; idx += C.G * 512) {
        const float *p0[2], *p1[2], *p2[2]; int c; size_t orow;
        if (idx < NPROMPT) { const int q = idx / NC4, r = q & 1, pi = q >> 1, pm = (pi / 7) * 8 + 1 + (pi % 7); c = (idx % NC4) * 4; orow = (size_t)pm * 256 + r;
#pragma unroll
            for (int s = 0; s < 2; ++s) { const size_t co = (size_t)s * FF + c; p0[s] = HALO + ((size_t)pm * 4 + r) * F2 + co;
                p1[s] = HALO + (r == 1 ? ((size_t)pm * 4 + 0) : ((size_t)(pm - 1) * 4 + 3)) * F2 + co; p2[s] = HALO + ((size_t)(pm - 1) * 4 + (r == 0 ? 2 : 3)) * F2 + co; }
        } else { const int q = (idx - NPROMPT) / NC4, t = q & 1, b = q >> 1, rs = b * 8 + t; c = ((idx - NPROMPT) % NC4) * 4; orow = (size_t)MP + rs;
#pragma unroll
            for (int s = 0; s < 2; ++s) { const size_t co = (size_t)s * FF + c; p0[s] = RAWS + (size_t)rs * F2 + co;
                p1[s] = t == 0 ? sc + ((size_t)b * 2 + 1) * F2 + co : RAWS + (size_t)(rs - 1) * F2 + co; p2[s] = sc + ((size_t)b * 2 + t) * F2 + co; }
        }
        f32x4 cv[2];
#pragma unroll
        for (int s = 0; s < 2; ++s) { const size_t co = (size_t)s * FF + c; const f32x4 h0 = *(const GAS f32x4*)p0[s], h1 = *(const GAS f32x4*)p1[s], h2 = *(const GAS f32x4*)p2[s];
            cv[s] = *(const GAS f32x4*)(cb + co) + *(const GAS f32x4*)(cw + co) * h2 + *(const GAS f32x4*)(cw + F2 + co) * h1 + *(const GAS f32x4*)(cw + 2 * F2 + co) * h0; }
        v2u o; o.x = pk2(gelu_tanh(cv[0].x) * cv[1].x, gelu_tanh(cv[0].y) * cv[1].y); o.y = pk2(gelu_tanh(cv[0].z) * cv[1].z, gelu_tanh(cv[0].w) * cv[1].w);
        *(GAS v2u*)(ACT + orow * FF + c) = o; }
}

constexpr float QSCALE = 0.125f * 1.4426950408889634f;
__device__ __forceinline__ void rope_phase(const Ctx& C, const In& in, unsigned char* ws, float* out) {
    bf16* QKV = (bf16*)(ws + WS_QKV); const float* rope = (const float*)(ws + WS_ROPE);
    for (int m = C.gw; m < M; m += C.NGW) {
        const bool pr = m < MP; const int t = pr ? (m & (PT - 1)) : ((m - MP) & 7), b = pr ? (m >> 11) : ((m - MP) >> 3), pos = pr ? t : PT + t;
        bf16* rowp = QKV + (size_t)m * NQKV;
        f32x4 cs0 = *(const GAS f32x4*)(rope + (size_t)pos * 16), cs1 = *(const GAS f32x4*)(rope + (size_t)pos * 16 + 4), cs2 = *(const GAS f32x4*)(rope + (size_t)pos * 16 + 8), cs3 = *(const GAS f32x4*)(rope + (size_t)pos * 16 + 12);
        const float cc[8] = {cs0.x, cs0.z, cs1.x, cs1.z, cs2.x, cs2.z, cs3.x, cs3.z}, sn[8] = {cs0.y, cs0.w, cs1.y, cs1.w, cs2.y, cs2.w, cs3.y, cs3.w};
#pragma unroll
        for (int it = 0; it < 9; ++it) {
            const int c8 = C.lane + 64 * it, col0 = 8 * c8, s = col0 / 1536, rem = col0 % 1536, g = rem / 512, h = (rem % 512) / 64, e0 = rem % 64;
            const v4u own = *(const GAS v4u*)(rowp + col0);
            const bool rot = (s < 2) && (e0 < 16);
            v4u par = own; if (rot) par = *(const GAS v4u*)(rowp + col0 + (e0 == 0 ? 8 : -8));
            float x[8], y[8], o[8]; unpack8(own, x); unpack8(par, y);
#pragma unroll
            for (int i = 0; i < 8; ++i) o[i] = !rot ? x[i] : (e0 == 0 ? x[i] * cc[i] - y[i] * sn[i] : x[i] * cc[i] + y[i] * sn[i]);
            if (s == 0) {
#pragma unroll
                for (int i = 0; i < 8; ++i) o[i] *= QSCALE; }
            if (s < 2) { v4u w; w.x = pk2(o[0], o[1]); w.y = pk2(o[2], o[3]); w.z = pk2(o[4], o[5]); w.w = pk2(o[6], o[7]); *(GAS v4u*)(rowp + col0) = w; }
            if (s >= 1) {
                const int L = g == 0 ? 128 : (g == 1 ? 512 : 2048); float* dst = nullptr;
                if (pr) { const int j = t - (PT - L); if (j >= 0) dst = out + (g == 0 ? O_PKV128 : (g == 1 ? O_PKV512 : O_PKV2048)) + ((((size_t)b * L + j) * 2 + (s - 1)) * 8 + h) * 64 + e0; }
                else dst = out + (g == 0 ? O_SKV128 : (g == 1 ? O_SKV512 : O_SKV2048)) + ((((size_t)b * 8 + t) * 2 + (s - 1)) * 8 + h) * 64 + e0;
                if (dst) { *(GAS f32x4*)dst = (f32x4){o[0], o[1], o[2], o[3]}; *(GAS f32x4*)(dst + 4) = (f32x4){o[4], o[5], o[6], o[7]}; } }
        }
    }
}

constexpr int AT_RS = 160;
constexpr int AT_K = 0, AT_V = 256 * AT_RS;
typedef short s16x4 __attribute__((ext_vector_type(4)));
__device__ __forceinline__ s16x4 lds_tr16(const LAS unsigned char* p) { return __builtin_bit_cast(s16x4, __builtin_amdgcn_ds_read_tr16_b64_v4i16((LAS s16x4*)p)); }
struct PUnit { int b, h, g, res, n; };
__device__ __forceinline__ PUnit punit(int u) { PUnit r; const int bh = u / 48, j = u % 48; r.b = bh >> 3; r.h = bh & 7;
    if (j < 16) { r.g = 0; r.res = 0; r.n = j; } else if (j < 32) { r.g = 1; r.res = (j - 16) >> 2; r.n = (j - 16) & 3; } else { r.g = 2; r.res = j - 32; r.n = 0; } return r; }
__device__ __forceinline__ void pattn_load(const Ctx& C, const bf16* QKV, const PUnit& u, v4u (&kr)[4], v4u (&vr)[4]) {
    const int Dl = u.g == 0 ? 1 : (u.g == 1 ? 4 : 16);
#pragma unroll
    for (int i = 0; i < 4; ++i) { const int ch = C.tid + 512 * i, kj = ch >> 3, c = ch & 7; int lk = (u.n - 1) * 128 + kj; lk = lk < 0 ? 0 : lk;
        const bf16* rp = QKV + ((size_t)u.b * PT + u.res + Dl * lk) * NQKV + u.h * 64 + c * 8;
        kr[i] = *(const GAS v4u*)(rp + (3 + u.g) * 512); vr[i] = *(const GAS v4u*)(rp + (6 + u.g) * 512); }
}
__device__ __forceinline__ void pattn_store_lds(const Ctx& C, const v4u (&kr)[4], const v4u (&vr)[4]) {
#pragma unroll
    for (int i = 0; i < 4; ++i) { const int ch = C.tid + 512 * i, kj = ch >> 3, c = ch & 7;
        *(LAS v4u*)(C.lds + AT_K + kj * AT_RS + c * 16) = kr[i]; *(LAS v4u*)(C.lds + AT_V + kj * AT_RS + c * 16) = vr[i]; }
}
__device__ __forceinline__ void pattn_compute(const Ctx& C, unsigned char* ws, const PUnit& u) {
    const bf16* QKV = (const bf16*)(ws + WS_QKV); bf16* OG = (bf16*)(ws + WS_OG); float* LSE = (float*)(ws + WS_LSE);
    const int Dl = u.g == 0 ? 1 : (u.g == 1 ? 4 : 16), q16 = C.lane & 15, g4 = C.lane >> 4, qi = 16 * C.wave + q16;
    const size_t qrow = (size_t)u.b * PT + u.res + Dl * (u.n * 128 + qi);
    const bf16* qp = QKV + qrow * NQKV + u.g * 512 + u.h * 64;
    const bf16x8 qf0 = *(const GAS bf16x8*)(qp + 8 * g4), qf1 = *(const GAS bf16x8*)(qp + 32 + 8 * g4);
    f32x4 sc[16];
    const LAS unsigned char* kbase = C.lds + AT_K + q16 * AT_RS + g4 * 16;
#pragma unroll
    for (int T = 0; T < 16; ++T) { const bf16x8 k0 = *(const LAS bf16x8*)(kbase + T * 16 * AT_RS), k1 = *(const LAS bf16x8*)(kbase + T * 16 * AT_RS + 64);
        f32x4 a = __builtin_amdgcn_mfma_f32_16x16x32_bf16(k0, qf0, (f32x4){0.f, 0.f, 0.f, 0.f}, 0, 0, 0); sc[T] = __builtin_amdgcn_mfma_f32_16x16x32_bf16(k1, qf1, a, 0, 0, 0); }
    const int klo = (u.n == 0 && qi < 128) ? 128 : qi; float mx = -1e30f;
#pragma unroll
    for (int T = 0; T < 16; ++T)
#pragma unroll
        for (int j = 0; j < 4; ++j) { const int kj = 16 * T + 4 * g4 + j; const bool ok = kj >= klo && kj <= qi + 128; sc[T][j] = ok ? sc[T][j] : -1e30f; mx = fmaxf(mx, sc[T][j]); }
    mx = fmaxf(mx, __shfl_xor(mx, 16)); mx = fmaxf(mx, __shfl_xor(mx, 32));
    float sum = 0.f;
#pragma unroll
    for (int T = 0; T < 16; ++T)
#pragma unroll
        for (int j = 0; j < 4; ++j) { const float p = __builtin_amdgcn_exp2f(sc[T][j] - mx); sc[T][j] = p; sum += p; }
    sum += __shfl_xor(sum, 16); sum += __shfl_xor(sum, 32);
    f32x4 oa[4] = {(f32x4){0.f, 0.f, 0.f, 0.f}, (f32x4){0.f, 0.f, 0.f, 0.f}, (f32x4){0.f, 0.f, 0.f, 0.f}, (f32x4){0.f, 0.f, 0.f, 0.f}};
    const LAS unsigned char* vbase = C.lds + AT_V + (4 * g4 + (q16 >> 2)) * AT_RS + (q16 & 3) * 8;
#pragma unroll
    for (int s = 0; s < 8; ++s) {
        pg8::u32x4 pw; pw.x = pg8::cvt_pk_bf16(sc[2 * s][0], sc[2 * s][1]); pw.y = pg8::cvt_pk_bf16(sc[2 * s][2], sc[2 * s][3]); pw.z = pg8::cvt_pk_bf16(sc[2 * s + 1][0], sc[2 * s + 1][1]); pw.w = pg8::cvt_pk_bf16(sc[2 * s + 1][2], sc[2 * s + 1][3]);
        const bf16x8 pf = __builtin_bit_cast(bf16x8, pw);
#pragma unroll
        for (int c = 0; c < 4; ++c) { const s16x4 lo = lds_tr16(vbase + (32 * s) * AT_RS + c * 32), hi = lds_tr16(vbase + (32 * s + 16) * AT_RS + c * 32);
            const bf16x8 vf = (bf16x8){lo[0], lo[1], lo[2], lo[3], hi[0], hi[1], hi[2], hi[3]};
            oa[c] = __builtin_amdgcn_mfma_f32_16x16x32_bf16(vf, pf, oa[c], 0, 0, 0); }
    }
    const float inv = 1.0f / sum;
    bf16* op = OG + ((size_t)u.g * M + qrow) * AW + u.h * 64 + 4 * g4;
#pragma unroll
    for (int c = 0; c < 4; ++c) { v2u w; w.x = pk2(oa[c][0] * inv, oa[c][1] * inv); w.y = pk2(oa[c][2] * inv, oa[c][3] * inv); *(GAS v2u*)(op + 16 * c) = w; }
    if (g4 == 0) LSE[((size_t)u.g * M + qrow) * 8 + u.h] = mx + __builtin_amdgcn_logf(sum);
}
__device__ __forceinline__ void sattn_unit(const Ctx& C, const float* cache_g, unsigned char* ws, const float* out, int b, int g, int h) {
    const bf16* QKV = (const bf16*)(ws + WS_QKV); bf16* OG = (bf16*)(ws + WS_OG); float* LSE = (float*)(ws + WS_LSE);
    const int L = g == 0 ? 128 : (g == 1 ? 512 : 2048), Dl = g == 0 ? 1 : (g == 1 ? 4 : 16), i = C.wave, d16 = C.lane & 15, sub = C.lane >> 4;
    const size_t qrow = (size_t)MP + (size_t)b * 8 + i;
    const v2u qw = *(const GAS v2u*)(QKV + qrow * NQKV + g * 512 + h * 64 + 4 * d16);
    const f32x4 q = (f32x4){bflo(qw.x), bfhi(qw.x), bflo(qw.y), bfhi(qw.y)};
    const float* cache = cache_g + (size_t)b * L * 1024 + h * 64 + 4 * d16;
    const float* fresh = out + (g == 0 ? O_SKV128 : (g == 1 ? O_SKV512 : O_SKV2048)) + (size_t)b * 8 * 1024 + h * 64 + 4 * d16;
    float s[33]; float mx = -1e30f;
#pragma unroll
    for (int it = 0; it < 33; ++it) { const int j = 4 * it + sub; const bool ok = j <= 128; const int idx = L + i - Dl * (ok ? j : 0);
        const float* kp = idx >= L ? fresh + (size_t)(idx - L) * 1024 : cache + (size_t)idx * 1024;
        const f32x4 kv = *(const GAS f32x4*)kp;
        float d = (q.x * kv.x + q.y * kv.y) + (q.z * kv.z + q.w * kv.w); d = row16_sum(d);
        s[it] = ok ? d : -1e30f; mx = fmaxf(mx, s[it]); }
    mx = fmaxf(mx, __shfl_xor(mx, 16)); mx = fmaxf(mx, __shfl_xor(mx, 32));
    float sum = 0.f; f32x4 o = (f32x4){0.f, 0.f, 0.f, 0.f};
#pragma unroll
    for (int it = 0; it < 33; ++it) { const int j = 4 * it + sub; const bool ok = j <= 128; const int idx = L + i - Dl * (ok ? j : 0);
        const float* vp = (idx >= L ? fresh + (size_t)(idx - L) * 1024 : cache + (size_t)idx * 1024) + 512;
        const f32x4 vv = *(const GAS f32x4*)vp; const float p = __builtin_amdgcn_exp2f(s[it] - mx); sum += p; o = o + vv * p; }
    sum += __shfl_xor(sum, 16); sum += __shfl_xor(sum, 32);
#pragma unroll
    for (int e = 0; e < 4; ++e) { o[e] += __shfl_xor(o[e], 16); o[e] += __shfl_xor(o[e], 32); }
    if (sub == 0) { const float inv = 1.0f / sum; v2u w; w.x = pk2(o.x * inv, o.y * inv); w.y = pk2(o.z * inv, o.w * inv);
        *(GAS v2u*)(OG + ((size_t)g * M + qrow) * AW + h * 64 + 4 * d16) = w;
        if (d16 == 0) LSE[((size_t)g * M + qrow) * 8 + h] = mx + __builtin_amdgcn_logf(sum); }
}
typedef const __attribute__((address_space(4))) In* KInP;
__device__ __forceinline__ void attn_phase(const Ctx& C, KInP kp, unsigned char* ws, float* out) {
    const bf16* QKV = (const bf16*)(ws + WS_QKV);
    constexpr int NPU = PB * 8 * 48;
    v4u kr[4], vr[4];
    int u = C.bid;
    if (u < NPU) { const PUnit pu = punit(u); pattn_load(C, QKV, pu, kr, vr); }
    for (; u < NPU; u += C.G) {
        const PUnit pu = punit(u);
        pattn_store_lds(C, kr, vr);
        __syncthreads();
        if (u + C.G < NPU) { const PUnit nu = punit(u + C.G); pattn_load(C, QKV, nu, kr, vr); }
        pattn_compute(C, ws, pu);
        __syncthreads();
    }
#ifndef ATTN_REP_SAMPLE
#define ATTN_REP_SAMPLE 1
#endif
    for (int rep_ = 0; rep_ < ATTN_REP_SAMPLE; ++rep_)
    for (int su = C.bid; su < SBN * 3 * 8; su += C.G) { const int h = su & 7, b = (su >> 3) & 127, g = su >> 10; const float* cache_g = kp->p[4 + (2 - g)];
        sattn_unit(C, cache_g, ws, out, b, 2 - g, h); }
}
__device__ __forceinline__ void merge_phase(const Ctx& C, unsigned char* ws) {
    const bf16* OG = (const bf16*)(ws + WS_OG); const float* LSE = (const float*)(ws + WS_LSE); bf16* OM = (bf16*)(ws + WS_OM);
    for (int idx = C.bid * 512 + C.tid; idx < M * 64; idx += C.G * 512) { const int m = idx >> 6, c8 = idx & 63, h = c8 >> 3;
        const float l0 = LSE[((size_t)0 * M + m) * 8 + h], l1 = LSE[((size_t)1 * M + m) * 8 + h], l2 = LSE[((size_t)2 * M + m) * 8 + h];
        const float mx = fmaxf(l0, fmaxf(l1, l2)); float w0 = __builtin_amdgcn_exp2f(l0 - mx), w1 = __builtin_amdgcn_exp2f(l1 - mx), w2 = __builtin_amdgcn_exp2f(l2 - mx);
        const float inv = 1.0f / (w0 + w1 + w2); w0 *= inv; w1 *= inv; w2 *= inv;
        float a[8], b[8], c[8];
        unpack8(*(const GAS v4u*)(OG + ((size_t)0 * M + m) * AW + 8 * c8), a); unpack8(*(const GAS v4u*)(OG + ((size_t)1 * M + m) * AW + 8 * c8), b); unpack8(*(const GAS v4u*)(OG + ((size_t)2 * M + m) * AW + 8 * c8), c);
        float o[8];
#pragma unroll
        for (int e = 0; e < 8; ++e) o[e] = w0 * a[e] + w1 * b[e] + w2 * c[e];
        v4u w; w.x = pk2(o[0], o[1]); w.y = pk2(o[2], o[3]); w.z = pk2(o[4], o[5]); w.w = pk2(o[6], o[7]);
        *(GAS v4u*)(OM + (size_t)m * AW + 8 * c8) = w; }
}

#ifndef MK_ONE_LAUNCH
#define MK_ONE_LAUNCH 1
#endif
#ifndef REP_MASK
#define REP_MASK 0
#endif
#ifndef ONLY
#define ONLY -1
#endif
constexpr int N_PHASES = 21;
struct Args { In in; float* out; unsigned char* ws; int ph_lo, ph_hi; };
typedef const __attribute__((address_space(4))) In* KIn;
__device__ __forceinline__ KIn launder_kernarg() { unsigned long long p = (unsigned long long)__builtin_amdgcn_kernarg_segment_ptr(); asm volatile("" : "+s"(p)); return (KIn)p; }
#define IN_LOAD() In in; { KIn kp_ = launder_kernarg(); _Pragma("unroll") for (int i_ = 0; i_ < 33; ++i_) in.p[i_] = kp_->p[i_]; }
#define GEMM_PHASE(EPI, Aoff, Boff, Nn, Kk, ASEL, ...) { pg8::Gemm g{(const bf16*)(ws + (Aoff)), (const bf16*)(ws + (Boff)), M, (Nn), (Kk), (ASEL)}; pg8::StaticOrder S; S.init(M, (Nn), C.G, C.bid); \
        pg8::EPI E{__VA_ARGS__}; pg8::gemm_phase<pg8::EPI, pg8::StaticOrder, true, true>(ring, g, S, E); }
#define DOWN_PHASE(Boff, layer) GEMM_PHASE(EpiF32, WS_ACT, Boff, D, FF, 0, (float*)(ws + WS_MO), D)
#define FIX_PHASE(layer) { IN_LOAD(); fixup_phase(C, ws, in.p[30] + (size_t)(layer) * 3 * F2, in.p[31] + (size_t)(layer) * F2, in.p[7] + (size_t)(layer) * SBN * 2 * F2); }
#define UP_PHASE(Boff, layer) { IN_LOAD(); GEMM_PHASE(EpiConv, WS_XN, Boff, F2, D, 0, (bf16*)(ws + WS_ACT), (float*)(ws + WS_HID), (float*)(ws + WS_HID + 8 * MiB), out + O_PCONV + (size_t)(layer) * PB * 2 * F2, out + O_SCONV + (size_t)(layer) * SBN * 2 * F2, \
        in.p[30] + (size_t)(layer) * 3 * F2, in.p[31] + (size_t)(layer) * F2, (LAS float*)(C.lds + EX_OFF)) }

#define PBODY_0 { IN_LOAD(); p0_prologue(C, in, ws, out); }
#define PBODY_1 GEMM_PHASE(EpiG1, WS_XM, WS_W1CAT, 3840, D, RB16, (float*)(ws + WS_R), (bf16*)(ws + WS_L2A))
#define PBODY_2 { IN_LOAD(); GEMM_PHASE(EpiL2, WS_L2A, WS_WL2, 3072, 384, 0, (float*)(ws + WS_DC), in.p[14], in.p[17]) }
#define PBODY_3 { IN_LOAD(); scan_phase(C, in, ws, out); }
#define PBODY_4 { IN_LOAD(); scan_post_phase(C, in, ws); }
#define PBODY_5 GEMM_PHASE(EpiF32, WS_YG, WS_WORW, D, D, 0, (float*)(ws + WS_MO), D)
#define PBODY_6 { IN_LOAD(); rowwise_phase(C, in, nullptr, (const float*)(ws + WS_MO), in.p[8] + 1 * D, (float*)(ws + WS_X1), in.p[8] + 2 * D, (bf16*)(ws + WS_XN)); }
#define PBODY_7 UP_PHASE(WS_WUP0, 0)
#define PBODY_8 FIX_PHASE(0)
#define PBODY_9 DOWN_PHASE(WS_WDN0, 0)
#define PBODY_10 { IN_LOAD(); rowwise_phase(C, in, (const float*)(ws + WS_X1), (const float*)(ws + WS_MO), in.p[8] + 3 * D, (float*)(ws + WS_X2), in.p[8] + 4 * D, (bf16*)(ws + WS_XN)); }
#define PBODY_11 GEMM_PHASE(EpiBf16, WS_XN, WS_WQKV, NQKV, D, 0, (bf16*)(ws + WS_QKV), NQKV)
#define PBODY_12 { IN_LOAD(); rope_phase(C, in, ws, out); }
#define PBODY_13 { attn_phase(C, launder_kernarg(), ws, out); }
#define PBODY_14 { merge_phase(C, ws); }
#define PBODY_15 GEMM_PHASE(EpiF32, WS_OM, WS_WOAT, D, AW, 0, (float*)(ws + WS_MO), D)
#define PBODY_16 { IN_LOAD(); rowwise_phase(C, in, (const float*)(ws + WS_X2), (const float*)(ws + WS_MO), in.p[8] + 5 * D, (float*)(ws + WS_X3), in.p[8] + 6 * D, (bf16*)(ws + WS_XN)); }
#define PBODY_17 UP_PHASE(WS_WUP1, 1)
#define PBODY_18 FIX_PHASE(1)
#define PBODY_19 DOWN_PHASE(WS_WDN1, 1)
#define PBODY_20 { IN_LOAD(); rowwise_phase(C, in, (const float*)(ws + WS_X3), (const float*)(ws + WS_MO), in.p[8] + 7 * D, out + O_YP, nullptr, nullptr); }

__global__ void __launch_bounds__(NWAVES * 64, 2) fwd(Args args) {
    extern __shared__ __attribute__((aligned(16))) unsigned char lds[];
    Ctx C; C.lds = (LAS unsigned char*)lds; C.tid = threadIdx.x; C.lane = C.tid & 63; C.wave = __builtin_amdgcn_readfirstlane(C.tid >> 6);
    C.G = gridDim.x; C.bid = blockIdx.x; C.gw = C.bid * NWAVES + C.wave; C.NGW = C.G * NWAVES;
    unsigned char* ws = args.ws; float* out = args.out;
    volatile LAS unsigned* MISC = (volatile LAS unsigned*)(C.lds + MISC_OFF);
    for (int u = C.tid; u < (LDS_BYTES - LDSCTL_OFF) / 4; u += NWAVES * 64) ((LAS unsigned*)(C.lds + LDSCTL_OFF))[u] = 0u;
    __syncthreads();
    XcdBarrier bar; bar.bar = (unsigned*)(ws + WS_CTL) + CW_BAR; bar.x = 0; bar.st = nullptr;
    const int lo = args.ph_lo, hi = args.ph_hi;
    if (hi - lo > 1) bar = xcd_barrier_post((unsigned*)(ws + WS_CTL) + CW_BAR, MISC + 8);
    LAS unsigned char* ring = C.lds + RING_OFF;
#define IN(k) ((ONLY < 0 || ONLY == (k)) && lo <= (k) && (k) < hi)
#define PHASE(k) if (IN(k)) PBODY_##k if (IN(k) && ((REP_MASK >> (k)) & 1)) { if (hi - lo > 1) xcd_barrier(bar); PBODY_##k } if (IN(k) && IN((k) + 1)) xcd_barrier(bar);
    PHASE(0) PHASE(1) PHASE(2) PHASE(3) PHASE(4) PHASE(5) PHASE(6) PHASE(7) PHASE(8) PHASE(9) PHASE(10) PHASE(11) PHASE(12) PHASE(13) PHASE(14) PHASE(15) PHASE(16) PHASE(17) PHASE(18) PHASE(19) PHASE(20)
#undef IN
#undef PHASE
}

extern "C" void kernel_launch(void* const* d_in, const int* in_sizes, int n_in, void* d_out, int out_size, void* d_ws, size_t ws_size, hipStream_t stream) {
    static int grid = 0;
    if (grid == 0) {
        if (n_in != 33 || (size_t)out_size != O_END || ws_size < WS_END) { fprintf(stderr, "kernel_launch: unexpected sizes: n_in %d out %d ws %zu (need %zu)\n", n_in, out_size, ws_size, (size_t)WS_END); grid = -1; return; }
        int dev = 0, cus = 0, per_cu = 0;
        if (hipGetDevice(&dev) != hipSuccess || hipDeviceGetAttribute(&cus, hipDeviceAttributeMultiprocessorCount, dev) != hipSuccess) { grid = -1; return; }
        if (hipFuncSetAttribute((const void*)fwd, hipFuncAttributeMaxDynamicSharedMemorySize, LDS_BYTES) != hipSuccess) { fprintf(stderr, "kernel_launch: hipFuncSetAttribute failed\n"); grid = -1; return; }
        if (hipOccupancyMaxActiveBlocksPerMultiprocessor(&per_cu, (const void*)fwd, NWAVES * 64, LDS_BYTES) != hipSuccess || per_cu < 1) { fprintf(stderr, "kernel_launch: occupancy query says %d\n", per_cu); }
        (void)hipGetLastError();
        grid = cus;
    }
    if (grid < 0) return;
    (void)hipMemsetAsync((char*)d_ws + WS_CTL, 0, CTL_ZERO_BYTES, stream);
    Args a{};
    for (int i = 0; i < 33; ++i) a.in.p[i] = (const float*)d_in[i];
    a.out = (float*)d_out; a.ws = (unsigned char*)d_ws;
#if MK_ONE_LAUNCH
    a.ph_lo = 0; a.ph_hi = N_PHASES;
    hipLaunchKernelGGL(fwd, dim3(grid), dim3(NWAVES * 64), LDS_BYTES, stream, a);
#else
    for (int ph = 0; ph < N_PHASES; ++ph) { a.ph_lo = ph; a.ph_hi = ph + 1; hipLaunchKernelGGL(fwd, dim3(grid), dim3(NWAVES * 64), LDS_BYTES, stream, a); }
#endif
}
```

```cpp
#include <hip/hip_runtime.h>
#include <cstdio>
#include <cstdint>
namespace pg8 {
#define PG8_LAS __attribute__((address_space(3)))
typedef unsigned short bf16_t;
typedef short bf16x8 __attribute__((ext_vector_type(8)));
typedef float f32x4 __attribute__((ext_vector_type(4)));
typedef float f32x2 __attribute__((ext_vector_type(2)));
typedef unsigned u32x4 __attribute__((ext_vector_type(4)));
typedef unsigned u32x2 __attribute__((ext_vector_type(2)));
constexpr int BM = 256, BK = 64, HALF = 128, HTB = HALF * BK * 2  , STAGE_BYTES = 8 * HTB, NXCD = 8, WGM = 8;

__host__ __device__ __forceinline__ int lds_byte(int r, int c) { const int st = (r >> 4) * 2 + (c >> 5), rr = r & 15, cc = c & 31, ob = rr * 64 + cc * 2; return st * 1024 + (ob ^ (((ob >> 9) & 1) << 5)); }
__host__ __device__ __forceinline__ void stage_rc(int b, int& R, int& C) { const int st = b / 1024, sb = b % 1024, swz = sb ^ (((sb >> 9) & 1) << 5); R = (st >> 1) * 16 + swz / 64; C = (st & 1) * 32 + (swz % 64) / 2; }
__host__ __device__ __forceinline__ int perm32(int rho) { const int n = rho >> 4, i = rho & 15; return 8 * (i >> 2) + 4 * n + (i & 3); }

struct Unit { int pm, pn; };
struct Gemm { const bf16_t* A; const bf16_t* Bt; int M, N, K; size_t a_sel_bytes; };

struct StaticOrder {
    int nM, nN, nwg, G, c;
    __host__ __device__ __forceinline__ void init(int M, int N, int G_, int c_) { nM = M / BM; nN = N / BM; nwg = nM * nN; G = G_; c = c_; }
    __host__ __device__ __forceinline__ bool next(int i, Unit& u) const {
        const long L = (long)i * G + c; if (L >= nwg) return false;
        int wgid = (int)L; { const int q = nwg / NXCD, r = nwg % NXCD, xcd = wgid % NXCD, off = wgid / NXCD; wgid = (xcd < r ? xcd * (q + 1) : r * (q + 1) + (xcd - r) * q) + off; }
        const int nig = WGM * nN, gid = wgid / nig, fm = gid * WGM, gsz = (nM - fm) < WGM ? (nM - fm) : WGM;
        u.pm = fm + ((wgid % nig) % gsz); u.pn = (wgid % nig) / gsz; return true;
    }
    __device__ __forceinline__ void a_ready(const Unit&) const {}
    __device__ __forceinline__ void done(const Unit&) const {}
};

__device__ __forceinline__ unsigned cvt_pk_bf16(float lo, float hi) { unsigned r; asm volatile("v_cvt_pk_bf16_f32 %0, %1, %2" : "=v"(r) : "v"(lo), "v"(hi)); return r; }
__device__ __forceinline__ float fast_tanh(float x) { return 1.0f - 2.0f / (1.0f + __expf(2.0f * x)); }
__device__ __forceinline__ float fast_sigmoid(float x) { return 1.0f / (1.0f + __expf(-x)); }

struct EpiF32 {
    static constexpr bool PERM = false, AFTER_DRAIN = false;
    static __device__ __forceinline__ int asel(int) { return 0; }
    float* C; int ldc;
    __device__ __forceinline__ void operator()(const f32x4 (&acc)[2][2][4][2], const Unit& u, int wr, int wc, int fr, int fq) const {
        const int row0 = u.pm * BM + wr * 64 + fr, col0 = u.pn * BM + wc * 32 + 4 * fq;
#pragma unroll
        for (int ai = 0; ai < 2; ++ai)
#pragma unroll
            for (int m = 0; m < 4; ++m) { float* rowp = C + (size_t)(row0 + ai * HALF + m * 16) * ldc + col0;
#pragma unroll
                for (int bj = 0; bj < 2; ++bj)
#pragma unroll
                    for (int n = 0; n < 2; ++n) *(f32x4*)(rowp + bj * HALF + n * 16) = acc[ai][bj][m][n]; }
    }
};
struct EpiBf16 {
    static constexpr bool PERM = true, AFTER_DRAIN = false;
    static __device__ __forceinline__ int asel(int) { return 0; }
    bf16_t* O; int ldc;
    __device__ __forceinline__ void operator()(const f32x4 (&acc)[2][2][4][2], const Unit& u, int wr, int wc, int fr, int fq) const {
        const int row0 = u.pm * BM + wr * 64 + fr, col0 = u.pn * BM + wc * 32 + 8 * fq;
#pragma unroll
        for (int ai = 0; ai < 2; ++ai)
#pragma unroll
            for (int m = 0; m < 4; ++m) { bf16_t* rowp = O + (size_t)(row0 + ai * HALF + m * 16) * ldc + col0;
#pragma unroll
                for (int bj = 0; bj < 2; ++bj) { const f32x4 v0 = acc[ai][bj][m][0], v1 = acc[ai][bj][m][1];
                    u32x4 w; w.x = cvt_pk_bf16(v0[0], v0[1]); w.y = cvt_pk_bf16(v0[2], v0[3]); w.z = cvt_pk_bf16(v1[0], v1[1]); w.w = cvt_pk_bf16(v1[2], v1[3]);
                    *(u32x4*)(rowp + bj * HALF) = w; } }
    }
};
constexpr size_t RKV_STRIDE = (size_t)17408 * 1024;
struct EpiG1 {
    static constexpr bool PERM = false, AFTER_DRAIN = false;
    static __device__ __forceinline__ int asel(int pn) { return pn < 12 ? (pn >> 2) : pn - 9; }
    float* RKV; bf16_t* L2A;
    __device__ __forceinline__ void operator()(const f32x4 (&acc)[2][2][4][2], const Unit& u, int wr, int wc, int fr, int fq) const {
        const int row0 = u.pm * BM + wr * 64 + fr;
        if (u.pn < 12) {
            float* base = RKV + (size_t)(u.pn >> 2) * RKV_STRIDE; const int col0 = (u.pn & 3) * BM + wc * 32 + 4 * fq;
#pragma unroll
            for (int ai = 0; ai < 2; ++ai)
#pragma unroll
                for (int m = 0; m < 4; ++m) { float* rowp = base + (size_t)(row0 + ai * HALF + m * 16) * 1024 + col0;
#pragma unroll
                    for (int bj = 0; bj < 2; ++bj)
#pragma unroll
                        for (int n = 0; n < 2; ++n) *(f32x4*)(rowp + bj * HALF + n * 16) = acc[ai][bj][m][n]; }
        } else {
            const int mode = u.pn - 12, cbase = mode == 0 ? 0 : (mode == 1 ? 64 : 128);
#pragma unroll
            for (int ai = 0; ai < 2; ++ai)
#pragma unroll
                for (int m = 0; m < 4; ++m) { bf16_t* rowp = L2A + (size_t)(row0 + ai * HALF + m * 16) * 384 + cbase;
#pragma unroll
                    for (int bj = 0; bj < 2; ++bj)
#pragma unroll
                        for (int n = 0; n < 2; ++n) { const int lc = bj * HALF + wc * 32 + n * 16 + 4 * fq;
                            if (mode < 2 && lc >= 64) continue;
                            f32x4 v = acc[ai][bj][m][n];
                            if (mode == 0) { v[0] = fast_tanh(v[0]); v[1] = fast_tanh(v[1]); v[2] = fast_tanh(v[2]); v[3] = fast_tanh(v[3]); }
                            if (mode == 2) { v[0] = fast_sigmoid(v[0]); v[1] = fast_sigmoid(v[1]); v[2] = fast_sigmoid(v[2]); v[3] = fast_sigmoid(v[3]); }
                            u32x2 w; w.x = cvt_pk_bf16(v[0], v[1]); w.y = cvt_pk_bf16(v[2], v[3]); *(u32x2*)(rowp + lc) = w; } }
        }
    }
};
struct EpiL2 {
    static constexpr bool PERM = false, AFTER_DRAIN = false;
    static __device__ __forceinline__ int asel(int) { return 0; }
    float* DAG; const float* w0; const float* a0;
    __device__ __forceinline__ void operator()(const f32x4 (&acc)[2][2][4][2], const Unit& u, int wr, int wc, int fr, int fq) const {
        const int row0 = u.pm * BM + wr * 64 + fr, mode = u.pn >> 2, col0 = (u.pn & 3) * BM + wc * 32 + 4 * fq;
        float* base = DAG + (size_t)mode * RKV_STRIDE + (size_t)row0 * 1024 + col0;
        if (mode == 0) {
#pragma unroll
            for (int bj = 0; bj < 2; ++bj)
#pragma unroll
                for (int n = 0; n < 2; ++n) { const f32x4 bv = *(const f32x4*)(w0 + col0 + bj * HALF + n * 16);
#pragma unroll
                    for (int ai = 0; ai < 2; ++ai)
#pragma unroll
                        for (int m = 0; m < 4; ++m) { f32x4 v = acc[ai][bj][m][n] + bv;
#pragma unroll
                            for (int j = 0; j < 4; ++j) { const float z = v[j], sp = fmaxf(-z, 0.f) + __logf(1.0f + __expf(-fabsf(z))); v[j] = __expf(-__expf(-sp - 0.5f)); }
                            *(f32x4*)(base + (size_t)(ai * HALF + m * 16) * 1024 + bj * HALF + n * 16) = v; } }
        } else if (mode == 1) {
#pragma unroll
            for (int bj = 0; bj < 2; ++bj)
#pragma unroll
                for (int n = 0; n < 2; ++n) { const f32x4 bv = *(const f32x4*)(a0 + col0 + bj * HALF + n * 16);
#pragma unroll
                    for (int ai = 0; ai < 2; ++ai)
#pragma unroll
                        for (int m = 0; m < 4; ++m) { f32x4 v = acc[ai][bj][m][n] + bv;
#pragma unroll
                            for (int j = 0; j < 4; ++j) v[j] = fast_sigmoid(v[j]);
                            *(f32x4*)(base + (size_t)(ai * HALF + m * 16) * 1024 + bj * HALF + n * 16) = v; } }
        } else {
#pragma unroll
            for (int ai = 0; ai < 2; ++ai)
#pragma unroll
                for (int m = 0; m < 4; ++m)
#pragma unroll
                    for (int bj = 0; bj < 2; ++bj)
#pragma unroll
                        for (int n = 0; n < 2; ++n) *(f32x4*)(base + (size_t)(ai * HALF + m * 16) * 1024 + bj * HALF + n * 16) = acc[ai][bj][m][n];
        }
    }
};
constexpr int EX_FLOATS_PER_BLK = 2 * 2 * 128;
__device__ __forceinline__ float gelu_tanh_f(float x) { const float u = 0.7978845608028654f * (x + 0.044715f * x * x * x); return 0.5f * x * (1.0f + fast_tanh(u)); }
#define PG8_ROR(x, n) __builtin_bit_cast(float, __builtin_amdgcn_mov_dpp(__builtin_bit_cast(int, (x)), 0x120 + (n), 0xF, 0xF, false))
struct EpiConv {
    static constexpr bool PERM = true, AFTER_DRAIN = false;
    static __device__ __forceinline__ int asel(int) { return 0; }
    bf16_t* ACT; float* HALO; float* RAWS; float* pconv; float* sconv; const float* cw; const float* cb; PG8_LAS float* X;
    __device__ __forceinline__ void operator()(f32x4 (&acc)[2][2][4][2], const Unit& u, int wr, int wc, int fr, int fq) const {
        constexpr int FFc = 2816, F2c = 5632, MPc = 16384;
        const int lcb = wc * 32 + 8 * fq, cg = u.pn * 128 + lcb;
        if (fr >= 14) {
#pragma unroll
            for (int ai = 0; ai < 2; ++ai)
#pragma unroll
                for (int bj = 0; bj < 2; ++bj)
#pragma unroll
                    for (int n = 0; n < 2; ++n) *(PG8_LAS f32x4*)(X + (ai * 2 + wr) * EX_FLOATS_PER_BLK + ((fr - 14) * 2 + bj) * 128 + lcb + 4 * n) = acc[ai][bj][3][n];
        }
        asm volatile("s_waitcnt lgkmcnt(0)" ::: "memory"); __builtin_amdgcn_s_barrier(); asm volatile("" ::: "memory");
        const int row0 = u.pm * BM + wr * 64 + fr;
        if (u.pm >= 64) {
            const int t = fr & 7;
            if (t < 2 || t >= 6) {
#pragma unroll
                for (int ai = 0; ai < 2; ++ai)
#pragma unroll
                    for (int m = 0; m < 4; ++m) { const int rs = row0 + ai * HALF + m * 16 - MPc; float* dst = t < 2 ? RAWS + (size_t)rs * F2c : sconv + ((size_t)(rs >> 3) * 2 + (t - 6)) * F2c;
#pragma unroll
                        for (int bj = 0; bj < 2; ++bj)
#pragma unroll
                            for (int n = 0; n < 2; ++n) *(f32x4*)(dst + bj * FFc + cg + 4 * n) = acc[ai][bj][m][n]; }
            }
        } else {
            if (wr == 0 && fr < 2) {
#pragma unroll
                for (int bj = 0; bj < 2; ++bj)
#pragma unroll
                    for (int n = 0; n < 2; ++n) *(f32x4*)(HALO + ((size_t)u.pm * 4 + fr) * F2c + bj * FFc + cg + 4 * n) = acc[0][bj][0][n]; }
            if (wr == 1 && fr >= 14) {
#pragma unroll
                for (int bj = 0; bj < 2; ++bj)
#pragma unroll
                    for (int n = 0; n < 2; ++n) { *(f32x4*)(HALO + ((size_t)u.pm * 4 + fr - 12) * F2c + bj * FFc + cg + 4 * n) = acc[1][bj][3][n];
                        if ((u.pm & 7) == 7) *(f32x4*)(pconv + ((size_t)(u.pm >> 3) * 2 + (fr - 14)) * F2c + bj * FFc + cg + 4 * n) = acc[1][bj][3][n]; } }
        }
        asm volatile("" ::: "memory"); __builtin_amdgcn_sched_barrier(0);
#pragma unroll
        for (int n = 0; n < 2; ++n)
#pragma unroll
            for (int s = 0; s < 2; ++s) {
                const int c = s * FFc + cg + 4 * n;
                const f32x4 bb = *(const f32x4*)(cb + c), w0 = *(const f32x4*)(cw + c), w1 = *(const f32x4*)(cw + F2c + c), w2 = *(const f32x4*)(cw + 2 * F2c + c);
#pragma unroll
                for (int ai = 0; ai < 2; ++ai) {
                    const int pblk = wr == 1 ? ai * 2 : 1; const bool has_prev = (wr == 1 || ai == 1);
                    f32x4 e1 = *(const PG8_LAS f32x4*)(X + pblk * EX_FLOATS_PER_BLK + (1 * 2 + s) * 128 + lcb + 4 * n), e2 = *(const PG8_LAS f32x4*)(X + pblk * EX_FLOATS_PER_BLK + (0 * 2 + s) * 128 + lcb + 4 * n);
                    if (!has_prev) { e1 = (f32x4){0.f, 0.f, 0.f, 0.f}; e2 = e1; }
                    f32x4 p1, p2;
#pragma unroll
                    for (int m = 0; m < 4; ++m) {
                        const f32x4 a = acc[ai][s][m][n]; f32x4 r1, r2, h1, h2;
                        asm volatile("s_nop 1\n\tv_mov_b32_dpp %0, %8 row_ror:1 row_mask:0xf bank_mask:0xf\n\tv_mov_b32_dpp %1, %9 row_ror:1 row_mask:0xf bank_mask:0xf\n\tv_mov_b32_dpp %2, %10 row_ror:1 row_mask:0xf bank_mask:0xf\n\tv_mov_b32_dpp %3, %11 row_ror:1 row_mask:0xf bank_mask:0xf\n\t"
                                     "v_mov_b32_dpp %4, %8 row_ror:2 row_mask:0xf bank_mask:0xf\n\tv_mov_b32_dpp %5, %9 row_ror:2 row_mask:0xf bank_mask:0xf\n\tv_mov_b32_dpp %6, %10 row_ror:2 row_mask:0xf bank_mask:0xf\n\tv_mov_b32_dpp %7, %11 row_ror:2 row_mask:0xf bank_mask:0xf"
                                     : "=&v"(r1[0]), "=&v"(r1[1]), "=&v"(r1[2]), "=&v"(r1[3]), "=&v"(r2[0]), "=&v"(r2[1]), "=&v"(r2[2]), "=&v"(r2[3]) : "v"(a[0]), "v"(a[1]), "v"(a[2]), "v"(a[3]));
                        if (m == 0) { h1 = fr >= 1 ? r1 : e1; h2 = fr >= 2 ? r2 : (fr == 0 ? e2 : e1); }
                        else { h1 = fr >= 1 ? r1 : p1; h2 = fr >= 2 ? r2 : p2; }
                        p1 = r1; p2 = r2;
                        acc[ai][s][m][n] = bb + w0 * h2 + w1 * h1 + w2 * a;
                        __builtin_amdgcn_sched_barrier(0);
                    }
                }
                asm volatile("" ::: "memory"); __builtin_amdgcn_sched_barrier(0);
            }
#pragma unroll
        for (int ai = 0; ai < 2; ++ai)
#pragma unroll
            for (int m = 0; m < 4; ++m) { const int row = row0 + ai * HALF + m * 16; u32x4 o;
                { const f32x4 g = acc[ai][0][m][0], v = acc[ai][1][m][0]; o.x = cvt_pk_bf16(gelu_tanh_f(g[0]) * v[0], gelu_tanh_f(g[1]) * v[1]); o.y = cvt_pk_bf16(gelu_tanh_f(g[2]) * v[2], gelu_tanh_f(g[3]) * v[3]); }
                { const f32x4 g = acc[ai][0][m][1], v = acc[ai][1][m][1]; o.z = cvt_pk_bf16(gelu_tanh_f(g[0]) * v[0], gelu_tanh_f(g[1]) * v[1]); o.w = cvt_pk_bf16(gelu_tanh_f(g[2]) * v[2], gelu_tanh_f(g[3]) * v[3]); }
                *(u32x4*)(ACT + (size_t)row * FFc + cg) = o; }
    }
};
template <class Epi, class Sched, bool ALIGN_EPI = false, bool SP2 = false>
__device__ __forceinline__ void gemm_phase(PG8_LAS unsigned char* lds, const Gemm g, const Sched& S, const Epi& E) {
    const int tid = threadIdx.x, wid = __builtin_amdgcn_readfirstlane(tid >> 6), lane = tid & 63, wr = wid >> 2, wc = wid & 3, fr = lane & 15, fq = lane >> 4;
    int K = g.K; asm volatile("" : "+s"(K));
    const int nt = K / BK;
    unsigned voffA[2], voffB[2];
#pragma unroll
    for (int i = 0; i < 2; ++i) { int R, C; stage_rc(tid * 16 + i * 8192, R, C); const int Rb = Epi::PERM ? ((R & ~31) + perm32(R & 31)) : R;
        voffA[i] = (unsigned)(R * K + C) * 2u; voffB[i] = (unsigned)(Rb * K + C) * 2u; }
    const size_t kstep = (size_t)(BK * 2);
    const size_t hstep = (size_t)HALF * K * 2;
    const size_t tstep = 2 * hstep;
    const unsigned ldsw = (unsigned)wid * 1024u;
    const int aoff = lds_byte(wr * 64 + fr, fq * 8), boff = lds_byte(wc * 32 + fr, fq * 8);
#define PG8_SA(b, h) (((b) * 2 + (h)) * HTB)
#define PG8_SB(b, h) ((4 + (b) * 2 + (h)) * HTB)
#define PG8_STAGE(bufoff, gbase, voff) do { _Pragma("unroll") for (int _i = 0; _i < 2; ++_i) \
        __builtin_amdgcn_global_load_lds((const unsigned*)((const char*)(gbase) + (voff)[_i]), (PG8_LAS unsigned*)(lds + (bufoff) + ldsw + _i * 8192), 16, 0, 0); } while (0)
#define PG8_LDA(dst, b, h) do { _Pragma("unroll") for (int m = 0; m < 4; ++m) _Pragma("unroll") for (int k = 0; k < 2; ++k) dst[m][k] = *(const PG8_LAS bf16x8*)(lds + PG8_SA(b, h) + aoff + m * 2048 + k * 1024); } while (0)
#define PG8_LDB(dst, b, h) do { _Pragma("unroll") for (int n = 0; n < 2; ++n) _Pragma("unroll") for (int k = 0; k < 2; ++k) dst[n][k] = *(const PG8_LAS bf16x8*)(lds + PG8_SB(b, h) + boff + n * 2048 + k * 1024); } while (0)
#define PG8_MMA(ai, bj, At, Bt) do { __builtin_amdgcn_s_setprio(1); _Pragma("unroll") for (int m = 0; m < 4; ++m) _Pragma("unroll") for (int n = 0; n < 2; ++n) _Pragma("unroll") for (int k = 0; k < 2; ++k) \
        acc[ai][bj][m][n] = __builtin_amdgcn_mfma_f32_16x16x32_bf16(Bt[n][k], At[m][k], acc[ai][bj][m][n], 0, 0, 0); __builtin_amdgcn_s_setprio(0); } while (0)
#define PG8_WAIT_V(n) asm volatile("s_waitcnt vmcnt(" #n ")" ::: "memory")
#define PG8_WAIT_L(n) asm volatile("s_waitcnt lgkmcnt(" #n ")" ::: "memory")
#define PG8_BAR __builtin_amdgcn_s_barrier()
#define PG8_SCHED __builtin_amdgcn_sched_barrier(0)
    Unit cur, nxt; int ui = 0;
    if (!S.next(0, cur)) return;
    f32x4 acc[2][2][4][2];
#pragma unroll
    for (int a = 0; a < 2; ++a)
#pragma unroll
        for (int b = 0; b < 2; ++b)
#pragma unroll
            for (int m = 0; m < 4; ++m)
#pragma unroll
                for (int n = 0; n < 2; ++n) acc[a][b][m][n] = (f32x4){0.f, 0.f, 0.f, 0.f};
    bf16x8 At[4][2], B0[2][2], B1[2][2];
    const char* cA = (const char*)g.A + (size_t)Epi::asel(cur.pn) * g.a_sel_bytes + (size_t)cur.pm * tstep; const char* cB = (const char*)g.Bt + (size_t)cur.pn * tstep;
    S.a_ready(cur);
    if constexpr (SP2) {
        PG8_STAGE(PG8_SB(0, 0), cB, voffB); PG8_STAGE(PG8_SB(0, 1), cB + hstep, voffB); PG8_STAGE(PG8_SA(0, 0), cA, voffA); PG8_STAGE(PG8_SA(0, 1), cA + hstep, voffA);
        if (wr == 1) PG8_BAR;
        PG8_WAIT_V(2); PG8_BAR;
        PG8_STAGE(PG8_SB(1, 0), cB + kstep, voffB); PG8_STAGE(PG8_SA(1, 0), cA + kstep, voffA); PG8_STAGE(PG8_SB(1, 1), cB + hstep + kstep, voffB);
        PG8_WAIT_V(6); PG8_BAR;
    } else {
        PG8_STAGE(PG8_SB(0, 0), cB, voffB); PG8_STAGE(PG8_SA(0, 0), cA, voffA); PG8_STAGE(PG8_SB(0, 1), cB + hstep, voffB); PG8_STAGE(PG8_SA(0, 1), cA + hstep, voffA);
        if (wr == 1) PG8_BAR;
        PG8_WAIT_V(4); PG8_BAR;
        PG8_STAGE(PG8_SB(1, 0), cB + kstep, voffB); PG8_STAGE(PG8_SA(1, 0), cA + kstep, voffA); PG8_STAGE(PG8_SB(1, 1), cB + hstep + kstep, voffB);
        PG8_WAIT_V(6); PG8_BAR;
    }
    for (;;) {
        const bool has_next = S.next(ui + 1, nxt);
        const char* nA = has_next ? (const char*)g.A + (size_t)Epi::asel(nxt.pn) * g.a_sel_bytes + (size_t)nxt.pm * tstep : cA; const char* nB = has_next ? (const char*)g.Bt + (size_t)nxt.pn * tstep : cB;
        for (int t = 0; t < nt; t += 2) {
            const bool last = (t == nt - 2);
            const char* a1 = cA + (size_t)(t + 1) * kstep;
            const char* a2 = last ? nA : cA + (size_t)(t + 2) * kstep; const char* b2 = last ? nB : cB + (size_t)(t + 2) * kstep;
            const char* a3 = a2 + kstep; const char* b3 = b2 + kstep;
            if (last && has_next) S.a_ready(nxt);
            if constexpr (SP2) {
            PG8_LDB(B0, 0, 0); PG8_LDB(B1, 0, 1); PG8_SCHED; PG8_LDA(At, 0, 0); PG8_STAGE(PG8_SA(1, 1), a1 + hstep, voffA);
            PG8_WAIT_V(8); PG8_WAIT_L(0); PG8_BAR; PG8_MMA(0, 0, At, B0); PG8_MMA(0, 1, At, B1); PG8_BAR; PG8_SCHED;
            PG8_LDA(At, 0, 1); PG8_STAGE(PG8_SB(0, 0), b2, voffB); PG8_STAGE(PG8_SB(0, 1), b2 + hstep, voffB); PG8_STAGE(PG8_SA(0, 0), a2, voffA);
            PG8_WAIT_V(8); PG8_WAIT_L(0); PG8_BAR; PG8_MMA(1, 0, At, B0); PG8_MMA(1, 1, At, B1); PG8_BAR; PG8_SCHED;
            PG8_LDB(B0, 1, 0); PG8_LDB(B1, 1, 1); PG8_SCHED; PG8_LDA(At, 1, 0); PG8_STAGE(PG8_SA(0, 1), a2 + hstep, voffA);
            PG8_WAIT_V(8); PG8_WAIT_L(0); PG8_BAR; PG8_MMA(0, 0, At, B0); PG8_MMA(0, 1, At, B1); PG8_BAR; PG8_SCHED;
            PG8_LDA(At, 1, 1); PG8_STAGE(PG8_SB(1, 0), b3, voffB); PG8_STAGE(PG8_SB(1, 1), b3 + hstep, voffB); PG8_STAGE(PG8_SA(1, 0), a3, voffA);
            PG8_WAIT_V(8); PG8_WAIT_L(0); PG8_BAR; PG8_MMA(1, 0, At, B0); PG8_MMA(1, 1, At, B1); PG8_BAR; PG8_SCHED;
            } else {
            PG8_LDB(B0, 0, 0); PG8_SCHED; PG8_LDA(At, 0, 0); PG8_STAGE(PG8_SA(1, 1), a1 + hstep, voffA);
            PG8_WAIT_L(8); PG8_BAR; PG8_WAIT_L(0); PG8_MMA(0, 0, At, B0); PG8_BAR; PG8_SCHED;
            PG8_LDB(B1, 0, 1); PG8_STAGE(PG8_SB(0, 0), b2, voffB);
            PG8_BAR; PG8_WAIT_L(0); PG8_MMA(0, 1, At, B1); PG8_BAR;
            PG8_LDA(At, 0, 1); PG8_STAGE(PG8_SA(0, 0), a2, voffA);
            PG8_BAR; PG8_WAIT_L(0); PG8_MMA(1, 0, At, B0); PG8_BAR; PG8_SCHED;
            PG8_STAGE(PG8_SB(0, 1), b2 + hstep, voffB);
            PG8_WAIT_V(6); PG8_BAR; PG8_MMA(1, 1, At, B1); PG8_BAR;
            PG8_LDB(B0, 1, 0); PG8_SCHED; PG8_LDA(At, 1, 0); PG8_STAGE(PG8_SA(0, 1), a2 + hstep, voffA);
            PG8_WAIT_L(8); PG8_BAR; PG8_WAIT_L(0); PG8_MMA(0, 0, At, B0); PG8_BAR; PG8_SCHED;
            PG8_LDB(B1, 1, 1); PG8_STAGE(PG8_SB(1, 0), b3, voffB);
            PG8_BAR; PG8_WAIT_L(0); PG8_MMA(0, 1, At, B1); PG8_BAR;
            PG8_LDA(At, 1, 1); PG8_STAGE(PG8_SA(1, 0), a3, voffA);
            PG8_BAR; PG8_WAIT_L(0); PG8_MMA(1, 0, At, B0); PG8_BAR; PG8_SCHED;
            PG8_STAGE(PG8_SB(1, 1), b3 + hstep, voffB);
            PG8_WAIT_V(6); PG8_BAR; PG8_MMA(1, 1, At, B1); PG8_BAR;
            }
        }
        if constexpr (ALIGN_EPI) { if (wr == 0) PG8_BAR; }
        if constexpr (!Epi::AFTER_DRAIN) { E(acc, cur, wr, wc, fr, fq); S.done(cur); }
        if (!has_next) break;
#pragma unroll
        for (int a = 0; a < 2; ++a)
#pragma unroll
            for (int b = 0; b < 2; ++b)
#pragma unroll
                for (int m = 0; m < 4; ++m)
#pragma unroll
                    for (int n = 0; n < 2; ++n) acc[a][b][m][n] = (f32x4){0.f, 0.f, 0.f, 0.f};
        cur = nxt; cA = nA; cB = nB; ++ui;
        if constexpr (ALIGN_EPI) { if (wr == 1) PG8_BAR; }
    }
    PG8_WAIT_V(0);
    if constexpr (!ALIGN_EPI) { if (wr == 0) PG8_BAR; }
    PG8_BAR;
    if constexpr (Epi::AFTER_DRAIN) { E.fused(acc, cur, wr, wc, fr, fq, lds, wid, lane); S.done(cur); }
#undef PG8_SA
#undef PG8_SB
#undef PG8_STAGE
#undef PG8_LDA
#undef PG8_LDB
#undef PG8_MMA
#undef PG8_WAIT_V
#undef PG8_WAIT_L
#undef PG8_BAR
#undef PG8_SCHED
}
}
using pg8::fast_tanh; using pg8::fast_sigmoid;

constexpr int D = 1024, PB = 8, PT = 2048, SBN = 128, STN = 8;
constexpr int MP = PB * PT, MS = SBN * STN, M = MP + MS;
constexpr int RH = 16, FF = 2816, F2 = 5632, AH = 8, AW = 512, NQKV = 4608;
constexpr float NORM_EPS = 1e-6f, GN_EPS = 64e-5f;
constexpr size_t O_YP = 0, O_YS = O_YP + (size_t)MP * D, O_PSHIFT = O_YS + (size_t)MS * D, O_PWKV = O_PSHIFT + (size_t)PB * D,
    O_PKV128 = O_PWKV + (size_t)PB * RH * 64 * 64, O_PKV512 = O_PKV128 + (size_t)PB * 128 * 1024, O_PKV2048 = O_PKV512 + (size_t)PB * 512 * 1024,
    O_PCONV = O_PKV2048 + (size_t)PB * 2048 * 1024, O_SSHIFT = O_PCONV + (size_t)2 * PB * 2 * F2, O_SWKV = O_SSHIFT + (size_t)SBN * D,
    O_SKV128 = O_SWKV + (size_t)SBN * RH * 64 * 64, O_SKV512 = O_SKV128 + (size_t)SBN * 8 * 1024, O_SKV2048 = O_SKV512 + (size_t)SBN * 8 * 1024,
    O_SCONV = O_SKV2048 + (size_t)SBN * 8 * 1024, O_END = O_SCONV + (size_t)2 * SBN * 2 * F2;
static_assert(O_END == 55107584, "output size");
constexpr size_t MiB = 1u << 20;
constexpr size_t WS_CTL = 0, CTL_ZERO_BYTES = 1 * MiB;
constexpr size_t WS_ROPE = 1 * MiB;
constexpr size_t WS_W1CAT = 2 * MiB, WS_WL2 = 10 * MiB, WS_WORW = 13 * MiB, WS_WUP0 = 15 * MiB, WS_WDN0 = 26 * MiB, WS_WQKV = 32 * MiB, WS_WOAT = 41 * MiB, WS_WUP1 = 42 * MiB, WS_WDN1 = 53 * MiB;
constexpr size_t RB16 = (size_t)M * D * 2, RF32 = (size_t)M * D * 4;
constexpr size_t WS_XM = 64 * MiB;
constexpr size_t WS_R = WS_XM + 6 * RB16, WS_K = WS_R + RF32, WS_V = WS_K + RF32, WS_DC = WS_V + RF32, WS_AA = WS_DC + RF32, WS_GG = WS_AA + RF32;
constexpr size_t WS_L2A = WS_GG + RF32;
constexpr size_t WS_Y = WS_L2A + 13 * MiB, WS_BONUS = WS_Y + RF32, WS_YG = WS_BONUS + 2 * MiB, WS_MO = WS_YG + RB16;
constexpr size_t WS_X1 = WS_MO + RF32, WS_X2 = WS_X1 + RF32, WS_X3 = WS_X2 + RF32, WS_XN = WS_X3 + RF32;
constexpr size_t WS_HID = WS_XN + RB16;
constexpr size_t WS_ACT = WS_HID + (size_t)M * F2 * 2;
constexpr size_t WS_QKV = WS_ACT + (size_t)M * FF * 2;
constexpr size_t WS_OG = WS_QKV + (size_t)M * NQKV * 2;
constexpr size_t WS_LSE = WS_OG + (size_t)3 * M * AW * 2;
constexpr size_t WS_OM = WS_LSE + 2 * MiB;
constexpr size_t WS_END = WS_OM + (size_t)M * AW * 2 + MiB;
static_assert(WS_W1CAT + (size_t)3840 * 1024 * 2 <= WS_WL2 && WS_WL2 + (size_t)3072 * 384 * 2 <= WS_WORW && WS_WUP0 + (size_t)F2 * D * 2 <= WS_WDN0 && WS_WDN0 + (size_t)D * FF * 2 <= WS_WQKV &&
              WS_WQKV + (size_t)NQKV * D * 2 <= WS_WOAT && WS_WUP1 + (size_t)F2 * D * 2 <= WS_WDN1 && WS_WDN1 + (size_t)D * FF * 2 <= WS_XM && (size_t)M * 384 * 2 <= 13 * MiB && (size_t)3 * M * 8 * 4 <= 2 * MiB, "ws map");
constexpr int CW_TMO = 0, CW_BAR = 4096;

constexpr int NWAVES = 8;
constexpr int RING_OFF = 0, RING_BYTES = 131072;
constexpr int LDSCTL_OFF = RING_BYTES, MISC_OFF = LDSCTL_OFF + 320;
constexpr int EX_OFF = MISC_OFF + 128;
constexpr int LDS_BYTES = 147456;

#define GAS __attribute__((address_space(1)))
#define LAS __attribute__((address_space(3)))
typedef unsigned short bf16;
typedef unsigned v4u __attribute__((ext_vector_type(4)));
typedef unsigned v2u __attribute__((ext_vector_type(2)));
typedef float f32x4 __attribute__((ext_vector_type(4)));
typedef float f32x2 __attribute__((ext_vector_type(2)));
typedef short bf16x8 __attribute__((ext_vector_type(8)));
typedef GAS unsigned gu32;
#define RLX_AGENT __ATOMIC_RELAXED, __HIP_MEMORY_SCOPE_AGENT
#define LDS_WAIT() asm volatile("s_waitcnt lgkmcnt(0)" ::: "memory")
#define VM_WAIT() asm volatile("s_waitcnt vmcnt(0)" ::: "memory")
__device__ __forceinline__ unsigned f2bf(float f) { unsigned u = __builtin_bit_cast(unsigned, f); return (u + 0x7fffu + ((u >> 16) & 1u)) >> 16; }
__device__ __forceinline__ unsigned pk2(float lo, float hi) { return f2bf(lo) | (f2bf(hi) << 16); }
__device__ __forceinline__ float bflo(unsigned w) { return __builtin_bit_cast(float, w << 16); }
__device__ __forceinline__ float bfhi(unsigned w) { return __builtin_bit_cast(float, w & 0xffff0000u); }
__device__ __forceinline__ float wave_sum(float v) {
#pragma unroll
    for (int o = 1; o < 64; o <<= 1) v += __shfl_xor(v, o);
    return v;
}
#define DPP_F(x, ctrl) __builtin_bit_cast(float, __builtin_amdgcn_mov_dpp(__builtin_bit_cast(int, (x)), (ctrl), 0xF, 0xF, true))
__device__ __forceinline__ float row16_sum(float x) {
    x += DPP_F(x, 0xB1);
    x += DPP_F(x, 0x4E);
    x += DPP_F(x, 0x141);
    x += DPP_F(x, 0x140);
    return x;
}
#define XB_TMO      128
#define XB_XCNT(j)  (256  + 64 * (j))
#define XB_XSUB(j)  (1280 + 64 * (j))
#define XB_XGEN(j)  (2304 + 64 * (j))
#define XB_TOP      3328
#define XB_TOPGEN   3392
#define XCD_BAR_WORDS 3456
#define XB_SPIN_CAP (1u << 18)

__device__ __forceinline__ unsigned xb_ld(unsigned* p)              { return __hip_atomic_load(p, __ATOMIC_RELAXED, __HIP_MEMORY_SCOPE_AGENT); }
__device__ __forceinline__ unsigned xb_add(unsigned* p, unsigned v) { return __hip_atomic_fetch_add(p, v, __ATOMIC_RELAXED, __HIP_MEMORY_SCOPE_AGENT); }
__device__ __forceinline__ unsigned xb_xcc_id() { return (unsigned)__builtin_amdgcn_s_getreg((3 << 11) | 20) & 0xFu; }
#define XB_SPIN(cond, bar) do { unsigned _sp = 0; while (cond) { __builtin_amdgcn_s_sleep(1); \
    if ((++_sp & 255u) == 0u) { if (xb_ld(&(bar)[XB_TMO])) break; if (_sp > XB_SPIN_CAP) { atomicAdd(&(bar)[XB_TMO], 1u); break; } } } } while (0)

struct XcdBarrier {
    unsigned* bar; unsigned x;
    volatile LAS unsigned* st;
};

__device__ __forceinline__ XcdBarrier xcd_barrier_post(unsigned* bar, volatile LAS unsigned* st) {
    XcdBarrier b; b.bar = bar; b.x = xb_xcc_id(); b.st = st;
    if (threadIdx.x == 0) (void)xb_add(&bar[XB_XCNT(b.x)], 1u);
    return b;
}
__device__ __forceinline__ void xcd_barrier_complete(unsigned* bar, unsigned x, unsigned& nloc, unsigned& nx) {
    const unsigned G = gridDim.x * gridDim.y * gridDim.z;
    unsigned sum, cnt, mine, sp = 0u;
    for (;;) {
        sum = 0u; cnt = 0u; mine = 0u;
#pragma unroll
        for (unsigned j = 0; j < 16; ++j) { const unsigned c = xb_ld(&bar[XB_XCNT(j)]); sum += c; cnt += (c > 0u) ? 1u : 0u; mine = (j == x) ? c : mine; }
        if (sum == G) break;
        __builtin_amdgcn_s_sleep(1);
        if ((++sp & 255u) == 0u) { if (xb_ld(&bar[XB_TMO])) break; if (sp > XB_SPIN_CAP) { atomicAdd(&bar[XB_TMO], 1u); break; } }
    }
    nloc = mine > 0u ? mine : 1u; nx = cnt > 0u ? cnt : 1u;
}

__device__ __forceinline__ void xcd_barrier(const XcdBarrier& b) {
    asm volatile("s_waitcnt vmcnt(0)" ::: "memory");
    __syncthreads();
    if (threadIdx.x == 0) {
        unsigned* bar = b.bar;
        __builtin_amdgcn_s_waitcnt(0);
        unsigned nloc = b.st[0], nx = b.st[1];
        if (nloc == 0u) { xcd_barrier_complete(bar, b.x, nloc, nx); b.st[0] = nloc; b.st[1] = nx; }
        const unsigned old = xb_add(&bar[XB_XSUB(b.x)], 1u);
        const unsigned gen = old / nloc;
        if (old + 1u == (gen + 1u) * nloc) {
            __builtin_amdgcn_fence(__ATOMIC_RELEASE, "agent");
            asm volatile("s_waitcnt vmcnt(0)" ::: "memory");
            const unsigned og = xb_add(&bar[XB_TOP], 1u);
            const unsigned tg = og / nx;
            if (og + 1u == (tg + 1u) * nx) xb_add(&bar[XB_TOPGEN], 1u);
            else XB_SPIN(xb_ld(&bar[XB_TOPGEN]) == tg, bar);
            __builtin_amdgcn_fence(__ATOMIC_ACQUIRE, "agent");
            xb_add(&bar[XB_XGEN(b.x)], 1u);
            asm volatile("s_waitcnt vmcnt(0)" ::: "memory");
        } else {
            XB_SPIN(xb_ld(&bar[XB_XGEN(b.x)]) == gen, bar);
            __builtin_amdgcn_fence(__ATOMIC_ACQUIRE, "agent");
            asm volatile("s_waitcnt vmcnt(0)" ::: "memory");
        }
    }
    __syncthreads();
}

struct Ctx { LAS unsigned char* lds; int tid, lane, wave, gw, NGW, G, bid; };

__device__ __forceinline__ void transpose_item(const float* W, int ldw, int Kvalid, bf16* WT, int ldt, int drow0, int dcol0, int k0, int n0, LAS float* scr, int lane) {
#pragma unroll 8
    for (int i = 0; i < 32; ++i) { const int kk = 2 * i + (lane >> 5), k = k0 + kk; scr[kk * 33 + (lane & 31)] = (k < Kvalid) ? W[(size_t)k * ldw + n0 + (lane & 31)] : 0.f; }
    LDS_WAIT(); asm volatile("" ::: "memory");
    const int c = lane & 7;
#pragma unroll
    for (int j = 0; j < 4; ++j) { const int n = (lane >> 3) + 8 * j; const LAS float* s = scr + (8 * c) * 33 + n;
        v4u o; o.x = pk2(s[0 * 33], s[1 * 33]); o.y = pk2(s[2 * 33], s[3 * 33]); o.z = pk2(s[4 * 33], s[5 * 33]); o.w = pk2(s[6 * 33], s[7 * 33]);
        *(GAS v4u*)(WT + (size_t)(drow0 + n) * ldt + dcol0 + 8 * c) = o; }
    LDS_WAIT(); asm volatile("" ::: "memory");
}
template <bool GLU = false> __device__ __forceinline__ void transpose_mat(const Ctx& C, const float* W, int K, int N, bf16* WT, int ldt, int row_off, int& base, LAS float* scr) {
    const int nblk = N / 32, nit = ((K + 63) / 64) * nblk;
    int start = (C.gw - base) % C.NGW; if (start < 0) start += C.NGW;
    for (int it = start; it < nit; it += C.NGW) { const int kb = it / nblk, nb = it % nblk, n0 = 32 * nb;
        const int drow = GLU ? (n0 < FF ? (n0 / 128) * 256 + (n0 % 128) : ((n0 - FF) / 128) * 256 + 128 + ((n0 - FF) % 128)) : n0;
        transpose_item(W, N, K, WT, ldt, row_off + drow, 64 * kb, 64 * kb, n0, scr, C.lane); }
    base += nit;
}
__device__ __forceinline__ void zero_rows(const Ctx& C, bf16* WT, int ldt, int r0, int r1) {
    const size_t n16 = (size_t)(r1 - r0) * ldt / 8; GAS v4u* p = (GAS v4u*)(WT + (size_t)r0 * ldt);
    for (size_t i = (size_t)C.bid * 512 + C.tid; i < n16; i += (size_t)C.G * 512) p[i] = (v4u){0u, 0u, 0u, 0u};
}

struct In { const float* p[33]; };

__device__ __forceinline__ void p0_prologue(const Ctx& C, const In& in, unsigned char* ws, float* out) {
    LAS float* scr = (LAS float*)(C.lds + RING_OFF + C.wave * 16384);
    bf16* W1CAT = (bf16*)(ws + WS_W1CAT); bf16* WL2 = (bf16*)(ws + WS_WL2);
    int base = 0;
    transpose_mat(C, in.p[10], D, D, W1CAT, D, 0, base, scr);
    transpose_mat(C, in.p[11], D, D, W1CAT, D, 1024, base, scr);
    transpose_mat(C, in.p[12], D, D, W1CAT, D, 2048, base, scr);
    transpose_mat(C, in.p[15], D, 64, W1CAT, D, 3072, base, scr);
    transpose_mat(C, in.p[18], D, 64, W1CAT, D, 3328, base, scr);
    transpose_mat(C, in.p[20], D, 160, W1CAT, D, 3584, base, scr);
    transpose_mat(C, in.p[13], D, D, (bf16*)(ws + WS_WORW), D, 0, base, scr);
    transpose_mat<true>(C, in.p[29], D, F2, (bf16*)(ws + WS_WUP0), D, 0, base, scr);
    transpose_mat<true>(C, in.p[29] + (size_t)D * F2, D, F2, (bf16*)(ws + WS_WUP1), D, 0, base, scr);
    transpose_mat(C, in.p[32], FF, D, (bf16*)(ws + WS_WDN0), FF, 0, base, scr);
    transpose_mat(C, in.p[32] + (size_t)FF * D, FF, D, (bf16*)(ws + WS_WDN1), FF, 0, base, scr);
    transpose_mat(C, in.p[27], D, NQKV, (bf16*)(ws + WS_WQKV), D, 0, base, scr);
    transpose_mat(C, in.p[28], AW, D, (bf16*)(ws + WS_WOAT), AW, 0, base, scr);
    zero_rows(C, W1CAT, D, 3072 + 64, 3328); zero_rows(C, W1CAT, D, 3328 + 64, 3584); zero_rows(C, W1CAT, D, 3584 + 160, 3840);
    { const float* w2 = in.p[16]; const float* a2 = in.p[19]; const float* g2 = in.p[21];
      for (int idx = C.bid * 512 + C.tid; idx < 48 * 3072; idx += C.G * 512) { const int kc = idx / 3072, n = idx % 3072, k0 = 8 * kc; float v[8];
#pragma unroll
          for (int j = 0; j < 8; ++j) { const int k = k0 + j; float x = 0.f;
              if (n < 1024) { if (k < 64) x = w2[(size_t)k * D + n]; }
              else if (n < 2048) { if (k >= 64 && k < 128) x = a2[(size_t)(k - 64) * D + (n - 1024)]; }
              else { if (k >= 128 && k < 288) x = g2[(size_t)(k - 128) * D + (n - 2048)]; }
              v[j] = x; }
          v4u o; o.x = pk2(v[0], v[1]); o.y = pk2(v[2], v[3]); o.z = pk2(v[4], v[5]); o.w = pk2(v[6], v[7]);
          *(GAS v4u*)(WL2 + (size_t)n * 384 + k0) = o; } }
    { float* rope = (float*)(ws + WS_ROPE);
      for (int idx = C.bid * 512 + C.tid; idx < 2056 * 8; idx += C.G * 512) { const int pos = idx >> 3, i = idx & 7;
          const double c = i == 0 ? 0.15915494309189535 : i == 1 ? 0.03086376340470123 : i == 2 ? 0.005985185712713705 : i == 3 ? 0.001160663641240061 :
                           i == 4 ? 0.00022507907903927653 : i == 5 ? 4.364795279280289e-05 : i == 6 ? 8.464330808241401e-06 : 1.6414262627950345e-06;
          const double rev = (double)pos * c; const float fr = (float)(rev - __builtin_floor(rev));
          rope[2 * idx] = __builtin_amdgcn_cosf(fr); rope[2 * idx + 1] = __builtin_amdgcn_sinf(fr); } }
    { const float* g0 = in.p[8]; const float* mu = in.p[9]; bf16* XM = (bf16*)(ws + WS_XM);
      for (int m = C.gw; m < M; m += C.NGW) {
          const bool pr = m < MP; const int t = pr ? (m & (PT - 1)) : ((m - MP) & (STN - 1)), b = pr ? (m >> 11) : ((m - MP) >> 3);
          const float* xr = pr ? in.p[0] + (size_t)m * D : in.p[1] + (size_t)(m - MP) * D;
          f32x4 v[4], pv[4]; float ss = 0.f, ps = 0.f;
#pragma unroll
          for (int j = 0; j < 4; ++j) { v[j] = *(const GAS f32x4*)(xr + 4 * C.lane + 256 * j); ss += (v[j].x * v[j].x + v[j].y * v[j].y) + (v[j].z * v[j].z + v[j].w * v[j].w); }
          if (t > 0) {
#pragma unroll
              for (int j = 0; j < 4; ++j) { pv[j] = *(const GAS f32x4*)(xr - D + 4 * C.lane + 256 * j); ps += (pv[j].x * pv[j].x + pv[j].y * pv[j].y) + (pv[j].z * pv[j].z + pv[j].w * pv[j].w); }
          } else {
#pragma unroll
              for (int j = 0; j < 4; ++j) pv[j] = pr ? (f32x4){0.f, 0.f, 0.f, 0.f} : *(const GAS f32x4*)(in.p[2] + (size_t)b * D + 4 * C.lane + 256 * j);
          }
          const float rs = 1.0f / sqrtf(wave_sum(ss) * (1.f / D) + NORM_EPS), prs = 1.0f / sqrtf(wave_sum(ps) * (1.f / D) + NORM_EPS);
          const bool last = pr ? (t == PT - 1) : (t == STN - 1);
#pragma unroll
          for (int j = 0; j < 4; ++j) { const int col = 4 * C.lane + 256 * j; const f32x4 g = *(const GAS f32x4*)(g0 + col);
              const f32x4 hn = v[j] * rs * g; const f32x4 hp = t > 0 ? pv[j] * prs * g : pv[j]; const f32x4 xx = hp - hn;
              if (last) *(GAS f32x4*)(out + (pr ? O_PSHIFT : O_SSHIFT) + (size_t)b * D + col) = hn;
#pragma unroll
              for (int i = 0; i < 6; ++i) { const f32x4 mm = *(const GAS f32x4*)(mu + i * D + col); const f32x4 r = hn + xx * mm;
                  const int slot = i == 1 ? 3 : (i == 2 ? 1 : (i == 3 ? 2 : i));
                  v2u o; o.x = pk2(r.x, r.y); o.y = pk2(r.z, r.w); *(GAS v2u*)(XM + (size_t)slot * M * D + (size_t)m * D + col) = o; } }
      } }
}

constexpr int SC_OPS = 0, SC_OPS_BYTES = 16 * 16 * 20 * 4, SC_VV = 2 * SC_OPS_BYTES, SC_VV_BYTES = 16 * 32 * 4, SC_YB = SC_VV + 2 * SC_VV_BYTES, SC_YB_BYTES = 16 * 32 * 4;
struct ScanItem { size_t tok; int b, h, vh, nt; bool prompt, first, last, valid; };
__device__ __forceinline__ ScanItem scan_item(int q, int bid, int G) {
    ScanItem it; const int npu = (PB * RH * 2 - bid + G - 1) / G, npi = npu > 0 ? npu * 128 : 0;
    if (q < npi) { const int u = bid + (q >> 7) * G, c = q & 127; it.b = u >> 5; it.h = (u >> 1) & 15; it.vh = u & 1; it.tok = (size_t)it.b * PT + 16 * c; it.nt = 16; it.prompt = true; it.first = c == 0; it.last = c == 127; it.valid = true; }
    else { const int su = bid + (q - npi) * G; it.valid = su < SBN * RH * 2; it.b = su >> 5; it.h = (su >> 1) & 15; it.vh = su & 1; it.tok = (size_t)MP + (size_t)it.b * STN; it.nt = 8; it.prompt = false; it.first = true; it.last = true; }
    return it;
}
__device__ __forceinline__ void scan_phase(const Ctx& C, const In& in, unsigned char* ws, float* out) {
    const float* Rb = (const float*)(ws + WS_R); const float* Kb = (const float*)(ws + WS_K); const float* Vb = (const float*)(ws + WS_V);
    const float* Db = (const float*)(ws + WS_DC); const float* Ab = (const float*)(ws + WS_AA); float* Yb = (float*)(ws + WS_Y); float* Bon = (float*)(ws + WS_BONUS);
    const int row = C.tid >> 4, p = C.tid & 15;
    LAS float* OPS = (LAS float*)(C.lds + SC_OPS); LAS float* VV = (LAS float*)(C.lds + SC_VV); LAS float* YB = (LAS float*)(C.lds + SC_YB);
    const bool stg = C.tid < 256, stv = C.tid >= 256 && C.tid < 384; const int vt = (C.tid - 256) >> 3, vq = (C.tid - 256) & 7;
    f32x4 lr, lk, ld, la, lv, Snext; lr = lk = ld = la = lv = Snext = (f32x4){0.f, 0.f, 0.f, 0.f};
#define SC_FETCH(it) do { if ((it).valid) { \
        if (stg && row < (it).nt) { const size_t o = ((it).tok + row) * D + (it).h * 64 + 4 * p; lr = *(const GAS f32x4*)(Rb + o); lk = *(const GAS f32x4*)(Kb + o); ld = *(const GAS f32x4*)(Db + o); la = *(const GAS f32x4*)(Ab + o); } \
        if (stv && vt < (it).nt) lv = *(const GAS f32x4*)(Vb + ((it).tok + vt) * D + (it).h * 64 + 32 * (it).vh + 4 * vq); \
        if ((it).first && !(it).prompt) Snext = *(const GAS f32x4*)(in.p[3] + ((((size_t)(it).b * RH + (it).h) * 64 + 32 * (it).vh + row) * 64 + 4 * p)); } } while (0)
#define SC_STAGE(it, buf) do { if ((it).valid) { \
        if (stg && row < (it).nt) { const int col = (it).h * 64 + 4 * p; const f32x4 ka = *(const GAS f32x4*)(in.p[23] + col), kw = *(const GAS f32x4*)(in.p[22] + col), rk = *(const GAS f32x4*)(in.p[24] + col); \
            const f32x4 kp = lk * (1.0f + (la - 1.0f) * ka), kr = lk * kw; const float n2 = row16_sum((kr.x * kr.x + kr.y * kr.y) + (kr.z * kr.z + kr.w * kr.w)); \
            const f32x4 kn = kr * (1.0f / fmaxf(sqrtf(n2), 1e-12f)); const f32x4 rb = lr * kp * rk; const float bon = row16_sum((rb.x + rb.y) + (rb.z + rb.w)); \
            LAS f32x4* o = (LAS f32x4*)(OPS + (buf) * (SC_OPS_BYTES / 4) + (row * 16 + p) * 20); o[0] = kn; o[1] = ld; o[2] = kp; o[3] = lr; o[4] = kn * la; \
            if ((it).vh == 0 && p == 0) Bon[((it).tok + row) * 16 + (it).h] = bon; } \
        if (stv && vt < (it).nt) *(LAS f32x4*)(VV + (buf) * (SC_VV_BYTES / 4) + vt * 32 + 4 * vq) = lv; } } while (0)
#define SC_STEP(tl) do { const f32x4 kk = op[(tl) * 80 + 0], dd = op[(tl) * 80 + 1], kp = op[(tl) * 80 + 2], rr = op[(tl) * 80 + 3], kka = op[(tl) * 80 + 4]; const float vv = vvp[(tl) * 32]; \
        f32x2 t_ = S01 * kk.lo; t_ = S23 * kk.hi + t_; const float sk = row16_sum(t_.x + t_.y); const f32x2 vv2 = (f32x2){vv, vv}, sk2 = (f32x2){sk, sk}; \
        S01 = S01 * dd.lo; S01 = kp.lo * vv2 + S01; S01 = S01 - kka.lo * sk2; S23 = S23 * dd.hi; S23 = kp.hi * vv2 + S23; S23 = S23 - kka.hi * sk2; \
        f32x2 u_ = S01 * rr.lo; u_ = S23 * rr.hi + u_; const float y = row16_sum(u_.x + u_.y); ykeep = (p == (tl)) ? y : ykeep; } while (0)
    ScanItem cur = scan_item(0, C.bid, C.G);
    if (!cur.valid) return;
    SC_FETCH(cur); SC_STAGE(cur, 0);
    f32x4 S = cur.prompt ? (f32x4){0.f, 0.f, 0.f, 0.f} : Snext; f32x2 S01 = S.lo, S23 = S.hi;
    __syncthreads();
    for (int q = 0; cur.valid; ++q) {
        const int buf = q & 1; const ScanItem nxt = scan_item(q + 1, C.bid, C.G);
        SC_FETCH(nxt);
        float ykeep = 0.f;
        const LAS f32x4* op = (const LAS f32x4*)(OPS + buf * (SC_OPS_BYTES / 4) + p * 20); const LAS float* vvp = VV + buf * (SC_VV_BYTES / 4) + row;
        SC_STEP(0); SC_STEP(1); SC_STEP(2); SC_STEP(3); SC_STEP(4); SC_STEP(5); SC_STEP(6); SC_STEP(7);
        if (cur.nt == 16) { SC_STEP(8); SC_STEP(9); SC_STEP(10); SC_STEP(11); SC_STEP(12); SC_STEP(13); SC_STEP(14); SC_STEP(15); }
        if (p < cur.nt) YB[buf * (SC_YB_BYTES / 4) + p * 32 + row] = ykeep;
        if (cur.last) *(GAS f32x4*)(out + (cur.prompt ? O_PWKV : O_SWKV) + ((((size_t)cur.b * RH + cur.h) * 64 + 32 * cur.vh + row) * 64 + 4 * p)) = (f32x4){S01.x, S01.y, S23.x, S23.y};
        SC_STAGE(nxt, buf ^ 1);
        if (nxt.valid && nxt.first) { S = nxt.prompt ? (f32x4){0.f, 0.f, 0.f, 0.f} : Snext; S01 = S.lo; S23 = S.hi; }
        __syncthreads();
        { const int tl = C.tid >> 5, rr = C.tid & 31; if (tl < cur.nt) Yb[(cur.tok + tl) * D + cur.h * 64 + 32 * cur.vh + rr] = YB[buf * (SC_YB_BYTES / 4) + tl * 32 + rr]; }
        cur = nxt;
    }
#undef SC_FETCH
#undef SC_STAGE
#undef SC_STEP
}
__device__ __forceinline__ void scan_post_phase(const Ctx& C, const In& in, unsigned char* ws) {
    const float* Yb = (const float*)(ws + WS_Y); const float* Vb = (const float*)(ws + WS_V); const float* Gb = (const float*)(ws + WS_GG); const float* Bon = (const float*)(ws + WS_BONUS);
    bf16* YG = (bf16*)(ws + WS_YG); const float* lg = in.p[25]; const float* lb = in.p[26];
    for (int m = C.gw; m < M; m += C.NGW) {
#pragma unroll
        for (int j = 0; j < 4; ++j) { const int col = 4 * C.lane + 256 * j, head = 4 * j + (C.lane >> 4); const size_t o = (size_t)m * D + col;
            const f32x4 y = *(const GAS f32x4*)(Yb + o); const float mean = row16_sum((y.x + y.y) + (y.z + y.w)) * (1.f / 64.f);
            const f32x4 d = y - mean; const float var = row16_sum((d.x * d.x + d.y * d.y) + (d.z * d.z + d.w * d.w)) * (1.f / 64.f);
            const float rs = 1.0f / sqrtf(var + GN_EPS), bon = Bon[(size_t)m * 16 + head];
            const f32x4 vv = *(const GAS f32x4*)(Vb + o), gg = *(const GAS f32x4*)(Gb + o), g4 = *(const GAS f32x4*)(lg + col), b4 = *(const GAS f32x4*)(lb + col);
            const f32x4 r = (d * rs * g4 + b4 + vv * bon) * gg;
            v2u w; w.x = pk2(r.x, r.y); w.y = pk2(r.z, r.w); *(GAS v2u*)(YG + o) = w; }
    }
}
__device__ __forceinline__ void rowwise_phase(const Ctx& C, const In& in, const float* xin, const float* mo, const float* g1, float* xout, const float* g2, bf16* xn) {
    for (int m = C.gw; m < M; m += C.NGW) {
        const float* xr = xin ? xin + (size_t)m * D : (m < MP ? in.p[0] + (size_t)m * D : in.p[1] + (size_t)(m - MP) * D);
        f32x4 a[4], x[4]; float ss = 0.f;
#pragma unroll
        for (int j = 0; j < 4; ++j) { a[j] = *(const GAS f32x4*)(mo + (size_t)m * D + 4 * C.lane + 256 * j); x[j] = *(const GAS f32x4*)(xr + 4 * C.lane + 256 * j);
            ss += (a[j].x * a[j].x + a[j].y * a[j].y) + (a[j].z * a[j].z + a[j].w * a[j].w); }
        const float rs = 1.0f / sqrtf(wave_sum(ss) * (1.f / D) + NORM_EPS); float s2 = 0.f;
#pragma unroll
        for (int j = 0; j < 4; ++j) { const int col = 4 * C.lane + 256 * j; x[j] = x[j] + a[j] * rs * *(const GAS f32x4*)(g1 + col);
            *(GAS f32x4*)(xout + (size_t)m * D + col) = x[j]; s2 += (x[j].x * x[j].x + x[j].y * x[j].y) + (x[j].z * x[j].z + x[j].w * x[j].w); }
        if (xn) { const float r2 = 1.0f / sqrtf(wave_sum(s2) * (1.f / D) + NORM_EPS);
#pragma unroll
            for (int j = 0; j < 4; ++j) { const int col = 4 * C.lane + 256 * j; const f32x4 r = x[j] * r2 * *(const GAS f32x4*)(g2 + col);
                v2u w; w.x = pk2(r.x, r.y); w.y = pk2(r.z, r.w); *(GAS v2u*)(xn + (size_t)m * D + col) = w; } }
    }
}
__device__ __forceinline__ float gelu_tanh(float x) { const float u = 0.7978845608028654f * (x + 0.044715f * x * x * x); return 0.5f * x * (1.0f + fast_tanh(u)); }
__device__ __forceinline__ void unpack8(const v4u w, float* f) { f[0] = bflo(w.x); f[1] = bfhi(w.x); f[2] = bflo(w.y); f[3] = bfhi(w.y); f[4] = bflo(w.z); f[5] = bfhi(w.z); f[6] = bflo(w.w); f[7] = bfhi(w.w); }
__device__ __forceinline__ void fixup_phase(const Ctx& C, unsigned char* ws, const float* cw, const float* cb, const float* sc) {
    const float* HALO = (const float*)(ws + WS_HID); const float* RAWS = (const float*)(ws + WS_HID + 8 * MiB); bf16* ACT = (bf16*)(ws + WS_ACT);
    constexpr int NC4 = FF / 4, NPROMPT = 56 * 2 * NC4, NSAMPLE = SBN * 2 * NC4;
    for (int idx = C.bid * 512 + C.tid; idx < NPROMPT + NSAMPLE; idx += C.G * 512) {
        const float *p0[2], *p1[2], *p2[2]; int c; size_t orow;
        if (idx < NPROMPT) { const int q = idx / NC4, r = q & 1, pi = q >> 1, pm = (pi / 7) * 8 + 1 + (pi % 7); c = (idx % NC4) * 4; orow = (size_t)pm * 256 + r;
#pragma unroll
            for (int s = 0; s < 2; ++s) { const size_t co = (size_t)s * FF + c; p0[s] = HALO + ((size_t)pm * 4 + r) * F2 + co;
                p1[s] = HALO + (r == 1 ? ((size_t)pm * 4 + 0) : ((size_t)(pm - 1) * 4 + 3)) * F2 + co; p2[s] = HALO + ((size_t)(pm - 1) * 4 + (r == 0 ? 2 : 3)) * F2 + co; }
        } else { const int q = (idx - NPROMPT) / NC4, t = q & 1, b = q >> 1, rs = b * 8 + t; c = ((idx - NPROMPT) % NC4) * 4; orow = (size_t)MP + rs;
#pragma unroll
            for (int s = 0; s < 2; ++s) { const size_t co = (size_t)s * FF + c; p0[s] = RAWS + (size_t)rs * F2 + co;
                p1[s] = t == 0 ? sc + ((size_t)b * 2 + 1) * F2 + co : RAWS + (size_t)(rs - 1) * F2 + co; p2[s] = sc + ((size_t)b * 2 + t) * F2 + co; }
        }
        f32x4 cv[2];
#pragma unroll
        for (int s = 0; s < 2; ++s) { const size_t co = (size_t)s * FF + c; const f32x4 h0 = *(const GAS f32x4*)p0[s], h1 = *(const GAS f32x4*)p1[s], h2 = *(const GAS f32x4*)p2[s];
            cv[s] = *(const GAS f32x4*)(cb + co) + *(const GAS f32x4*)(cw + co) * h2 + *(const GAS f32x4*)(cw + F2 + co) * h1 + *(const GAS f32x4*)(cw + 2 * F2 + co) * h0; }
        v2u o; o.x = pk2(gelu_tanh(cv[0].x) * cv[1].x, gelu_tanh(cv[0].y) * cv[1].y); o.y = pk2(gelu_tanh(cv[0].z) * cv[1].z, gelu_tanh(cv[0].w) * cv[1].w);
        *(GAS v2u*)(ACT + orow * FF + c) = o; }
}

constexpr float QSCALE = 0.125f * 1.4426950408889634f;
__device__ __forceinline__ void rope_phase(const Ctx& C, const In& in, unsigned char* ws, float* out) {
    bf16* QKV = (bf16*)(ws + WS_QKV); const float* rope = (const float*)(ws + WS_ROPE);
    for (int m = C.gw; m < M; m += C.NGW) {
        const bool pr = m < MP; const int t = pr ? (m & (PT - 1)) : ((m - MP) & 7), b = pr ? (m >> 11) : ((m - MP) >> 3), pos = pr ? t : PT + t;
        bf16* rowp = QKV + (size_t)m * NQKV;
        f32x4 cs0 = *(const GAS f32x4*)(rope + (size_t)pos * 16), cs1 = *(const GAS f32x4*)(rope + (size_t)pos * 16 + 4), cs2 = *(const GAS f32x4*)(rope + (size_t)pos * 16 + 8), cs3 = *(const GAS f32x4*)(rope + (size_t)pos * 16 + 12);
        const float cc[8] = {cs0.x, cs0.z, cs1.x, cs1.z, cs2.x, cs2.z, cs3.x, cs3.z}, sn[8] = {cs0.y, cs0.w, cs1.y, cs1.w, cs2.y, cs2.w, cs3.y, cs3.w};
#pragma unroll
        for (int it = 0; it < 9; ++it) {
            const int c8 = C.lane + 64 * it, col0 = 8 * c8, s = col0 / 1536, rem = col0 % 1536, g = rem / 512, h = (rem % 512) / 64, e0 = rem % 64;
            const v4u own = *(const GAS v4u*)(rowp + col0);
            const bool rot = (s < 2) && (e0 < 16);
            v4u par = own; if (rot) par = *(const GAS v4u*)(rowp + col0 + (e0 == 0 ? 8 : -8));
            float x[8], y[8], o[8]; unpack8(own, x); unpack8(par, y);
#pragma unroll
            for (int i = 0; i < 8; ++i) o[i] = !rot ? x[i] : (e0 == 0 ? x[i] * cc[i] - y[i] * sn[i] : x[i] * cc[i] + y[i] * sn[i]);
            if (s == 0) {
#pragma unroll
                for (int i = 0; i < 8; ++i) o[i] *= QSCALE; }
            if (s < 2) { v4u w; w.x = pk2(o[0], o[1]); w.y = pk2(o[2], o[3]); w.z = pk2(o[4], o[5]); w.w = pk2(o[6], o[7]); *(GAS v4u*)(rowp + col0) = w; }
            if (s >= 1) {
                const int L = g == 0 ? 128 : (g == 1 ? 512 : 2048); float* dst = nullptr;
                if (pr) { const int j = t - (PT - L); if (j >= 0) dst = out + (g == 0 ? O_PKV128 : (g == 1 ? O_PKV512 : O_PKV2048)) + ((((size_t)b * L + j) * 2 + (s - 1)) * 8 + h) * 64 + e0; }
                else dst = out + (g == 0 ? O_SKV128 : (g == 1 ? O_SKV512 : O_SKV2048)) + ((((size_t)b * 8 + t) * 2 + (s - 1)) * 8 + h) * 64 + e0;
                if (dst) { *(GAS f32x4*)dst = (f32x4){o[0], o[1], o[2], o[3]}; *(GAS f32x4*)(dst + 4) = (f32x4){o[4], o[5], o[6], o[7]}; } }
        }
    }
}

constexpr int AT_RS = 160;
constexpr int AT_K = 0, AT_V = 256 * AT_RS;
typedef short s16x4 __attribute__((ext_vector_type(4)));
__device__ __forceinline__ s16x4 lds_tr16(const LAS unsigned char* p) { return __builtin_bit_cast(s16x4, __builtin_amdgcn_ds_read_tr16_b64_v4i16((LAS s16x4*)p)); }
struct PUnit { int b, h, g, res, n; };
__device__ __forceinline__ PUnit punit(int u) { PUnit r; const int bh = u / 48, j = u % 48; r.b = bh >> 3; r.h = bh & 7;
    if (j < 16) { r.g = 0; r.res = 0; r.n = j; } else if (j < 32) { r.g = 1; r.res = (j - 16) >> 2; r.n = (j - 16) & 3; } else { r.g = 2; r.res = j - 32; r.n = 0; } return r; }
__device__ __forceinline__ void pattn_load(const Ctx& C, const bf16* QKV, const PUnit& u, v4u (&kr)[4], v4u (&vr)[4]) {
    const int Dl = u.g == 0 ? 1 : (u.g == 1 ? 4 : 16);
#pragma unroll
    for (int i = 0; i < 4; ++i) { const int ch = C.tid + 512 * i, kj = ch >> 3, c = ch & 7; int lk = (u.n - 1) * 128 + kj; lk = lk < 0 ? 0 : lk;
        const bf16* rp = QKV + ((size_t)u.b * PT + u.res + Dl * lk) * NQKV + u.h * 64 + c * 8;
        kr[i] = *(const GAS v4u*)(rp + (3 + u.g) * 512); vr[i] = *(const GAS v4u*)(rp + (6 + u.g) * 512); }
}
__device__ __forceinline__ void pattn_store_lds(const Ctx& C, const v4u (&kr)[4], const v4u (&vr)[4]) {
#pragma unroll
    for (int i = 0; i < 4; ++i) { const int ch = C.tid + 512 * i, kj = ch >> 3, c = ch & 7;
        *(LAS v4u*)(C.lds + AT_K + kj * AT_RS + c * 16) = kr[i]; *(LAS v4u*)(C.lds + AT_V + kj * AT_RS + c * 16) = vr[i]; }
}
__device__ __forceinline__ void pattn_compute(const Ctx& C, unsigned char* ws, const PUnit& u) {
    const bf16* QKV = (const bf16*)(ws + WS_QKV); bf16* OG = (bf16*)(ws + WS_OG); float* LSE = (float*)(ws + WS_LSE);
    const int Dl = u.g == 0 ? 1 : (u.g == 1 ? 4 : 16), q16 = C.lane & 15, g4 = C.lane >> 4, qi = 16 * C.wave + q16;
    const size_t qrow = (size_t)u.b * PT + u.res + Dl * (u.n * 128 + qi);
    const bf16* qp = QKV + qrow * NQKV + u.g * 512 + u.h * 64;
    const bf16x8 qf0 = *(const GAS bf16x8*)(qp + 8 * g4), qf1 = *(const GAS bf16x8*)(qp + 32 + 8 * g4);
    f32x4 sc[16];
    const LAS unsigned char* kbase = C.lds + AT_K + q16 * AT_RS + g4 * 16;
#pragma unroll
    for (int T = 0; T < 16; ++T) { const bf16x8 k0 = *(const LAS bf16x8*)(kbase + T * 16 * AT_RS), k1 = *(const LAS bf16x8*)(kbase + T * 16 * AT_RS + 64);
        f32x4 a = __builtin_amdgcn_mfma_f32_16x16x32_bf16(k0, qf0, (f32x4){0.f, 0.f, 0.f, 0.f}, 0, 0, 0); sc[T] = __builtin_amdgcn_mfma_f32_16x16x32_bf16(k1, qf1, a, 0, 0, 0); }
    const int klo = (u.n == 0 && qi < 128) ? 128 : qi; float mx = -1e30f;
#pragma unroll
    for (int T = 0; T < 16; ++T)
#pragma unroll
        for (int j = 0; j < 4; ++j) { const int kj = 16 * T + 4 * g4 + j; const bool ok = kj >= klo && kj <= qi + 128; sc[T][j] = ok ? sc[T][j] : -1e30f; mx = fmaxf(mx, sc[T][j]); }
    mx = fmaxf(mx, __shfl_xor(mx, 16)); mx = fmaxf(mx, __shfl_xor(mx, 32));
    float sum = 0.f;
#pragma unroll
    for (int T = 0; T < 16; ++T)
#pragma unroll
        for (int j = 0; j < 4; ++j) { const float p = __builtin_amdgcn_exp2f(sc[T][j] - mx); sc[T][j] = p; sum += p; }
    sum += __shfl_xor(sum, 16); sum += __shfl_xor(sum, 32);
    f32x4 oa[4] = {(f32x4){0.f, 0.f, 0.f, 0.f}, (f32x4){0.f, 0.f, 0.f, 0.f}, (f32x4){0.f, 0.f, 0.f, 0.f}, (f32x4){0.f, 0.f, 0.f, 0.f}};
    const LAS unsigned char* vbase = C.lds + AT_V + (4 * g4 + (q16 >> 2)) * AT_RS + (q16 & 3) * 8;
#pragma unroll
    for (int s = 0; s < 8; ++s) {
        pg8::u32x4 pw; pw.x = pg8::cvt_pk_bf16(sc[2 * s][0], sc[2 * s][1]); pw.y = pg8::cvt_pk_bf16(sc[2 * s][2], sc[2 * s][3]); pw.z = pg8::cvt_pk_bf16(sc[2 * s + 1][0], sc[2 * s + 1][1]); pw.w = pg8::cvt_pk_bf16(sc[2 * s + 1][2], sc[2 * s + 1][3]);
        const bf16x8 pf = __builtin_bit_cast(bf16x8, pw);
#pragma unroll
        for (int c = 0; c < 4; ++c) { const s16x4 lo = lds_tr16(vbase + (32 * s) * AT_RS + c * 32), hi = lds_tr16(vbase + (32 * s + 16) * AT_RS + c * 32);
            const bf16x8 vf = (bf16x8){lo[0], lo[1], lo[2], lo[3], hi[0], hi[1], hi[2], hi[3]};
            oa[c] = __builtin_amdgcn_mfma_f32_16x16x32_bf16(vf, pf, oa[c], 0, 0, 0); }
    }
    const float inv = 1.0f / sum;
    bf16* op = OG + ((size_t)u.g * M + qrow) * AW + u.h * 64 + 4 * g4;
#pragma unroll
    for (int c = 0; c < 4; ++c) { v2u w; w.x = pk2(oa[c][0] * inv, oa[c][1] * inv); w.y = pk2(oa[c][2] * inv, oa[c][3] * inv); *(GAS v2u*)(op + 16 * c) = w; }
    if (g4 == 0) LSE[((size_t)u.g * M + qrow) * 8 + u.h] = mx + __builtin_amdgcn_logf(sum);
}
__device__ __forceinline__ void sattn_unit(const Ctx& C, const float* cache_g, unsigned char* ws, const float* out, int b, int g, int h) {
    const bf16* QKV = (const bf16*)(ws + WS_QKV); bf16* OG = (bf16*)(ws + WS_OG); float* LSE = (float*)(ws + WS_LSE);
    const int L = g == 0 ? 128 : (g == 1 ? 512 : 2048), Dl = g == 0 ? 1 : (g == 1 ? 4 : 16), i = C.wave, d16 = C.lane & 15, sub = C.lane >> 4;
    const size_t qrow = (size_t)MP + (size_t)b * 8 + i;
    const v2u qw = *(const GAS v2u*)(QKV + qrow * NQKV + g * 512 + h * 64 + 4 * d16);
    const f32x4 q = (f32x4){bflo(qw.x), bfhi(qw.x), bflo(qw.y), bfhi(qw.y)};
    const float* cache = cache_g + (size_t)b * L * 1024 + h * 64 + 4 * d16;
    const float* fresh = out + (g == 0 ? O_SKV128 : (g == 1 ? O_SKV512 : O_SKV2048)) + (size_t)b * 8 * 1024 + h * 64 + 4 * d16;
    float s[33]; float mx = -1e30f;
#pragma unroll
    for (int it = 0; it < 33; ++it) { const int j = 4 * it + sub; const bool ok = j <= 128; const int idx = L + i - Dl * (ok ? j : 0);
        const float* kp = idx >= L ? fresh + (size_t)(idx - L) * 1024 : cache + (size_t)idx * 1024;
        const f32x4 kv = *(const GAS f32x4*)kp;
        float d = (q.x * kv.x + q.y * kv.y) + (q.z * kv.z + q.w * kv.w); d = row16_sum(d);
        s[it] = ok ? d : -1e30f; mx = fmaxf(mx, s[it]); }
    mx = fmaxf(mx, __shfl_xor(mx, 16)); mx = fmaxf(mx, __shfl_xor(mx, 32));
    float sum = 0.f; f32x4 o = (f32x4){0.f, 0.f, 0.f, 0.f};
#pragma unroll
    for (int it = 0; it < 33; ++it) { const int j = 4 * it + sub; const bool ok = j <= 128; const int idx = L + i - Dl * (ok ? j : 0);
        const float* vp = (idx >= L ? fresh + (size_t)(idx - L) * 1024 : cache + (size_t)idx * 1024) + 512;
        const f32x4 vv = *(const GAS f32x4*)vp; const float p = __builtin_amdgcn_exp2f(s[it] - mx); sum += p; o = o + vv * p; }
    sum += __shfl_xor(sum, 16); sum += __shfl_xor(sum, 32);
#pragma unroll
    for (int e = 0; e < 4; ++e) { o[e] += __shfl_xor(o[e], 16); o[e] += __shfl_xor(o[e], 32); }
    if (sub == 0) { const float inv = 1.0f / sum; v2u w; w.x = pk2(o.x * inv, o.y * inv); w.y = pk2(o.z * inv, o.w * inv);
        *(GAS v2u*)(OG + ((size_t)g * M + qrow) * AW + h * 64 + 4 * d16) = w;
        if (d16 == 0) LSE[((size_t)g * M + qrow) * 8 + h] = mx + __builtin_amdgcn_logf(sum); }
}
typedef const __attribute__((address_space(4))) In* KInP;
__device__ __forceinline__ void attn_phase(const Ctx& C, KInP kp, unsigned char* ws, float* out) {
    const bf16* QKV = (const bf16*)(ws + WS_QKV);
    constexpr int NPU = PB * 8 * 48;
    v4u kr[4], vr[4];
    int u = C.bid;
    if (u < NPU) { const PUnit pu = punit(u); pattn_load(C, QKV, pu, kr, vr); }
    for (; u < NPU; u += C.G) {
        const PUnit pu = punit(u);
        pattn_store_lds(C, kr, vr);
        __syncthreads();
        if (u + C.G < NPU) { const PUnit nu = punit(u + C.G); pattn_load(C, QKV, nu, kr, vr); }
        pattn_compute(C, ws, pu);
        __syncthreads();
    }
#ifndef ATTN_REP_SAMPLE
#define ATTN_REP_SAMPLE 1
#endif
    for (int rep_ = 0; rep_ < ATTN_REP_SAMPLE; ++rep_)
    for (int su = C.bid; su < SBN * 3 * 8; su += C.G) { const int h = su & 7, b = (su >> 3) & 127, g = su >> 10; const float* cache_g = kp->p[4 + (2 - g)];
        sattn_unit(C, cache_g, ws, out, b, 2 - g, h); }
}
__device__ __forceinline__ void merge_phase(const Ctx& C, unsigned char* ws) {
    const bf16* OG = (const bf16*)(ws + WS_OG); const float* LSE = (const float*)(ws + WS_LSE); bf16* OM = (bf16*)(ws + WS_OM);
    for (int idx = C.bid * 512 + C.tid; idx < M * 64; idx += C.G * 512) { const int m = idx >> 6, c8 = idx & 63, h = c8 >> 3;
        const float l0 = LSE[((size_t)0 * M + m) * 8 + h], l1 = LSE[((size_t)1 * M + m) * 8 + h], l2 = LSE[((size_t)2 * M + m) * 8 + h];
        const float mx = fmaxf(l0, fmaxf(l1, l2)); float w0 = __builtin_amdgcn_exp2f(l0 - mx), w1 = __builtin_amdgcn_exp2f(l1 - mx), w2 = __builtin_amdgcn_exp2f(l2 - mx);
        const float inv = 1.0f / (w0 + w1 + w2); w0 *= inv; w1 *= inv; w2 *= inv;
        float a[8], b[8], c[8];
        unpack8(*(const GAS v4u*)(OG + ((size_t)0 * M + m) * AW + 8 * c8), a); unpack8(*(const GAS v4u*)(OG + ((size_t)1 * M + m) * AW + 8 * c8), b); unpack8(*(const GAS v4u*)(OG + ((size_t)2 * M + m) * AW + 8 * c8), c);
        float o[8];
#pragma unroll
        for (int e = 0; e < 8; ++e) o[e] = w0 * a[e] + w1 * b[e] + w2 * c[e];
        v4u w; w.x = pk2(o[0], o[1]); w.y = pk2(o[2], o[3]); w.z = pk2(o[4], o[5]); w.w = pk2(o[6], o[7]);
        *(GAS v4u*)(OM + (size_t)m * AW + 8 * c8) = w; }
}

#ifndef MK_ONE_LAUNCH
#define MK_ONE_LAUNCH 1
#endif
#ifndef REP_MASK
#define REP_MASK 0
#endif
#ifndef ONLY
#define ONLY -1
#endif
constexpr int N_PHASES = 21;
struct Args { In in; float* out; unsigned char* ws; int ph_lo, ph_hi; };
typedef const __attribute__((address_space(4))) In* KIn;
__device__ __forceinline__ KIn launder_kernarg() { unsigned long long p = (unsigned long long)__builtin_amdgcn_kernarg_segment_ptr(); asm volatile("" : "+s"(p)); return (KIn)p; }
#define IN_LOAD() In in; { KIn kp_ = launder_kernarg(); _Pragma("unroll") for (int i_ = 0; i_ < 33; ++i_) in.p[i_] = kp_->p[i_]; }
#define GEMM_PHASE(EPI, Aoff, Boff, Nn, Kk, ASEL, ...) { pg8::Gemm g{(const bf16*)(ws + (Aoff)), (const bf16*)(ws + (Boff)), M, (Nn), (Kk), (ASEL)}; pg8::StaticOrder S; S.init(M, (Nn), C.G, C.bid); \
        pg8::EPI E{__VA_ARGS__}; pg8::gemm_phase<pg8::EPI, pg8::StaticOrder, true, true>(ring, g, S, E); }
#define DOWN_PHASE(Boff, layer) GEMM_PHASE(EpiF32, WS_ACT, Boff, D, FF, 0, (float*)(ws + WS_MO), D)
#define FIX_PHASE(layer) { IN_LOAD(); fixup_phase(C, ws, in.p[30] + (size_t)(layer) * 3 * F2, in.p[31] + (size_t)(layer) * F2, in.p[7] + (size_t)(layer) * SBN * 2 * F2); }
#define UP_PHASE(Boff, layer) { IN_LOAD(); GEMM_PHASE(EpiConv, WS_XN, Boff, F2, D, 0, (bf16*)(ws + WS_ACT), (float*)(ws + WS_HID), (float*)(ws + WS_HID + 8 * MiB), out + O_PCONV + (size_t)(layer) * PB * 2 * F2, out + O_SCONV + (size_t)(layer) * SBN * 2 * F2, \
        in.p[30] + (size_t)(layer) * 3 * F2, in.p[31] + (size_t)(layer) * F2, (LAS float*)(C.lds + EX_OFF)) }

#define PBODY_0 { IN_LOAD(); p0_prologue(C, in, ws, out); }
#define PBODY_1 GEMM_PHASE(EpiG1, WS_XM, WS_W1CAT, 3840, D, RB16, (float*)(ws + WS_R), (bf16*)(ws + WS_L2A))
#define PBODY_2 { IN_LOAD(); GEMM_PHASE(EpiL2, WS_L2A, WS_WL2, 3072, 384, 0, (float*)(ws + WS_DC), in.p[14], in.p[17]) }
#define PBODY_3 { IN_LOAD(); scan_phase(C, in, ws, out); }
#define PBODY_4 { IN_LOAD(); scan_post_phase(C, in, ws); }
#define PBODY_5 GEMM_PHASE(EpiF32, WS_YG, WS_WORW, D, D, 0, (float*)(ws + WS_MO), D)
#define PBODY_6 { IN_LOAD(); rowwise_phase(C, in, nullptr, (const float*)(ws + WS_MO), in.p[8] + 1 * D, (float*)(ws + WS_X1), in.p[8] + 2 * D, (bf16*)(ws + WS_XN)); }
#define PBODY_7 UP_PHASE(WS_WUP0, 0)
#define PBODY_8 FIX_PHASE(0)
#define PBODY_9 DOWN_PHASE(WS_WDN0, 0)
#define PBODY_10 { IN_LOAD(); rowwise_phase(C, in, (const float*)(ws + WS_X1), (const float*)(ws + WS_MO), in.p[8] + 3 * D, (float*)(ws + WS_X2), in.p[8] + 4 * D, (bf16*)(ws + WS_XN)); }
#define PBODY_11 GEMM_PHASE(EpiBf16, WS_XN, WS_WQKV, NQKV, D, 0, (bf16*)(ws + WS_QKV), NQKV)
#define PBODY_12 { IN_LOAD(); rope_phase(C, in, ws, out); }
#define PBODY_13 { attn_phase(C, launder_kernarg(), ws, out); }
#define PBODY_14 { merge_phase(C, ws); }
#define PBODY_15 GEMM_PHASE(EpiF32, WS_OM, WS_WOAT, D, AW, 0, (float*)(ws + WS_MO), D)
#define PBODY_16 { IN_LOAD(); rowwise_phase(C, in, (const float*)(ws + WS_X2), (const float*)(ws + WS_MO), in.p[8] + 5 * D, (float*)(ws + WS_X3), in.p[8] + 6 * D, (bf16*)(ws + WS_XN)); }
#define PBODY_17 UP_PHASE(WS_WUP1, 1)
#define PBODY_18 FIX_PHASE(1)
#define PBODY_19 DOWN_PHASE(WS_WDN1, 1)
#define PBODY_20 { IN_LOAD(); rowwise_phase(C, in, (const float*)(ws + WS_X3), (const float*)(ws + WS_MO), in.p[8] + 7 * D, out + O_YP, nullptr, nullptr); }

__global__ void __launch_bounds__(NWAVES * 64, 2) fwd(Args args) {
    extern __shared__ __attribute__((aligned(16))) unsigned char lds[];
    Ctx C; C.lds = (LAS unsigned char*)lds; C.tid = threadIdx.x; C.lane = C.tid & 63; C.wave = __builtin_amdgcn_readfirstlane(C.tid >> 6);
    C.G = gridDim.x; C.bid = blockIdx.x; C.gw = C.bid * NWAVES + C.wave; C.NGW = C.G * NWAVES;
    unsigned char* ws = args.ws; float* out = args.out;
    volatile LAS unsigned* MISC = (volatile LAS unsigned*)(C.lds + MISC_OFF);
    for (int u = C.tid; u < (LDS_BYTES - LDSCTL_OFF) / 4; u += NWAVES * 64) ((LAS unsigned*)(C.lds + LDSCTL_OFF))[u] = 0u;
    __syncthreads();
    XcdBarrier bar; bar.bar = (unsigned*)(ws + WS_CTL) + CW_BAR; bar.x = 0; bar.st = nullptr;
    const int lo = args.ph_lo, hi = args.ph_hi;
    if (hi - lo > 1) bar = xcd_barrier_post((unsigned*)(ws + WS_CTL) + CW_BAR, MISC + 8);
    LAS unsigned char* ring = C.lds + RING_OFF;
#define IN(k) ((ONLY < 0 || ONLY == (k)) && lo <= (k) && (k) < hi)
#define PHASE(k) if (IN(k)) PBODY_##k if (IN(k) && ((REP_MASK >> (k)) & 1)) { if (hi - lo > 1) xcd_barrier(bar); PBODY_##k } if (IN(k) && IN((k) + 1)) xcd_barrier(bar);
    PHASE(0) PHASE(1) PHASE(2) PHASE(3) PHASE(4) PHASE(5) PHASE(6) PHASE(7) PHASE(8) PHASE(9) PHASE(10) PHASE(11) PHASE(12) PHASE(13) PHASE(14) PHASE(15) PHASE(16) PHASE(17) PHASE(18) PHASE(19) PHASE(20)
#undef IN
#undef PHASE
}

extern "C" void kernel_launch(void* const* d_in, const int* in_sizes, int n_in, void* d_out, int out_size, void* d_ws, size_t ws_size, hipStream_t stream) {
    static int grid = 0;
    if (grid == 0) {
        if (n_in != 33 || (size_t)out_size != O_END || ws_size < WS_END) { fprintf(stderr, "kernel_launch: unexpected sizes: n_in %d out %d ws %zu (need %zu)\n", n_in, out_size, ws_size, (size_t)WS_END); grid = -1; return; }
        int dev = 0, cus = 0, per_cu = 0;
        if (hipGetDevice(&dev) != hipSuccess || hipDeviceGetAttribute(&cus, hipDeviceAttributeMultiprocessorCount, dev) != hipSuccess) { grid = -1; return; }
        if (hipFuncSetAttribute((const void*)fwd, hipFuncAttributeMaxDynamicSharedMemorySize, LDS_BYTES) != hipSuccess) { fprintf(stderr, "kernel_launch: hipFuncSetAttribute failed\n"); grid = -1; return; }
        if (hipOccupancyMaxActiveBlocksPerMultiprocessor(&per_cu, (const void*)fwd, NWAVES * 64, LDS_BYTES) != hipSuccess || per_cu < 1) { fprintf(stderr, "kernel_launch: occupancy query says %d\n", per_cu); }
        (void)hipGetLastError();
        grid = cus;
    }
    if (grid < 0) return;
    (void)hipMemsetAsync((char*)d_ws + WS_CTL, 0, CTL_ZERO_BYTES, stream);
    Args a{};
    for (int i = 0; i < 33; ++i) a.in.p[i] = (const float*)d_in[i];
    a.out = (float*)d_out; a.ws = (unsigned char*)d_ws;
#if MK_ONE_LAUNCH
    a.ph_lo = 0; a.ph_hi = N_PHASES;
    hipLaunchKernelGGL(fwd, dim3(grid), dim3(NWAVES * 64), LDS_BYTES, stream, a);
#else
    for (int ph = 0; ph < N_PHASES; ++ph) { a.ph_lo = ph; a.ph_hi = ph + 1; hipLaunchKernelGGL(fwd, dim3(grid), dim3(NWAVES * 64), LDS_BYTES, stream, a); }
#endif
}
```

```cpp
#include <hip/hip_runtime.h>
#include <cstdio>
#include <cstdint>
namespace pg8 {
#define PG8_LAS __attribute__((address_space(3)))
typedef unsigned short bf16_t;
typedef short bf16x8 __attribute__((ext_vector_type(8)));
typedef float f32x4 __attribute__((ext_vector_type(4)));
typedef float f32x2 __attribute__((ext_vector_type(2)));
typedef unsigned u32x4 __attribute__((ext_vector_type(4)));
typedef unsigned u32x2 __attribute__((ext_vector_type(2)));
constexpr int BM = 256, BK = 64, HALF = 128, HTB = HALF * BK * 2  , STAGE_BYTES = 8 * HTB, NXCD = 8, WGM = 8;

__host__ __device__ __forceinline__ int lds_byte(int r, int c) { const int st = (r >> 4) * 2 + (c >> 5), rr = r & 15, cc = c & 31, ob = rr * 64 + cc * 2; return st * 1024 + (ob ^ (((ob >> 9) & 1) << 5)); }
__host__ __device__ __forceinline__ void stage_rc(int b, int& R, int& C) { const int st = b / 1024, sb = b % 1024, swz = sb ^ (((sb >> 9) & 1) << 5); R = (st >> 1) * 16 + swz / 64; C = (st & 1) * 32 + (swz % 64) / 2; }
__host__ __device__ __forceinline__ int perm32(int rho) { const int n = rho >> 4, i = rho & 15; return 8 * (i >> 2) + 4 * n + (i & 3); }

struct Unit { int pm, pn; };
struct Gemm { const bf16_t* A; const bf16_t* Bt; int M, N, K; size_t a_sel_bytes; };

struct StaticOrder {
    int nM, nN, nwg, G, c;
    __host__ __device__ __forceinline__ void init(int M, int N, int G_, int c_) { nM = M / BM; nN = N / BM; nwg = nM * nN; G = G_; c = c_; }
    __host__ __device__ __forceinline__ bool next(int i, Unit& u) const {
        const long L = (long)i * G + c; if (L >= nwg) return false;
        int wgid = (int)L; { const int q = nwg / NXCD, r = nwg % NXCD, xcd = wgid % NXCD, off = wgid / NXCD; wgid = (xcd < r ? xcd * (q + 1) : r * (q + 1) + (xcd - r) * q) + off; }
        const int nig = WGM * nN, gid = wgid / nig, fm = gid * WGM, gsz = (nM - fm) < WGM ? (nM - fm) : WGM;
        u.pm = fm + ((wgid % nig) % gsz); u.pn = (wgid % nig) / gsz; return true;
    }
    __device__ __forceinline__ void a_ready(const Unit&) const {}
    __device__ __forceinline__ void done(const Unit&) const {}
};

__device__ __forceinline__ unsigned cvt_pk_bf16(float lo, float hi) { unsigned r; asm volatile("v_cvt_pk_bf16_f32 %0, %1, %2" : "=v"(r) : "v"(lo), "v"(hi)); return r; }
__device__ __forceinline__ float fast_tanh(float x) { return 1.0f - 2.0f / (1.0f + __expf(2.0f * x)); }
__device__ __forceinline__ float fast_sigmoid(float x) { return 1.0f / (1.0f + __expf(-x)); }

struct EpiF32 {
    static constexpr bool PERM = false, AFTER_DRAIN = false;
    static __device__ __forceinline__ int asel(int) { return 0; }
    float* C; int ldc;
    __device__ __forceinline__ void operator()(const f32x4 (&acc)[2][2][4][2], const Unit& u, int wr, int wc, int fr, int fq) const {
        const int row0 = u.pm * BM + wr * 64 + fr, col0 = u.pn * BM + wc * 32 + 4 * fq;
#pragma unroll
        for (int ai = 0; ai < 2; ++ai)
#pragma unroll
            for (int m = 0; m < 4; ++m) { float* rowp = C + (size_t)(row0 + ai * HALF + m * 16) * ldc + col0;
#pragma unroll
                for (int bj = 0; bj < 2; ++bj)
#pragma unroll
                    for (int n = 0; n < 2; ++n) *(f32x4*)(rowp + bj * HALF + n * 16) = acc[ai][bj][m][n]; }
    }
};
struct EpiBf16 {
    static constexpr bool PERM = true, AFTER_DRAIN = false;
    static __device__ __forceinline__ int asel(int) { return 0; }
    bf16_t* O; int ldc;
    __device__ __forceinline__ void operator()(const f32x4 (&acc)[2][2][4][2], const Unit& u, int wr, int wc, int fr, int fq) const {
        const int row0 = u.pm * BM + wr * 64 + fr, col0 = u.pn * BM + wc * 32 + 8 * fq;
#pragma unroll
        for (int ai = 0; ai < 2; ++ai)
#pragma unroll
            for (int m = 0; m < 4; ++m) { bf16_t* rowp = O + (size_t)(row0 + ai * HALF + m * 16) * ldc + col0;
#pragma unroll
                for (int bj = 0; bj < 2; ++bj) { const f32x4 v0 = acc[ai][bj][m][0], v1 = acc[ai][bj][m][1];
                    u32x4 w; w.x = cvt_pk_bf16(v0[0], v0[1]); w.y = cvt_pk_bf16(v0[2], v0[3]); w.z = cvt_pk_bf16(v1[0], v1[1]); w.w = cvt_pk_bf16(v1[2], v1[3]);
                    *(u32x4*)(rowp + bj * HALF) = w; } }
    }
};
constexpr size_t RKV_STRIDE = (size_t)17408 * 1024;
struct EpiG1 {
    static constexpr bool PERM = false, AFTER_DRAIN = false;
    static __device__ __forceinline__ int asel(int pn) { return pn < 12 ? (pn >> 2) : pn - 9; }
    float* RKV; bf16_t* L2A;
    __device__ __forceinline__ void operator()(const f32x4 (&acc)[2][2][4][2], const Unit& u, int wr, int wc, int fr, int fq) const {
        const int row0 = u.pm * BM + wr * 64 + fr;
        if (u.pn < 12) {
            float* base = RKV + (size_t)(u.pn >> 2) * RKV_STRIDE; const int col0 = (u.pn & 3) * BM + wc * 32 + 4 * fq;
#pragma unroll
            for (int ai = 0; ai < 2; ++ai)
#pragma unroll
                for (int m = 0; m < 4; ++m) { float* rowp = base + (size_t)(row0 + ai * HALF + m * 16) * 1024 + col0;
#pragma unroll
                    for (int bj = 0; bj < 2; ++bj)
#pragma unroll
                        for (int n = 0; n < 2; ++n) *(f32x4*)(rowp + bj * HALF + n * 16) = acc[ai][bj][m][n]; }
        } else {
            const int mode = u.pn - 12, cbase = mode == 0 ? 0 : (mode == 1 ? 64 : 128);
#pragma unroll
            for (int ai = 0; ai < 2; ++ai)
#pragma unroll
                for (int m = 0; m < 4; ++m) { bf16_t* rowp = L2A + (size_t)(row0 + ai * HALF + m * 16) * 384 + cbase;
#pragma unroll
                    for (int bj = 0; bj < 2; ++bj)
#pragma unroll
                        for (int n = 0; n < 2; ++n) { const int lc = bj * HALF + wc * 32 + n * 16 + 4 * fq;
                            if (mode < 2 && lc >= 64) continue;
                            f32x4 v = acc[ai][bj][m][n];
                            if (mode == 0) { v[0] = fast_tanh(v[0]); v[1] = fast_tanh(v[1]); v[2] = fast_tanh(v[2]); v[3] = fast_tanh(v[3]); }
                            if (mode == 2) { v[0] = fast_sigmoid(v[0]); v[1] = fast_sigmoid(v[1]); v[2] = fast_sigmoid(v[2]); v[3] = fast_sigmoid(v[3]); }
                            u32x2 w; w.x = cvt_pk_bf16(v[0], v[1]); w.y = cvt_pk_bf16(v[2], v[3]); *(u32x2*)(rowp + lc) = w; } }
        }
    }
};
struct EpiL2 {
    static constexpr bool PERM = false, AFTER_DRAIN = false;
    static __device__ __forceinline__ int asel(int) { return 0; }
    float* DAG; const float* w0; const float* a0;
    __device__ __forceinline__ void operator()(const f32x4 (&acc)[2][2][4][2], const Unit& u, int wr, int wc, int fr, int fq) const {
        const int row0 = u.pm * BM + wr * 64 + fr, mode = u.pn >> 2, col0 = (u.pn & 3) * BM + wc * 32 + 4 * fq;
        float* base = DAG + (size_t)mode * RKV_STRIDE + (size_t)row0 * 1024 + col0;
        if (mode == 0) {
#pragma unroll
            for (int bj = 0; bj < 2; ++bj)
#pragma unroll
                for (int n = 0; n < 2; ++n) { const f32x4 bv = *(const f32x4*)(w0 + col0 + bj * HALF + n * 16);
#pragma unroll
                    for (int ai = 0; ai < 2; ++ai)
#pragma unroll
                        for (int m = 0; m < 4; ++m) { f32x4 v = acc[ai][bj][m][n] + bv;
#pragma unroll
                            for (int j = 0; j < 4; ++j) { const float z = v[j], sp = fmaxf(-z, 0.f) + __logf(1.0f + __expf(-fabsf(z))); v[j] = __expf(-__expf(-sp - 0.5f)); }
                            *(f32x4*)(base + (size_t)(ai * HALF + m * 16) * 1024 + bj * HALF + n * 16) = v; } }
        } else if (mode == 1) {
#pragma unroll
            for (int bj = 0; bj < 2; ++bj)
#pragma unroll
                for (int n = 0; n < 2; ++n) { const f32x4 bv = *(const f32x4*)(a0 + col0 + bj * HALF + n * 16);
#pragma unroll
                    for (int ai = 0; ai < 2; ++ai)
#pragma unroll
                        for (int m = 0; m < 4; ++m) { f32x4 v = acc[ai][bj][m][n] + bv;
#pragma unroll
                            for (int j = 0; j < 4; ++j) v[j] = fast_sigmoid(v[j]);
                            *(f32x4*)(base + (size_t)(ai * HALF + m * 16) * 1024 + bj * HALF + n * 16) = v; } }
        } else {
#pragma unroll
            for (int ai = 0; ai < 2; ++ai)
#pragma unroll
                for (int m = 0; m < 4; ++m)
#pragma unroll
                    for (int bj = 0; bj < 2; ++bj)
#pragma unroll
                        for (int n = 0; n < 2; ++n) *(f32x4*)(base + (size_t)(ai * HALF + m * 16) * 1024 + bj * HALF + n * 16) = acc[ai][bj][m][n];
        }
    }
};
constexpr int EX_FLOATS_PER_BLK = 2 * 2 * 128;
__device__ __forceinline__ float gelu_tanh_f(float x) { const float u = 0.7978845608028654f * (x + 0.044715f * x * x * x); return 0.5f * x * (1.0f + fast_tanh(u)); }
#define PG8_ROR(x, n) __builtin_bit_cast(float, __builtin_amdgcn_mov_dpp(__builtin_bit_cast(int, (x)), 0x120 + (n), 0xF, 0xF, false))
struct EpiConv {
    static constexpr bool PERM = true, AFTER_DRAIN = false;
    static __device__ __forceinline__ int asel(int) { return 0; }
    bf16_t* ACT; float* HALO; float* RAWS; float* pconv; float* sconv; const float* cw; const float* cb; PG8_LAS float* X;
    __device__ __forceinline__ void operator()(f32x4 (&acc)[2][2][4][2], const Unit& u, int wr, int wc, int fr, int fq) const {
        constexpr int FFc = 2816, F2c = 5632, MPc = 16384;
        const int lcb = wc * 32 + 8 * fq, cg = u.pn * 128 + lcb;
        if (fr >= 14) {
#pragma unroll
            for (int ai = 0; ai < 2; ++ai)
#pragma unroll
                for (int bj = 0; bj < 2; ++bj)
#pragma unroll
                    for (int n = 0; n < 2; ++n) *(PG8_LAS f32x4*)(X + (ai * 2 + wr) * EX_FLOATS_PER_BLK + ((fr - 14) * 2 + bj) * 128 + lcb + 4 * n) = acc[ai][bj][3][n];
        }
        asm volatile("s_waitcnt lgkmcnt(0)" ::: "memory"); __builtin_amdgcn_s_barrier(); asm volatile("" ::: "memory");
        const int row0 = u.pm * BM + wr * 64 + fr;
        if (u.pm >= 64) {
            const int t = fr & 7;
            if (t < 2 || t >= 6) {
#pragma unroll
                for (int ai = 0; ai < 2; ++ai)
#pragma unroll
                    for (int m = 0; m < 4; ++m) { const int rs = row0 + ai * HALF + m * 16 - MPc; float* dst = t < 2 ? RAWS + (size_t)rs * F2c : sconv + ((size_t)(rs >> 3) * 2 + (t - 6)) * F2c;
#pragma unroll
                        for (int bj = 0; bj < 2; ++bj)
#pragma unroll
                            for (int n = 0; n < 2; ++n) *(f32x4*)(dst + bj * FFc + cg + 4 * n) = acc[ai][bj][m][n]; }
            }
        } else {
            if (wr == 0 && fr < 2) {
#pragma unroll
                for (int bj = 0; bj < 2; ++bj)
#pragma unroll
                    for (int n = 0; n < 2; ++n) *(f32x4*)(HALO + ((size_t)u.pm * 4 + fr) * F2c + bj * FFc + cg + 4 * n) = acc[0][bj][0][n]; }
            if (wr == 1 && fr >= 14) {
#pragma unroll
                for (int bj = 0; bj < 2; ++bj)
#pragma unroll
                    for (int n = 0; n < 2; ++n) { *(f32x4*)(HALO + ((size_t)u.pm * 4 + fr - 12) * F2c + bj * FFc + cg + 4 * n) = acc[1][bj][3][n];
                        if ((u.pm & 7) == 7) *(f32x4*)(pconv + ((size_t)(u.pm >> 3) * 2 + (fr - 14)) * F2c + bj * FFc + cg + 4 * n) = acc[1][bj][3][n]; } }
        }
        asm volatile("" ::: "memory"); __builtin_amdgcn_sched_barrier(0);
#pragma unroll
        for (int n = 0; n < 2; ++n)
#pragma unroll
            for (int s = 0; s < 2; ++s) {
                const int c = s * FFc + cg + 4 * n;
                const f32x4 bb = *(const f32x4*)(cb + c), w0 = *(const f32x4*)(cw + c), w1 = *(const f32x4*)(cw + F2c + c), w2 = *(const f32x4*)(cw + 2 * F2c + c);
#pragma unroll
                for (int ai = 0; ai < 2; ++ai) {
                    const int pblk = wr == 1 ? ai * 2 : 1; const bool has_prev = (wr == 1 || ai == 1);
                    f32x4 e1 = *(const PG8_LAS f32x4*)(X + pblk * EX_FLOATS_PER_BLK + (1 * 2 + s) * 128 + lcb + 4 * n), e2 = *(const PG8_LAS f32x4*)(X + pblk * EX_FLOATS_PER_BLK + (0 * 2 + s) * 128 + lcb + 4 * n);
                    if (!has_prev) { e1 = (f32x4){0.f, 0.f, 0.f, 0.f}; e2 = e1; }
                    f32x4 p1, p2;
#pragma unroll
                    for (int m = 0; m < 4; ++m) {
                        const f32x4 a = acc[ai][s][m][n]; f32x4 r1, r2, h1, h2;
                        asm volatile("s_nop 1\n\tv_mov_b32_dpp %0, %8 row_ror:1 row_mask:0xf bank_mask:0xf\n\tv_mov_b32_dpp %1, %9 row_ror:1 row_mask:0xf bank_mask:0xf\n\tv_mov_b32_dpp %2, %10 row_ror:1 row_mask:0xf bank_mask:0xf\n\tv_mov_b32_dpp %3, %11 row_ror:1 row_mask:0xf bank_mask:0xf\n\t"
                                     "v_mov_b32_dpp %4, %8 row_ror:2 row_mask:0xf bank_mask:0xf\n\tv_mov_b32_dpp %5, %9 row_ror:2 row_mask:0xf bank_mask:0xf\n\tv_mov_b32_dpp %6, %10 row_ror:2 row_mask:0xf bank_mask:0xf\n\tv_mov_b32_dpp %7, %11 row_ror:2 row_mask:0xf bank_mask:0xf"
                                     : "=&v"(r1[0]), "=&v"(r1[1]), "=&v"(r1[2]), "=&v"(r1[3]), "=&v"(r2[0]), "=&v"(r2[1]), "=&v"(r2[2]), "=&v"(r2[3]) : "v"(a[0]), "v"(a[1]), "v"(a[2]), "v"(a[3]));
                        if (m == 0) { h1 = fr >= 1 ? r1 : e1; h2 = fr >= 2 ? r2 : (fr == 0 ? e2 : e1); }
                        else { h1 = fr >= 1 ? r1 : p1; h2 = fr >= 2 ? r2 : p2; }
                        p1 = r1; p2 = r2;
                        acc[ai][s][m][n] = bb + w0 * h2 + w1 * h1 + w2 * a;
                        __builtin_amdgcn_sched_barrier(0);
                    }
                }
                asm volatile("" ::: "memory"); __builtin_amdgcn_sched_barrier(0);
            }
#pragma unroll
        for (int ai = 0; ai < 2; ++ai)
#pragma unroll
            for (int m = 0; m < 4; ++m) { const int row = row0 + ai * HALF + m * 16; u32x4 o;
                { const f32x4 g = acc[ai][0][m][0], v = acc[ai][1][m][0]; o.x = cvt_pk_bf16(gelu_tanh_f(g[0]) * v[0], gelu_tanh_f(g[1]) * v[1]); o.y = cvt_pk_bf16(gelu_tanh_f(g[2]) * v[2], gelu_tanh_f(g[3]) * v[3]); }
                { const f32x4 g = acc[ai][0][m][1], v = acc[ai][1][m][1]; o.z = cvt_pk_bf16(gelu_tanh_f(g[0]) * v[0], gelu_tanh_f(g[1]) * v[1]); o.w = cvt_pk_bf16(gelu_tanh_f(g[2]) * v[2], gelu_tanh_f(g[3]) * v[3]); }
                *(u32x4*)(ACT + (size_t)row * FFc + cg) = o; }
    }
};
template <class Epi, class Sched, bool ALIGN_EPI = false, bool SP2 = false>
__device__ __forceinline__ void gemm_phase(PG8_LAS unsigned char* lds, const Gemm g, const Sched& S, const Epi& E) {
    const int tid = threadIdx.x, wid = __builtin_amdgcn_readfirstlane(tid >> 6), lane = tid & 63, wr = wid >> 2, wc = wid & 3, fr = lane & 15, fq = lane >> 4;
    int K = g.K; asm volatile("" : "+s"(K));
    const int nt = K / BK;
    unsigned voffA[2], voffB[2];
#pragma unroll
    for (int i = 0; i < 2; ++i) { int R, C; stage_rc(tid * 16 + i * 8192, R, C); const int Rb = Epi::PERM ? ((R & ~31) + perm32(R & 31)) : R;
        voffA[i] = (unsigned)(R * K + C) * 2u; voffB[i] = (unsigned)(Rb * K + C) * 2u; }
    const size_t kstep = (size_t)(BK * 2);
    const size_t hstep = (size_t)HALF * K * 2;
    const size_t tstep = 2 * hstep;
    const unsigned ldsw = (unsigned)wid * 1024u;
    const int aoff = lds_byte(wr * 64 + fr, fq * 8), boff = lds_byte(wc * 32 + fr, fq * 8);
#define PG8_SA(b, h) (((b) * 2 + (h)) * HTB)
#define PG8_SB(b, h) ((4 + (b) * 2 + (h)) * HTB)
#define PG8_STAGE(bufoff, gbase, voff) do { _Pragma("unroll") for (int _i = 0; _i < 2; ++_i) \
        __builtin_amdgcn_global_load_lds((const unsigned*)((const char*)(gbase) + (voff)[_i]), (PG8_LAS unsigned*)(lds + (bufoff) + ldsw + _i * 8192), 16, 0, 0); } while (0)
#define PG8_LDA(dst, b, h) do { _Pragma("unroll") for (int m = 0; m < 4; ++m) _Pragma("unroll") for (int k = 0; k < 2; ++k) dst[m][k] = *(const PG8_LAS bf16x8*)(lds + PG8_SA(b, h) + aoff + m * 2048 + k * 1024); } while (0)
#define PG8_LDB(dst, b, h) do { _Pragma("unroll") for (int n = 0; n < 2; ++n) _Pragma("unroll") for (int k = 0; k < 2; ++k) dst[n][k] = *(const PG8_LAS bf16x8*)(lds + PG8_SB(b, h) + boff + n * 2048 + k * 1024); } while (0)
#define PG8_MMA(ai, bj, At, Bt) do { __builtin_amdgcn_s_setprio(1); _Pragma("unroll") for (int m = 0; m < 4; ++m) _Pragma("unroll") for (int n = 0; n < 2; ++n) _Pragma("unroll") for (int k = 0; k < 2; ++k) \
        acc[ai][bj][m][n] = __builtin_amdgcn_mfma_f32_16x16x32_bf16(Bt[n][k], At[m][k], acc[ai][bj][m][n], 0, 0, 0); __builtin_amdgcn_s_setprio(0); } while (0)
#define PG8_WAIT_V(n) asm volatile("s_waitcnt vmcnt(" #n ")" ::: "memory")
#define PG8_WAIT_L(n) asm volatile("s_waitcnt lgkmcnt(" #n ")" ::: "memory")
#define PG8_BAR __builtin_amdgcn_s_barrier()
#define PG8_SCHED __builtin_amdgcn_sched_barrier(0)
    Unit cur, nxt; int ui = 0;
    if (!S.next(0, cur)) return;
    f32x4 acc[2][2][4][2];
#pragma unroll
    for (int a = 0; a < 2; ++a)
#pragma unroll
        for (int b = 0; b < 2; ++b)
#pragma unroll
            for (int m = 0; m < 4; ++m)
#pragma unroll
                for (int n = 0; n < 2; ++n) acc[a][b][m][n] = (f32x4){0.f, 0.f, 0.f, 0.f};
    bf16x8 At[4][2], B0[2][2], B1[2][2];
    const char* cA = (const char*)g.A + (size_t)Epi::asel(cur.pn) * g.a_sel_bytes + (size_t)cur.pm * tstep; const char* cB = (const char*)g.Bt + (size_t)cur.pn * tstep;
    S.a_ready(cur);
    if constexpr (SP2) {
        PG8_STAGE(PG8_SB(0, 0), cB, voffB); PG8_STAGE(PG8_SB(0, 1), cB + hstep, voffB); PG8_STAGE(PG8_SA(0, 0), cA, voffA); PG8_STAGE(PG8_SA(0, 1), cA + hstep, voffA);
        if (wr == 1) PG8_BAR;
        PG8_WAIT_V(2); PG8_BAR;
        PG8_STAGE(PG8_SB(1, 0), cB + kstep, voffB); PG8_STAGE(PG8_SA(1, 0), cA + kstep, voffA); PG8_STAGE(PG8_SB(1, 1), cB + hstep + kstep, voffB);
        PG8_WAIT_V(6); PG8_BAR;
    } else {
        PG8_STAGE(PG8_SB(0, 0), cB, voffB); PG8_STAGE(PG8_SA(0, 0), cA, voffA); PG8_STAGE(PG8_SB(0, 1), cB + hstep, voffB); PG8_STAGE(PG8_SA(0, 1), cA + hstep, voffA);
        if (wr == 1) PG8_BAR;
        PG8_WAIT_V(4); PG8_BAR;
        PG8_STAGE(PG8_SB(1, 0), cB + kstep, voffB); PG8_STAGE(PG8_SA(1, 0), cA + kstep, voffA); PG8_STAGE(PG8_SB(1, 1), cB + hstep + kstep, voffB);
        PG8_WAIT_V(6); PG8_BAR;
    }
    for (;;) {
        const bool has_next = S.next(ui + 1, nxt);
        const char* nA = has_next ? (const char*)g.A + (size_t)Epi::asel(nxt.pn) * g.a_sel_bytes + (size_t)nxt.pm * tstep : cA; const char* nB = has_next ? (const char*)g.Bt + (size_t)nxt.pn * tstep : cB;
        for (int t = 0; t < nt; t += 2) {
            const bool last = (t == nt - 2);
            const char* a1 = cA + (size_t)(t + 1) * kstep;
            const char* a2 = last ? nA : cA + (size_t)(t + 2) * kstep; const char* b2 = last ? nB : cB + (size_t)(t + 2) * kstep;
            const char* a3 = a2 + kstep; const char* b3 = b2 + kstep;
            if (last && has_next) S.a_ready(nxt);
            if constexpr (SP2) {
            PG8_LDB(B0, 0, 0); PG8_LDB(B1, 0, 1); PG8_SCHED; PG8_LDA(At, 0, 0); PG8_STAGE(PG8_SA(1, 1), a1 + hstep, voffA);
            PG8_WAIT_V(8); PG8_WAIT_L(0); PG8_BAR; PG8_MMA(0, 0, At, B0); PG8_MMA(0, 1, At, B1); PG8_BAR; PG8_SCHED;
            PG8_LDA(At, 0, 1); PG8_STAGE(PG8_SB(0, 0), b2, voffB); PG8_STAGE(PG8_SB(0, 1), b2 + hstep, voffB); PG8_STAGE(PG8_SA(0, 0), a2, voffA);
            PG8_WAIT_V(8); PG8_WAIT_L(0); PG8_BAR; PG8_MMA(1, 0, At, B0); PG8_MMA(1, 1, At, B1); PG8_BAR; PG8_SCHED;
            PG8_LDB(B0, 1, 0); PG8_LDB(B1, 1, 1); PG8_SCHED; PG8_LDA(At, 1, 0); PG8_STAGE(PG8_SA(0, 1), a2 + hstep, voffA);
            PG8_WAIT_V(8); PG8_WAIT_L(0); PG8_BAR; PG8_MMA(0, 0, At, B0); PG8_MMA(0, 1, At, B1); PG8_BAR; PG8_SCHED;
            PG8_LDA(At, 1, 1); PG8_STAGE(PG8_SB(1, 0), b3, voffB); PG8_STAGE(PG8_SB(1, 1), b3 + hstep, voffB); PG8_STAGE(PG8_SA(1, 0), a3, voffA);
            PG8_WAIT_V(8); PG8_WAIT_L(0); PG8_BAR; PG8_MMA(1, 0, At, B0); PG8_MMA(1, 1, At, B1); PG8_BAR; PG8_SCHED;
            } else {
            PG8_LDB(B0, 0, 0); PG8_SCHED; PG8_LDA(At, 0, 0); PG8_STAGE(PG8_SA(1, 1), a1 + hstep, voffA);
            PG8_WAIT_L(8); PG8_BAR; PG8_WAIT_L(0); PG8_MMA(0, 0, At, B0); PG8_BAR; PG8_SCHED;
            PG8_LDB(B1, 0, 1); PG8_STAGE(PG8_SB(0, 0), b2, voffB);
            PG8_BAR; PG8_WAIT_L(0); PG8_MMA(0, 1, At, B1); PG8_BAR;
            PG8_LDA(At, 0, 1); PG8_STAGE(PG8_SA(0, 0), a2, voffA);
            PG8_BAR; PG8_WAIT_L(0); PG8_MMA(1, 0, At, B0); PG8_BAR; PG8_SCHED;
            PG8_STAGE(PG8_SB(0, 1), b2 + hstep, voffB);
            PG8_WAIT_V(6); PG8_BAR; PG8_MMA(1, 1, At, B1); PG8_BAR;
            PG8_LDB(B0, 1, 0); PG8_SCHED; PG8_LDA(At, 1, 0); PG8_STAGE(PG8_SA(0, 1), a2 + hstep, voffA);
            PG8_WAIT_L(8); PG8_BAR; PG8_WAIT_L(0); PG8_MMA(0, 0, At, B0); PG8_BAR; PG8_SCHED;
            PG8_LDB(B1, 1, 1); PG8_STAGE(PG8_SB(1, 0), b3, voffB);
            PG8_BAR; PG8_WAIT_L(0); PG8_MMA(0, 1, At, B1); PG8_BAR;
            PG8_LDA(At, 1, 1); PG8_STAGE(PG8_SA(1, 0), a3, voffA);
            PG8_BAR; PG8_WAIT_L(0); PG8_MMA(1, 0, At, B0); PG8_BAR; PG8_SCHED;
            PG8_STAGE(PG8_SB(1, 1), b3 + hstep, voffB);
            PG8_WAIT_V(6); PG8_BAR; PG8_MMA(1, 1, At, B1); PG8_BAR;
            }
        }
        if constexpr (ALIGN_EPI) { if (wr == 0) PG8_BAR; }
        if constexpr (!Epi::AFTER_DRAIN) { E(acc, cur, wr, wc, fr, fq); S.done(cur); }
        if (!has_next) break;
#pragma unroll
        for (int a = 0; a < 2; ++a)
#pragma unroll
            for (int b = 0; b < 2; ++b)
#pragma unroll
                for (int m = 0; m < 4; ++m)
#pragma unroll
                    for (int n = 0; n < 2; ++n) acc[a][b][m][n] = (f32x4){0.f, 0.f, 0.f, 0.f};
        cur = nxt; cA = nA; cB = nB; ++ui;
        if constexpr (ALIGN_EPI) { if (wr == 1) PG8_BAR; }
    }
    PG8_WAIT_V(0);
    if constexpr (!ALIGN_EPI) { if (wr == 0) PG8_BAR; }
    PG8_BAR;
    if constexpr (Epi::AFTER_DRAIN) { E.fused(acc, cur, wr, wc, fr, fq, lds, wid, lane); S.done(cur); }
#undef PG8_SA
#undef PG8_SB
#undef PG8_STAGE
#undef PG8_LDA
#undef PG8_LDB
#undef PG8_MMA
#undef PG8_WAIT_V
#undef PG8_WAIT_L
#undef PG8_BAR
#undef PG8_SCHED
}
}
using pg8::fast_tanh; using pg8::fast_sigmoid;

constexpr int D = 1024, PB = 8, PT = 2048, SBN = 128, STN = 8;
constexpr int MP = PB * PT, MS = SBN * STN, M = MP + MS;
constexpr int RH = 16, FF = 2816, F2 = 5632, AH = 8, AW = 512, NQKV = 4608;
constexpr float NORM_EPS = 1e-6f, GN_EPS = 64e-5f;
constexpr size_t O_YP = 0, O_YS = O_YP + (size_t)MP * D, O_PSHIFT = O_YS + (size_t)MS * D, O_PWKV = O_PSHIFT + (size_t)PB * D,
    O_PKV128 = O_PWKV + (size_t)PB * RH * 64 * 64, O_PKV512 = O_PKV128 + (size_t)PB * 128 * 1024, O_PKV2048 = O_PKV512 + (size_t)PB * 512 * 1024,
    O_PCONV = O_PKV2048 + (size_t)PB * 2048 * 1024, O_SSHIFT = O_PCONV + (size_t)2 * PB * 2 * F2, O_SWKV = O_SSHIFT + (size_t)SBN * D,
    O_SKV128 = O_SWKV + (size_t)SBN * RH * 64 * 64, O_SKV512 = O_SKV128 + (size_t)SBN * 8 * 1024, O_SKV2048 = O_SKV512 + (size_t)SBN * 8 * 1024,
    O_SCONV = O_SKV2048 + (size_t)SBN * 8 * 1024, O_END = O_SCONV + (size_t)2 * SBN * 2 * F2;
static_assert(O_END == 55107584, "output size");
constexpr size_t MiB = 1u << 20;
constexpr size_t WS_CTL = 0, CTL_ZERO_BYTES = 1 * MiB;
constexpr size_t WS_ROPE = 1 * MiB;
constexpr size_t WS_W1CAT = 2 * MiB, WS_WL2 = 10 * MiB, WS_WORW = 13 * MiB, WS_WUP0 = 15 * MiB, WS_WDN0 = 26 * MiB, WS_WQKV = 32 * MiB, WS_WOAT = 41 * MiB, WS_WUP1 = 42 * MiB, WS_WDN1 = 53 * MiB;
constexpr size_t RB16 = (size_t)M * D * 2, RF32 = (size_t)M * D * 4;
constexpr size_t WS_XM = 64 * MiB;
constexpr size_t WS_R = WS_XM + 6 * RB16, WS_K = WS_R + RF32, WS_V = WS_K + RF32, WS_DC = WS_V + RF32, WS_AA = WS_DC + RF32, WS_GG = WS_AA + RF32;
constexpr size_t WS_L2A = WS_GG + RF32;
constexpr size_t WS_Y = WS_L2A + 13 * MiB, WS_BONUS = WS_Y + RF32, WS_YG = WS_BONUS + 2 * MiB, WS_MO = WS_YG + RB16;
constexpr size_t WS_X1 = WS_MO + RF32, WS_X2 = WS_X1 + RF32, WS_X3 = WS_X2 + RF32, WS_XN = WS_X3 + RF32;
constexpr size_t WS_HID = WS_XN + RB16;
constexpr size_t WS_ACT = WS_HID + (size_t)M * F2 * 2;
constexpr size_t WS_QKV = WS_ACT + (size_t)M * FF * 2;
constexpr size_t WS_OG = WS_QKV + (size_t)M * NQKV * 2;
constexpr size_t WS_LSE = WS_OG + (size_t)3 * M * AW * 2;
constexpr size_t WS_OM = WS_LSE + 2 * MiB;
constexpr size_t WS_END = WS_OM + (size_t)M * AW * 2 + MiB;
static_assert(WS_W1CAT + (size_t)3840 * 1024 * 2 <= WS_WL2 && WS_WL2 + (size_t)3072 * 384 * 2 <= WS_WORW && WS_WUP0 + (size_t)F2 * D * 2 <= WS_WDN0 && WS_WDN0 + (size_t)D * FF * 2 <= WS_WQKV &&
              WS_WQKV + (size_t)NQKV * D * 2 <= WS_WOAT && WS_WUP1 + (size_t)F2 * D * 2 <= WS_WDN1 && WS_WDN1 + (size_t)D * FF * 2 <= WS_XM && (size_t)M * 384 * 2 <= 13 * MiB && (size_t)3 * M * 8 * 4 <= 2 * MiB, "ws map");
constexpr int CW_TMO = 0, CW_BAR = 4096;

constexpr int NWAVES = 8;
constexpr int RING_OFF = 0, RING_BYTES = 131072;
constexpr int LDSCTL_OFF = RING_BYTES, MISC_OFF = LDSCTL_OFF + 320;
constexpr int EX_OFF = MISC_OFF + 128;
constexpr int LDS_BYTES = 147456;

#define GAS __attribute__((address_space(1)))
#define LAS __attribute__((address_space(3)))
typedef unsigned short bf16;
typedef unsigned v4u __attribute__((ext_vector_type(4)));
typedef unsigned v2u __attribute__((ext_vector_type(2)));
typedef float f32x4 __attribute__((ext_vector_type(4)));
typedef float f32x2 __attribute__((ext_vector_type(2)));
typedef short bf16x8 __attribute__((ext_vector_type(8)));
typedef GAS unsigned gu32;
#define RLX_AGENT __ATOMIC_RELAXED, __HIP_MEMORY_SCOPE_AGENT
#define LDS_WAIT() asm volatile("s_waitcnt lgkmcnt(0)" ::: "memory")
#define VM_WAIT() asm volatile("s_waitcnt vmcnt(0)" ::: "memory")
__device__ __forceinline__ unsigned f2bf(float f) { unsigned u = __builtin_bit_cast(unsigned, f); return (u + 0x7fffu + ((u >> 16) & 1u)) >> 16; }
__device__ __forceinline__ unsigned pk2(float lo, float hi) { return f2bf(lo) | (f2bf(hi) << 16); }
__device__ __forceinline__ float bflo(unsigned w) { return __builtin_bit_cast(float, w << 16); }
__device__ __forceinline__ float bfhi(unsigned w) { return __builtin_bit_cast(float, w & 0xffff0000u); }
__device__ __forceinline__ float wave_sum(float v) {
#pragma unroll
    for (int o = 1; o < 64; o <<= 1) v += __shfl_xor(v, o);
    return v;
}
#define DPP_F(x, ctrl) __builtin_bit_cast(float, __builtin_amdgcn_mov_dpp(__builtin_bit_cast(int, (x)), (ctrl), 0xF, 0xF, true))
__device__ __forceinline__ float row16_sum(float x) {
    x += DPP_F(x, 0xB1);
    x += DPP_F(x, 0x4E);
    x += DPP_F(x, 0x141);
    x += DPP_F(x, 0x140);
    return x;
}
#define XB_TMO      128
#define XB_XCNT(j)  (256  + 64 * (j))
#define XB_XSUB(j)  (1280 + 64 * (j))
#define XB_XGEN(j)  (2304 + 64 * (j))
#define XB_TOP      3328
#define XB_TOPGEN   3392
#define XCD_BAR_WORDS 3456
#define XB_SPIN_CAP (1u << 18)

__device__ __forceinline__ unsigned xb_ld(unsigned* p)              { return __hip_atomic_load(p, __ATOMIC_RELAXED, __HIP_MEMORY_SCOPE_AGENT); }
__device__ __forceinline__ unsigned xb_add(unsigned* p, unsigned v) { return __hip_atomic_fetch_add(p, v, __ATOMIC_RELAXED, __HIP_MEMORY_SCOPE_AGENT); }
__device__ __forceinline__ unsigned xb_xcc_id() { return (unsigned)__builtin_amdgcn_s_getreg((3 << 11) | 20) & 0xFu; }
#define XB_SPIN(cond, bar) do { unsigned _sp = 0; while (cond) { __builtin_amdgcn_s_sleep(1); \
    if ((++_sp & 255u) == 0u) { if (xb_ld(&(bar)[XB_TMO])) break; if (_sp > XB_SPIN_CAP) { atomicAdd(&(bar)[XB_TMO], 1u); break; } } } } while (0)

struct XcdBarrier {
    unsigned* bar; unsigned x;
    volatile LAS unsigned* st;
};

__device__ __forceinline__ XcdBarrier xcd_barrier_post(unsigned* bar, volatile LAS unsigned* st) {
    XcdBarrier b; b.bar = bar; b.x = xb_xcc_id(); b.st = st;
    if (threadIdx.x == 0) (void)xb_add(&bar[XB_XCNT(b.x)], 1u);
    return b;
}
__device__ __forceinline__ void xcd_barrier_complete(unsigned* bar, unsigned x, unsigned& nloc, unsigned& nx) {
    const unsigned G = gridDim.x * gridDim.y * gridDim.z;
    unsigned sum, cnt, mine, sp = 0u;
    for (;;) {
        sum = 0u; cnt = 0u; mine = 0u;
#pragma unroll
        for (unsigned j = 0; j < 16; ++j) { const unsigned c = xb_ld(&bar[XB_XCNT(j)]); sum += c; cnt += (c > 0u) ? 1u : 0u; mine = (j == x) ? c : mine; }
        if (sum == G) break;
        __builtin_amdgcn_s_sleep(1);
        if ((++sp & 255u) == 0u) { if (xb_ld(&bar[XB_TMO])) break; if (sp > XB_SPIN_CAP) { atomicAdd(&bar[XB_TMO], 1u); break; } }
    }
    nloc = mine > 0u ? mine : 1u; nx = cnt > 0u ? cnt : 1u;
}

__device__ __forceinline__ void xcd_barrier(const XcdBarrier& b) {
    asm volatile("s_waitcnt vmcnt(0)" ::: "memory");
    __syncthreads();
    if (threadIdx.x == 0) {
        unsigned* bar = b.bar;
        __builtin_amdgcn_s_waitcnt(0);
        unsigned nloc = b.st[0], nx = b.st[1];
        if (nloc == 0u) { xcd_barrier_complete(bar, b.x, nloc, nx); b.st[0] = nloc; b.st[1] = nx; }
        const unsigned old = xb_add(&bar[XB_XSUB(b.x)], 1u);
        const unsigned gen = old / nloc;
        if (old + 1u == (gen + 1u) * nloc) {
            __builtin_amdgcn_fence(__ATOMIC_RELEASE, "agent");
            asm volatile("s_waitcnt vmcnt(0)" ::: "memory");
            const unsigned og = xb_add(&bar[XB_TOP], 1u);
            const unsigned tg = og / nx;
            if (og + 1u == (tg + 1u) * nx) xb_add(&bar[XB_TOPGEN], 1u);
            else XB_SPIN(xb_ld(&bar[XB_TOPGEN]) == tg, bar);
            __builtin_amdgcn_fence(__ATOMIC_ACQUIRE, "agent");
            xb_add(&bar[XB_XGEN(b.x)], 1u);
            asm volatile("s_waitcnt vmcnt(0)" ::: "memory");
        } else {
            XB_SPIN(xb_ld(&bar[XB_XGEN(b.x)]) == gen, bar);
            __builtin_amdgcn_fence(__ATOMIC_ACQUIRE, "agent");
            asm volatile("s_waitcnt vmcnt(0)" ::: "memory");
        }
    }
    __syncthreads();
}

struct Ctx { LAS unsigned char* lds; int tid, lane, wave, gw, NGW, G, bid; };

__device__ __forceinline__ void transpose_item(const float* W, int ldw, int Kvalid, bf16* WT, int ldt, int drow0, int dcol0, int k0, int n0, LAS float* scr, int lane) {
#pragma unroll 8
    for (int i = 0; i < 32; ++i) { const int kk = 2 * i + (lane >> 5), k = k0 + kk; scr[kk * 33 + (lane & 31)] = (k < Kvalid) ? W[(size_t)k * ldw + n0 + (lane & 31)] : 0.f; }
    LDS_WAIT(); asm volatile("" ::: "memory");
    const int c = lane & 7;
#pragma unroll
    for (int j = 0; j < 4; ++j) { const int n = (lane >> 3) + 8 * j; const LAS float* s = scr + (8 * c) * 33 + n;
        v4u o; o.x = pk2(s[0 * 33], s[1 * 33]); o.y = pk2(s[2 * 33], s[3 * 33]); o.z = pk2(s[4 * 33], s[5 * 33]); o.w = pk2(s[6 * 33], s[7 * 33]);
        *(GAS v4u*)(WT + (size_t)(drow0 + n) * ldt + dcol0 + 8 * c) = o; }
    LDS_WAIT(); asm volatile("" ::: "memory");
}
template <bool GLU = false> __device__ __forceinline__ void transpose_mat(const Ctx& C, const float* W, int K, int N, bf16* WT, int ldt, int row_off, int& base, LAS float* scr) {
    const int nblk = N / 32, nit = ((K + 63) / 64) * nblk;
    int start = (C.gw - base) % C.NGW; if (start < 0) start += C.NGW;
    for (int it = start; it < nit; it += C.NGW) { const int kb = it / nblk, nb = it % nblk, n0 = 32 * nb;
        const int drow = GLU ? (n0 < FF ? (n0 / 128) * 256 + (n0 % 128) : ((n0 - FF) / 128) * 256 + 128 + ((n0 - FF) % 128)) : n0;
        transpose_item(W, N, K, WT, ldt, row_off + drow, 64 * kb, 64 * kb, n0, scr, C.lane); }
    base += nit;
}
__device__ __forceinline__ void zero_rows(const Ctx& C, bf16* WT, int ldt, int r0, int r1) {
    const size_t n16 = (size_t)(r1 - r0) * ldt / 8; GAS v4u* p = (GAS v4u*)(WT + (size_t)r0 * ldt);
    for (size_t i = (size_t)C.bid * 512 + C.tid; i < n16; i += (size_t)C.G * 512) p[i] = (v4u){0u, 0u, 0u, 0u};
}

struct In { const float* p[33]; };

__device__ __forceinline__ void p0_prologue(const Ctx& C, const In& in, unsigned char* ws, float* out) {
    LAS float* scr = (LAS float*)(C.lds + RING_OFF + C.wave * 16384);
    bf16* W1CAT = (bf16*)(ws + WS_W1CAT); bf16* WL2 = (bf16*)(ws + WS_WL2);
    int base = 0;
    transpose_mat(C, in.p[10], D, D, W1CAT, D, 0, base, scr);
    transpose_mat(C, in.p[11], D, D, W1CAT, D, 1024, base, scr);
    transpose_mat(C, in.p[12], D, D, W1CAT, D, 2048, base, scr);
    transpose_mat(C, in.p[15], D, 64, W1CAT, D, 3072, base, scr);
    transpose_mat(C, in.p[18], D, 64, W1CAT, D, 3328, base, scr);
    transpose_mat(C, in.p[20], D, 160, W1CAT, D, 3584, base, scr);
    transpose_mat(C, in.p[13], D, D, (bf16*)(ws + WS_WORW), D, 0, base, scr);
    transpose_mat<true>(C, in.p[29], D, F2, (bf16*)(ws + WS_WUP0), D, 0, base, scr);
    transpose_mat<true>(C, in.p[29] + (size_t)D * F2, D, F2, (bf16*)(ws + WS_WUP1), D, 0, base, scr);
    transpose_mat(C, in.p[32], FF, D, (bf16*)(ws + WS_WDN0), FF, 0, base, scr);
    transpose_mat(C, in.p[32] + (size_t)FF * D, FF, D, (bf16*)(ws + WS_WDN1), FF, 0, base, scr);
    transpose_mat(C, in.p[27], D, NQKV, (bf16*)(ws + WS_WQKV), D, 0, base, scr);
    transpose_mat(C, in.p[28], AW, D, (bf16*)(ws + WS_WOAT), AW, 0, base, scr);
    zero_rows(C, W1CAT, D, 3072 + 64, 3328); zero_rows(C, W1CAT, D, 3328 + 64, 3584); zero_rows(C, W1CAT, D, 3584 + 160, 3840);
    { const float* w2 = in.p[16]; const float* a2 = in.p[19]; const float* g2 = in.p[21];
      for (int idx = C.bid * 512 + C.tid; idx < 48 * 3072; idx += C.G * 512) { const int kc = idx / 3072, n = idx % 3072, k0 = 8 * kc; float v[8];
#pragma unroll
          for (int j = 0; j < 8; ++j) { const int k = k0 + j; float x = 0.f;
              if (n < 1024) { if (k < 64) x = w2[(size_t)k * D + n]; }
              else if (n < 2048) { if (k >= 64 && k < 128) x = a2[(size_t)(k - 64) * D + (n - 1024)]; }
              else { if (k >= 128 && k < 288) x = g2[(size_t)(k - 128) * D + (n - 2048)]; }
              v[j] = x; }
          v4u o; o.x = pk2(v[0], v[1]); o.y = pk2(v[2], v[3]); o.z = pk2(v[4], v[5]); o.w = pk2(v[6], v[7]);
          *(GAS v4u*)(WL2 + (size_t)n * 384 + k0) = o; } }
    { float* rope = (float*)(ws + WS_ROPE);
      for (int idx = C.bid * 512 + C.tid; idx < 2056 * 8; idx += C.G * 512) { const int pos = idx >> 3, i = idx & 7;
          const double c = i == 0 ? 0.15915494309189535 : i == 1 ? 0.03086376340470123 : i == 2 ? 0.005985185712713705 : i == 3 ? 0.001160663641240061 :
                           i == 4 ? 0.00022507907903927653 : i == 5 ? 4.364795279280289e-05 : i == 6 ? 8.464330808241401e-06 : 1.6414262627950345e-06;
          const double rev = (double)pos * c; const float fr = (float)(rev - __builtin_floor(rev));
          rope[2 * idx] = __builtin_amdgcn_cosf(fr); rope[2 * idx + 1] = __builtin_amdgcn_sinf(fr); } }
    { const float* g0 = in.p[8]; const float* mu = in.p[9]; bf16* XM = (bf16*)(ws + WS_XM);
      for (int m = C.gw; m < M; m += C.NGW) {
          const bool pr = m < MP; const int t = pr ? (m & (PT - 1)) : ((m - MP) & (STN - 1)), b = pr ? (m >> 11) : ((m - MP) >> 3);
          const float* xr = pr ? in.p[0] + (size_t)m * D : in.p[1] + (size_t)(m - MP) * D;
          f32x4 v[4], pv[4]; float ss = 0.f, ps = 0.f;
#pragma unroll
          for (int j = 0; j < 4; ++j) { v[j] = *(const GAS f32x4*)(xr + 4 * C.lane + 256 * j); ss += (v[j].x * v[j].x + v[j].y * v[j].y) + (v[j].z * v[j].z + v[j].w * v[j].w); }
          if (t > 0) {
#pragma unroll
              for (int j = 0; j < 4; ++j) { pv[j] = *(const GAS f32x4*)(xr - D + 4 * C.lane + 256 * j); ps += (pv[j].x * pv[j].x + pv[j].y * pv[j].y) + (pv[j].z * pv[j].z + pv[j].w * pv[j].w); }
          } else {
#pragma unroll
              for (int j = 0; j < 4; ++j) pv[j] = pr ? (f32x4){0.f, 0.f, 0.f, 0.f} : *(const GAS f32x4*)(in.p[2] + (size_t)b * D + 4 * C.lane + 256 * j);
          }
          const float rs = 1.0f / sqrtf(wave_sum(ss) * (1.f / D) + NORM_EPS), prs = 1.0f / sqrtf(wave_sum(ps) * (1.f / D) + NORM_EPS);
          const bool last = pr ? (t == PT - 1) : (t == STN - 1);
#pragma unroll
          for (int j = 0; j < 4; ++j) { const int col = 4 * C.lane + 256 * j; const f32x4 g = *(const GAS f32x4*)(g0 + col);
              const f32x4 hn = v[j] * rs * g; const f32x4 hp = t > 0 ? pv[j] * prs * g : pv[j]; const f32x4 xx = hp - hn;
              if (last) *(GAS f32x4*)(out + (pr ? O_PSHIFT : O_SSHIFT) + (size_t)b * D + col) = hn;
#pragma unroll
              for (int i = 0; i < 6; ++i) { const f32x4 mm = *(const GAS f32x4*)(mu + i * D + col); const f32x4 r = hn + xx * mm;
                  const int slot = i == 1 ? 3 : (i == 2 ? 1 : (i == 3 ? 2 : i));
                  v2u o; o.x = pk2(r.x, r.y); o.y = pk2(r.z, r.w); *(GAS v2u*)(XM + (size_t)slot * M * D + (size_t)m * D + col) = o; } }
      } }
}

constexpr int SC_OPS = 0, SC_OPS_BYTES = 16 * 16 * 20 * 4, SC_VV = 2 * SC_OPS_BYTES, SC_VV_BYTES = 16 * 32 * 4, SC_YB = SC_VV + 2 * SC_VV_BYTES, SC_YB_BYTES = 16 * 32 * 4;
struct ScanItem { size_t tok; int b, h, vh, nt; bool prompt, first, last, valid; };
__device__ __forceinline__ ScanItem scan_item(int q, int bid, int G) {
    ScanItem it; const int npu = (PB * RH * 2 - bid + G - 1) / G, npi = npu > 0 ? npu * 128 : 0;
    if (q < npi) { const int u = bid + (q >> 7) * G, c = q & 127; it.b = u >> 5; it.h = (u >> 1) & 15; it.vh = u & 1; it.tok = (size_t)it.b * PT + 16 * c; it.nt = 16; it.prompt = true; it.first = c == 0; it.last = c == 127; it.valid = true; }
    else { const int su = bid + (q - npi) * G; it.valid = su < SBN * RH * 2; it.b = su >> 5; it.h = (su >> 1) & 15; it.vh = su & 1; it.tok = (size_t)MP + (size_t)it.b * STN; it.nt = 8; it.prompt = false; it.first = true; it.last = true; }
    return it;
}
__device__ __forceinline__ void scan_phase(const Ctx& C, const In& in, unsigned char* ws, float* out) {
    const float* Rb = (const float*)(ws + WS_R); const float* Kb = (const float*)(ws + WS_K); const float* Vb = (const float*)(ws + WS_V);
    const float* Db = (const float*)(ws + WS_DC); const float* Ab = (const float*)(ws + WS_AA); float* Yb = (float*)(ws + WS_Y); float* Bon = (float*)(ws + WS_BONUS);
    const int row = C.tid >> 4, p = C.tid & 15;
    LAS float* OPS = (LAS float*)(C.lds + SC_OPS); LAS float* VV = (LAS float*)(C.lds + SC_VV); LAS float* YB = (LAS float*)(C.lds + SC_YB);
    const bool stg = C.tid < 256, stv = C.tid >= 256 && C.tid < 384; const int vt = (C.tid - 256) >> 3, vq = (C.tid - 256) & 7;
    f32x4 lr, lk, ld, la, lv, Snext, pka, pkw, prk, nka, nkw, nrk; lr = lk = ld = la = lv = Snext = pka = pkw = prk = nka = nkw = nrk = (f32x4){0.f, 0.f, 0.f, 0.f};
#define SC_FETCH(it) do { if ((it).valid) { \
        if (stg && row < (it).nt) { const size_t o = ((it).tok + row) * D + (it).h * 64 + 4 * p; lr = *(const GAS f32x4*)(Rb + o); lk = *(const GAS f32x4*)(Kb + o); ld = *(const GAS f32x4*)(Db + o); la = *(const GAS f32x4*)(Ab + o); } \
        if (stv && vt < (it).nt) lv = *(const GAS f32x4*)(Vb + ((it).tok + vt) * D + (it).h * 64 + 32 * (it).vh + 4 * vq); \
        if (stg && (it).first) { const int col_ = (it).h * 64 + 4 * p; nka = *(const GAS f32x4*)(in.p[23] + col_); nkw = *(const GAS f32x4*)(in.p[22] + col_); nrk = *(const GAS f32x4*)(in.p[24] + col_); } \
        if ((it).first && !(it).prompt) Snext = *(const GAS f32x4*)(in.p[3] + ((((size_t)(it).b * RH + (it).h) * 64 + 32 * (it).vh + row) * 64 + 4 * p)); } } while (0)
#define SC_STAGE(it, buf) do { if ((it).valid) { if ((it).first) { pka = nka; pkw = nkw; prk = nrk; } \
        if (stg && row < (it).nt) { \
            const f32x4 kp = lk * (1.0f + (la - 1.0f) * pka), kr = lk * pkw; const float n2 = row16_sum((kr.x * kr.x + kr.y * kr.y) + (kr.z * kr.z + kr.w * kr.w)); \
            const f32x4 kn = kr * __builtin_amdgcn_rsqf(fmaxf(n2, 1e-24f)); const f32x4 rb = lr * kp * prk; const float bon = row16_sum((rb.x + rb.y) + (rb.z + rb.w)); \
            LAS f32x4* o = (LAS f32x4*)(OPS + (buf) * (SC_OPS_BYTES / 4) + (row * 16 + p) * 20); o[0] = kn; o[1] = ld; o[2] = kp; o[3] = lr; o[4] = kn * la; \
            if ((it).vh == 0 && p == 0) Bon[((it).tok + row) * 16 + (it).h] = bon; } \
        if (stv && vt < (it).nt) *(LAS f32x4*)(VV + (buf) * (SC_VV_BYTES / 4) + vt * 32 + 4 * vq) = lv; } } while (0)
#define SC_STEP(tl) do { const f32x4 kk = op[(tl) * 80 + 0], dd = op[(tl) * 80 + 1], kp = op[(tl) * 80 + 2], rr = op[(tl) * 80 + 3], kka = op[(tl) * 80 + 4]; const float vv = vvp[(tl) * 32]; \
        f32x2 t_ = S01 * kk.lo; t_ = S23 * kk.hi + t_; const float sk = row16_sum(t_.x + t_.y); const f32x2 vv2 = (f32x2){vv, vv}, sk2 = (f32x2){sk, sk}; \
        S01 = S01 * dd.lo; S01 = kp.lo * vv2 + S01; S01 = S01 - kka.lo * sk2; S23 = S23 * dd.hi; S23 = kp.hi * vv2 + S23; S23 = S23 - kka.hi * sk2; \
        f32x2 u_ = S01 * rr.lo; u_ = S23 * rr.hi + u_; const float y = row16_sum(u_.x + u_.y); ykeep = (p == (tl)) ? y : ykeep; } while (0)
    ScanItem cur = scan_item(0, C.bid, C.G);
    if (!cur.valid) return;
    SC_FETCH(cur); SC_STAGE(cur, 0);
    f32x4 S = cur.prompt ? (f32x4){0.f, 0.f, 0.f, 0.f} : Snext; f32x2 S01 = S.lo, S23 = S.hi;
    __syncthreads();
#ifdef SCAN_DUP_STEPS
    f32x2 D01 = (f32x2){0.f, 0.f}, D23 = D01; float dacc = 0.f;
#endif
    for (int q = 0; cur.valid; ++q) {
        const int buf = q & 1; const ScanItem nxt = scan_item(q + 1, C.bid, C.G);
        SC_FETCH(nxt);
        float ykeep = 0.f;
        const LAS f32x4* op = (const LAS f32x4*)(OPS + buf * (SC_OPS_BYTES / 4) + p * 20); const LAS float* vvp = VV + buf * (SC_VV_BYTES / 4) + row;
        SC_STEP(0); SC_STEP(1); SC_STEP(2); SC_STEP(3); SC_STEP(4); SC_STEP(5); SC_STEP(6); SC_STEP(7);
        if (cur.nt == 16) { SC_STEP(8); SC_STEP(9); SC_STEP(10); SC_STEP(11); SC_STEP(12); SC_STEP(13); SC_STEP(14); SC_STEP(15); }
#ifdef SCAN_DUP_STEPS
        { f32x2 k01 = S01, k23 = S23; float yk2 = ykeep; S01 = D01; S23 = D23;
          SC_STEP(0); SC_STEP(1); SC_STEP(2); SC_STEP(3); SC_STEP(4); SC_STEP(5); SC_STEP(6); SC_STEP(7);
          if (cur.nt == 16) { SC_STEP(8); SC_STEP(9); SC_STEP(10); SC_STEP(11); SC_STEP(12); SC_STEP(13); SC_STEP(14); SC_STEP(15); }
          D01 = S01; D23 = S23; dacc += ykeep; S01 = k01; S23 = k23; ykeep = yk2; }
#endif
        if (p < cur.nt) YB[buf * (SC_YB_BYTES / 4) + p * 32 + row] = ykeep;
        if (cur.last) *(GAS f32x4*)(out + (cur.prompt ? O_PWKV : O_SWKV) + ((((size_t)cur.b * RH + cur.h) * 64 + 32 * cur.vh + row) * 64 + 4 * p)) = (f32x4){S01.x, S01.y, S23.x, S23.y};
        SC_STAGE(nxt, buf ^ 1);
        if (nxt.valid && nxt.first) { S = nxt.prompt ? (f32x4){0.f, 0.f, 0.f, 0.f} : Snext; S01 = S.lo; S23 = S.hi; }
        __syncthreads();
        { const int tl = C.tid >> 5, rr = C.tid & 31; if (tl < cur.nt) Yb[(cur.tok + tl) * D + cur.h * 64 + 32 * cur.vh + rr] = YB[buf * (SC_YB_BYTES / 4) + tl * 32 + rr]; }
        cur = nxt;
    }
#ifdef SCAN_DUP_STEPS
    ((float*)(ws + WS_ACT))[(size_t)C.bid * 512 + C.tid] = dacc + D01.x + D01.y + D23.x + D23.y;
#endif
#undef SC_FETCH
#undef SC_STAGE
#undef SC_STEP
}
__device__ __forceinline__ void scan_post_phase(const Ctx& C, const In& in, unsigned char* ws) {
    const float* Yb = (const float*)(ws + WS_Y); const float* Vb = (const float*)(ws + WS_V); const float* Gb = (const float*)(ws + WS_GG); const float* Bon = (const float*)(ws + WS_BONUS);
    bf16* YG = (bf16*)(ws + WS_YG); const float* lg = in.p[25]; const float* lb = in.p[26];
    for (int m = C.gw; m < M; m += C.NGW) {
#pragma unroll
        for (int j = 0; j < 4; ++j) { const int col = 4 * C.lane + 256 * j, head = 4 * j + (C.lane >> 4); const size_t o = (size_t)m * D + col;
            const f32x4 y = *(const GAS f32x4*)(Yb + o); const float mean = row16_sum((y.x + y.y) + (y.z + y.w)) * (1.f / 64.f);
            const f32x4 d = y - mean; const float var = row16_sum((d.x * d.x + d.y * d.y) + (d.z * d.z + d.w * d.w)) * (1.f / 64.f);
            const float rs = 1.0f / sqrtf(var + GN_EPS), bon = Bon[(size_t)m * 16 + head];
            const f32x4 vv = *(const GAS f32x4*)(Vb + o), gg = *(const GAS f32x4*)(Gb + o), g4 = *(const GAS f32x4*)(lg + col), b4 = *(const GAS f32x4*)(lb + col);
            const f32x4 r = (d * rs * g4 + b4 + vv * bon) * gg;
            v2u w; w.x = pk2(r.x, r.y); w.y = pk2(r.z, r.w); *(GAS v2u*)(YG + o) = w; }
    }
}
__device__ __forceinline__ void rowwise_phase(const Ctx& C, const In& in, const float* xin, const float* mo, const float* g1, float* xout, const float* g2, bf16* xn) {
    for (int m = C.gw; m < M; m += C.NGW) {
        const float* xr = xin ? xin + (size_t)m * D : (m < MP ? in.p[0] + (size_t)m * D : in.p[1] + (size_t)(m - MP) * D);
        f32x4 a[4], x[4]; float ss = 0.f;
#pragma unroll
        for (int j = 0; j < 4; ++j) { a[j] = *(const GAS f32x4*)(mo + (size_t)m * D + 4 * C.lane + 256 * j); x[j] = *(const GAS f32x4*)(xr + 4 * C.lane + 256 * j);
            ss += (a[j].x * a[j].x + a[j].y * a[j].y) + (a[j].z * a[j].z + a[j].w * a[j].w); }
        const float rs = 1.0f / sqrtf(wave_sum(ss) * (1.f / D) + NORM_EPS); float s2 = 0.f;
#pragma unroll
        for (int j = 0; j < 4; ++j) { const int col = 4 * C.lane + 256 * j; x[j] = x[j] + a[j] * rs * *(const GAS f32x4*)(g1 + col);
            *(GAS f32x4*)(xout + (size_t)m * D + col) = x[j]; s2 += (x[j].x * x[j].x + x[j].y * x[j].y) + (x[j].z * x[j].z + x[j].w * x[j].w); }
        if (xn) { const float r2 = 1.0f / sqrtf(wave_sum(s2) * (1.f / D) + NORM_EPS);
#pragma unroll
            for (int j = 0; j < 4; ++j) { const int col = 4 * C.lane + 256 * j; const f32x4 r = x[j] * r2 * *(const GAS f32x4*)(g2 + col);
                v2u w; w.x = pk2(r.x, r.y); w.y = pk2(r.z, r.w); *(GAS v2u*)(xn + (size_t)m * D + col) = w; } }
    }
}
__device__ __forceinline__ float gelu_tanh(float x) { const float u = 0.7978845608028654f * (x + 0.044715f * x * x * x); return 0.5f * x * (1.0f + fast_tanh(u)); }
__device__ __forceinline__ void unpack8(const v4u w, float* f) { f[0] = bflo(w.x); f[1] = bfhi(w.x); f[2] = bflo(w.y); f[3] = bfhi(w.y); f[4] = bflo(w.z); f[5] = bfhi(w.z); f[6] = bflo(w.w); f[7] = bfhi(w.w); }
__device__ __forceinline__ void fixup_phase(const Ctx& C, unsigned char* ws, const float* cw, const float* cb, const float* sc) {
    const float* HALO = (const float*)(ws + WS_HID); const float* RAWS = (const float*)(ws + WS_HID + 8 * MiB); bf16* ACT = (bf16*)(ws + WS_ACT);
    constexpr int NC4 = FF / 4, NPROMPT = 56 * 2 * NC4, NSAMPLE = SBN * 2 * NC4;
    for (int idx = C.bid * 512 + C.tid; idx < NPROMPT + NSAMPLE; idx += C.G * 512) {
        const float *p0[2], *p1[2], *p2[2]; int c; size_t orow;
        if (idx < NPROMPT) { const int q = idx / NC4, r = q & 1, pi = q >> 1, pm = (pi / 7) * 8 + 1 + (pi % 7); c = (idx % NC4) * 4; orow = (size_t)pm * 256 + r;
#pragma unroll
            for (int s = 0; s < 2; ++s) { const size_t co = (size_t)s * FF + c; p0[s] = HALO + ((size_t)pm * 4 + r) * F2 + co;
                p1[s] = HALO + (r == 1 ? ((size_t)pm * 4 + 0) : ((size_t)(pm - 1) * 4 + 3)) * F2 + co; p2[s] = HALO + ((size_t)(pm - 1) * 4 + (r == 0 ? 2 : 3)) * F2 + co; }
        } else { const int q = (idx - NPROMPT) / NC4, t = q & 1, b = q >> 1, rs = b * 8 + t; c = ((idx - NPROMPT) % NC4) * 4; orow = (size_t)MP + rs;
#pragma unroll
            for (int s = 0; s < 2; ++s) { const size_t co = (size_t)s * FF + c; p0[s] = RAWS + (size_t)rs * F2 + co;
                p1[s] = t == 0 ? sc + ((size_t)b * 2 + 1) * F2 + co : RAWS + (size_t)(rs - 1) * F2 + co; p2[s] = sc + ((size_t)b * 2 + t) * F2 + co; }
        }
        f32x4 cv[2];
#pragma unroll
        for (int s = 0; s < 2; ++s) { const size_t co = (size_t)s * FF + c; const f32x4 h0 = *(const GAS f32x4*)p0[s], h1 = *(const GAS f32x4*)p1[s], h2 = *(const GAS f32x4*)p2[s];
            cv[s] = *(const GAS f32x4*)(cb + co) + *(const GAS f32x4*)(cw + co) * h2 + *(const GAS f32x4*)(cw + F2 + co) * h1 + *(const GAS f32x4*)(cw + 2 * F2 + co) * h0; }
        v2u o; o.x = pk2(gelu_tanh(cv[0].x) * cv[1].x, gelu_tanh(cv[0].y) * cv[1].y); o.y = pk2(gelu_tanh(cv[0].z) * cv[1].z, gelu_tanh(cv[0].w) * cv[1].w);
        *(GAS v2u*)(ACT + orow * FF + c) = o; }
}

constexpr float QSCALE = 0.125f * 1.4426950408889634f;
__device__ __forceinline__ void rope_phase(const Ctx& C, const In& in, unsigned char* ws, float* out) {
    bf16* QKV = (bf16*)(ws + WS_QKV); const float* rope = (const float*)(ws + WS_ROPE);
    for (int m = C.gw; m < M; m += C.NGW) {
        const bool pr = m < MP; const int t = pr ? (m & (PT - 1)) : ((m - MP) & 7), b = pr ? (m >> 11) : ((m - MP) >> 3), pos = pr ? t : PT + t;
        bf16* rowp = QKV + (size_t)m * NQKV;
        f32x4 cs0 = *(const GAS f32x4*)(rope + (size_t)pos * 16), cs1 = *(const GAS f32x4*)(rope + (size_t)pos * 16 + 4), cs2 = *(const GAS f32x4*)(rope + (size_t)pos * 16 + 8), cs3 = *(const GAS f32x4*)(rope + (size_t)pos * 16 + 12);
        const float cc[8] = {cs0.x, cs0.z, cs1.x, cs1.z, cs2.x, cs2.z, cs3.x, cs3.z}, sn[8] = {cs0.y, cs0.w, cs1.y, cs1.w, cs2.y, cs2.w, cs3.y, cs3.w};
#pragma unroll
        for (int it = 0; it < 9; ++it) {
            const int c8 = C.lane + 64 * it, col0 = 8 * c8, s = col0 / 1536, rem = col0 % 1536, g = rem / 512, h = (rem % 512) / 64, e0 = rem % 64;
            const v4u own = *(const GAS v4u*)(rowp + col0);
            const bool rot = (s < 2) && (e0 < 16);
            v4u par = own; if (rot) par = *(const GAS v4u*)(rowp + col0 + (e0 == 0 ? 8 : -8));
            float x[8], y[8], o[8]; unpack8(own, x); unpack8(par, y);
#pragma unroll
            for (int i = 0; i < 8; ++i) o[i] = !rot ? x[i] : (e0 == 0 ? x[i] * cc[i] - y[i] * sn[i] : x[i] * cc[i] + y[i] * sn[i]);
            if (s == 0) {
#pragma unroll
                for (int i = 0; i < 8; ++i) o[i] *= QSCALE; }
            if (s < 2) { v4u w; w.x = pk2(o[0], o[1]); w.y = pk2(o[2], o[3]); w.z = pk2(o[4], o[5]); w.w = pk2(o[6], o[7]); *(GAS v4u*)(rowp + col0) = w; }
            if (s >= 1) {
                const int L = g == 0 ? 128 : (g == 1 ? 512 : 2048); float* dst = nullptr;
                if (pr) { const int j = t - (PT - L); if (j >= 0) dst = out + (g == 0 ? O_PKV128 : (g == 1 ? O_PKV512 : O_PKV2048)) + ((((size_t)b * L + j) * 2 + (s - 1)) * 8 + h) * 64 + e0; }
                else dst = out + (g == 0 ? O_SKV128 : (g == 1 ? O_SKV512 : O_SKV2048)) + ((((size_t)b * 8 + t) * 2 + (s - 1)) * 8 + h) * 64 + e0;
                if (dst) { *(GAS f32x4*)dst = (f32x4){o[0], o[1], o[2], o[3]}; *(GAS f32x4*)(dst + 4) = (f32x4){o[4], o[5], o[6], o[7]}; } }
        }
    }
}

constexpr int AT_RS = 160;
constexpr int AT_K = 0, AT_V = 256 * AT_RS;
typedef short s16x4 __attribute__((ext_vector_type(4)));
__device__ __forceinline__ s16x4 lds_tr16(const LAS unsigned char* p) { return __builtin_bit_cast(s16x4, __builtin_amdgcn_ds_read_tr16_b64_v4i16((LAS s16x4*)p)); }
struct PUnit { int b, h, g, res, n; };
__device__ __forceinline__ PUnit punit(int u) { PUnit r; const int bh = u / 48, j = u % 48; r.b = bh >> 3; r.h = bh & 7;
    if (j < 16) { r.g = 0; r.res = 0; r.n = j; } else if (j < 32) { r.g = 1; r.res = (j - 16) >> 2; r.n = (j - 16) & 3; } else { r.g = 2; r.res = j - 32; r.n = 0; } return r; }
__device__ __forceinline__ void pattn_load(const Ctx& C, const bf16* QKV, const PUnit& u, v4u (&kr)[4], v4u (&vr)[4]) {
    const int Dl = u.g == 0 ? 1 : (u.g == 1 ? 4 : 16);
#pragma unroll
    for (int i = 0; i < 4; ++i) { const int ch = C.tid + 512 * i, kj = ch >> 3, c = ch & 7; int lk = (u.n - 1) * 128 + kj; lk = lk < 0 ? 0 : lk;
        const bf16* rp = QKV + ((size_t)u.b * PT + u.res + Dl * lk) * NQKV + u.h * 64 + c * 8;
        kr[i] = *(const GAS v4u*)(rp + (3 + u.g) * 512); vr[i] = *(const GAS v4u*)(rp + (6 + u.g) * 512); }
}
__device__ __forceinline__ void pattn_store_lds(const Ctx& C, const v4u (&kr)[4], const v4u (&vr)[4]) {
#pragma unroll
    for (int i = 0; i < 4; ++i) { const int ch = C.tid + 512 * i, kj = ch >> 3, c = ch & 7;
        *(LAS v4u*)(C.lds + AT_K + kj * AT_RS + c * 16) = kr[i]; *(LAS v4u*)(C.lds + AT_V + kj * AT_RS + c * 16) = vr[i]; }
}
__device__ __forceinline__ void pattn_compute(const Ctx& C, unsigned char* ws, const PUnit& u) {
    const bf16* QKV = (const bf16*)(ws + WS_QKV); bf16* OG = (bf16*)(ws + WS_OG); float* LSE = (float*)(ws + WS_LSE);
    const int Dl = u.g == 0 ? 1 : (u.g == 1 ? 4 : 16), q16 = C.lane & 15, g4 = C.lane >> 4, qi = 16 * C.wave + q16;
    const size_t qrow = (size_t)u.b * PT + u.res + Dl * (u.n * 128 + qi);
    const bf16* qp = QKV + qrow * NQKV + u.g * 512 + u.h * 64;
    const bf16x8 qf0 = *(const GAS bf16x8*)(qp + 8 * g4), qf1 = *(const GAS bf16x8*)(qp + 32 + 8 * g4);
    f32x4 sc[16];
    const LAS unsigned char* kbase = C.lds + AT_K + q16 * AT_RS + g4 * 16;
#pragma unroll
    for (int T = 0; T < 16; ++T) { const bf16x8 k0 = *(const LAS bf16x8*)(kbase + T * 16 * AT_RS), k1 = *(const LAS bf16x8*)(kbase + T * 16 * AT_RS + 64);
        f32x4 a = __builtin_amdgcn_mfma_f32_16x16x32_bf16(k0, qf0, (f32x4){0.f, 0.f, 0.f, 0.f}, 0, 0, 0); sc[T] = __builtin_amdgcn_mfma_f32_16x16x32_bf16(k1, qf1, a, 0, 0, 0); }
    const int klo = (u.n == 0 && qi < 128) ? 128 : qi; float mx = -1e30f;
#pragma unroll
    for (int T = 0; T < 16; ++T)
#pragma unroll
        for (int j = 0; j < 4; ++j) { const int kj = 16 * T + 4 * g4 + j; const bool ok = kj >= klo && kj <= qi + 128; sc[T][j] = ok ? sc[T][j] : -1e30f; mx = fmaxf(mx, sc[T][j]); }
    mx = fmaxf(mx, __shfl_xor(mx, 16)); mx = fmaxf(mx, __shfl_xor(mx, 32));
    float sum = 0.f;
#pragma unroll
    for (int T = 0; T < 16; ++T)
#pragma unroll
        for (int j = 0; j < 4; ++j) { const float p = __builtin_amdgcn_exp2f(sc[T][j] - mx); sc[T][j] = p; sum += p; }
    sum += __shfl_xor(sum, 16); sum += __shfl_xor(sum, 32);
    f32x4 oa[4] = {(f32x4){0.f, 0.f, 0.f, 0.f}, (f32x4){0.f, 0.f, 0.f, 0.f}, (f32x4){0.f, 0.f, 0.f, 0.f}, (f32x4){0.f, 0.f, 0.f, 0.f}};
    const LAS unsigned char* vbase = C.lds + AT_V + (4 * g4 + (q16 >> 2)) * AT_RS + (q16 & 3) * 8;
#pragma unroll
    for (int s = 0; s < 8; ++s) {
        pg8::u32x4 pw; pw.x = pg8::cvt_pk_bf16(sc[2 * s][0], sc[2 * s][1]); pw.y = pg8::cvt_pk_bf16(sc[2 * s][2], sc[2 * s][3]); pw.z = pg8::cvt_pk_bf16(sc[2 * s + 1][0], sc[2 * s + 1][1]); pw.w = pg8::cvt_pk_bf16(sc[2 * s + 1][2], sc[2 * s + 1][3]);
        const bf16x8 pf = __builtin_bit_cast(bf16x8, pw);
#pragma unroll
        for (int c = 0; c < 4; ++c) { const s16x4 lo = lds_tr16(vbase + (32 * s) * AT_RS + c * 32), hi = lds_tr16(vbase + (32 * s + 16) * AT_RS + c * 32);
            const bf16x8 vf = (bf16x8){lo[0], lo[1], lo[2], lo[3], hi[0], hi[1], hi[2], hi[3]};
            oa[c] = __builtin_amdgcn_mfma_f32_16x16x32_bf16(vf, pf, oa[c], 0, 0, 0); }
    }
    const float inv = 1.0f / sum;
    bf16* op = OG + ((size_t)u.g * M + qrow) * AW + u.h * 64 + 4 * g4;
#pragma unroll
    for (int c = 0; c < 4; ++c) { v2u w; w.x = pk2(oa[c][0] * inv, oa[c][1] * inv); w.y = pk2(oa[c][2] * inv, oa[c][3] * inv); *(GAS v2u*)(op + 16 * c) = w; }
    if (g4 == 0) LSE[((size_t)u.g * M + qrow) * 8 + u.h] = mx + __builtin_amdgcn_logf(sum);
}
__device__ __forceinline__ void sattn_unit(const Ctx& C, const float* cache_g, unsigned char* ws, const float* out, int b, int g, int h) {
    const bf16* QKV = (const bf16*)(ws + WS_QKV); bf16* OG = (bf16*)(ws + WS_OG); float* LSE = (float*)(ws + WS_LSE);
    const int L = g == 0 ? 128 : (g == 1 ? 512 : 2048), Dl = g == 0 ? 1 : (g == 1 ? 4 : 16), i = C.wave, d16 = C.lane & 15, sub = C.lane >> 4;
    const size_t qrow = (size_t)MP + (size_t)b * 8 + i;
    const v2u qw = *(const GAS v2u*)(QKV + qrow * NQKV + g * 512 + h * 64 + 4 * d16);
    const f32x4 q = (f32x4){bflo(qw.x), bfhi(qw.x), bflo(qw.y), bfhi(qw.y)};
    const float* cache = cache_g + (size_t)b * L * 1024 + h * 64 + 4 * d16;
    const float* fresh = out + (g == 0 ? O_SKV128 : (g == 1 ? O_SKV512 : O_SKV2048)) + (size_t)b * 8 * 1024 + h * 64 + 4 * d16;
    float s[33]; float mx = -1e30f;
#pragma unroll
    for (int it = 0; it < 33; ++it) { const int j = 4 * it + sub; const bool ok = j <= 128; const int idx = L + i - Dl * (ok ? j : 0);
        const float* kp = idx >= L ? fresh + (size_t)(idx - L) * 1024 : cache + (size_t)idx * 1024;
        const f32x4 kv = *(const GAS f32x4*)kp;
        float d = (q.x * kv.x + q.y * kv.y) + (q.z * kv.z + q.w * kv.w); d = row16_sum(d);
        s[it] = ok ? d : -1e30f; mx = fmaxf(mx, s[it]); }
    mx = fmaxf(mx, __shfl_xor(mx, 16)); mx = fmaxf(mx, __shfl_xor(mx, 32));
    float sum = 0.f; f32x4 o = (f32x4){0.f, 0.f, 0.f, 0.f};
#pragma unroll
    for (int it = 0; it < 33; ++it) { const int j = 4 * it + sub; const bool ok = j <= 128; const int idx = L + i - Dl * (ok ? j : 0);
        const float* vp = (idx >= L ? fresh + (size_t)(idx - L) * 1024 : cache + (size_t)idx * 1024) + 512;
        const f32x4 vv = *(const GAS f32x4*)vp; const float p = __builtin_amdgcn_exp2f(s[it] - mx); sum += p; o = o + vv * p; }
    sum += __shfl_xor(sum, 16); sum += __shfl_xor(sum, 32);
#pragma unroll
    for (int e = 0; e < 4; ++e) { o[e] += __shfl_xor(o[e], 16); o[e] += __shfl_xor(o[e], 32); }
    if (sub == 0) { const float inv = 1.0f / sum; v2u w; w.x = pk2(o.x * inv, o.y * inv); w.y = pk2(o.z * inv, o.w * inv);
        *(GAS v2u*)(OG + ((size_t)g * M + qrow) * AW + h * 64 + 4 * d16) = w;
        if (d16 == 0) LSE[((size_t)g * M + qrow) * 8 + h] = mx + __builtin_amdgcn_logf(sum); }
}
typedef const __attribute__((address_space(4))) In* KInP;
__device__ __forceinline__ void attn_phase(const Ctx& C, KInP kp, unsigned char* ws, float* out) {
    const bf16* QKV = (const bf16*)(ws + WS_QKV);
    constexpr int NPU = PB * 8 * 48;
    v4u kr[4], vr[4];
    int u = C.bid;
    if (u < NPU) { const PUnit pu = punit(u); pattn_load(C, QKV, pu, kr, vr); }
    for (; u < NPU; u += C.G) {
        const PUnit pu = punit(u);
        pattn_store_lds(C, kr, vr);
        __syncthreads();
        if (u + C.G < NPU) { const PUnit nu = punit(u + C.G); pattn_load(C, QKV, nu, kr, vr); }
        pattn_compute(C, ws, pu);
        __syncthreads();
    }
#ifndef ATTN_REP_SAMPLE
#define ATTN_REP_SAMPLE 1
#endif
    for (int rep_ = 0; rep_ < ATTN_REP_SAMPLE; ++rep_)
    for (int su = C.bid; su < SBN * 3 * 8; su += C.G) { const int h = su & 7, b = (su >> 3) & 127, g = su >> 10; const float* cache_g = kp->p[4 + (2 - g)];
        sattn_unit(C, cache_g, ws, out, b, 2 - g, h); }
}
__device__ __forceinline__ void merge_phase(const Ctx& C, unsigned char* ws) {
    const bf16* OG = (const bf16*)(ws + WS_OG); const float* LSE = (const float*)(ws + WS_LSE); bf16* OM = (bf16*)(ws + WS_OM);
    for (int idx = C.bid * 512 + C.tid; idx < M * 64; idx += C.G * 512) { const int m = idx >> 6, c8 = idx & 63, h = c8 >> 3;
        const float l0 = LSE[((size_t)0 * M + m) * 8 + h], l1 = LSE[((size_t)1 * M + m) * 8 + h], l2 = LSE[((size_t)2 * M + m) * 8 + h];
        const float mx = fmaxf(l0, fmaxf(l1, l2)); float w0 = __builtin_amdgcn_exp2f(l0 - mx), w1 = __builtin_amdgcn_exp2f(l1 - mx), w2 = __builtin_amdgcn_exp2f(l2 - mx);
        const float inv = 1.0f / (w0 + w1 + w2); w0 *= inv; w1 *= inv; w2 *= inv;
        float a[8], b[8], c[8];
        unpack8(*(const GAS v4u*)(OG + ((size_t)0 * M + m) * AW + 8 * c8), a); unpack8(*(const GAS v4u*)(OG + ((size_t)1 * M + m) * AW + 8 * c8), b); unpack8(*(const GAS v4u*)(OG + ((size_t)2 * M + m) * AW + 8 * c8), c);
        float o[8];
#pragma unroll
        for (int e = 0; e < 8; ++e) o[e] = w0 * a[e] + w1 * b[e] + w2 * c[e];
        v4u w; w.x = pk2(o[0], o[1]); w.y = pk2(o[2], o[3]); w.z = pk2(o[4], o[5]); w.w = pk2(o[6], o[7]);
        *(GAS v4u*)(OM + (size_t)m * AW + 8 * c8) = w; }
}

#ifndef MK_ONE_LAUNCH
#define MK_ONE_LAUNCH 1
#endif
#ifndef REP_MASK
#define REP_MASK 0
#endif
#ifndef ONLY
#define ONLY -1
#endif
constexpr int N_PHASES = 21;
struct Args { In in; float* out; unsigned char* ws; int ph_lo, ph_hi; };
typedef const __attribute__((address_space(4))) In* KIn;
__device__ __forceinline__ KIn launder_kernarg() { unsigned long long p = (unsigned long long)__builtin_amdgcn_kernarg_segment_ptr(); asm volatile("" : "+s"(p)); return (KIn)p; }
#define IN_LOAD() In in; { KIn kp_ = launder_kernarg(); _Pragma("unroll") for (int i_ = 0; i_ < 33; ++i_) in.p[i_] = kp_->p[i_]; }
#define GEMM_PHASE(EPI, Aoff, Boff, Nn, Kk, ASEL, ...) { pg8::Gemm g{(const bf16*)(ws + (Aoff)), (const bf16*)(ws + (Boff)), M, (Nn), (Kk), (ASEL)}; pg8::StaticOrder S; S.init(M, (Nn), C.G, C.bid); \
        pg8::EPI E{__VA_ARGS__}; pg8::gemm_phase<pg8::EPI, pg8::StaticOrder, true, true>(ring, g, S, E); }
#define DOWN_PHASE(Boff, layer) GEMM_PHASE(EpiF32, WS_ACT, Boff, D, FF, 0, (float*)(ws + WS_MO), D)
#define FIX_PHASE(layer) { IN_LOAD(); fixup_phase(C, ws, in.p[30] + (size_t)(layer) * 3 * F2, in.p[31] + (size_t)(layer) * F2, in.p[7] + (size_t)(layer) * SBN * 2 * F2); }
#define UP_PHASE(Boff, layer) { IN_LOAD(); GEMM_PHASE(EpiConv, WS_XN, Boff, F2, D, 0, (bf16*)(ws + WS_ACT), (float*)(ws + WS_HID), (float*)(ws + WS_HID + 8 * MiB), out + O_PCONV + (size_t)(layer) * PB * 2 * F2, out + O_SCONV + (size_t)(layer) * SBN * 2 * F2, \
        in.p[30] + (size_t)(layer) * 3 * F2, in.p[31] + (size_t)(layer) * F2, (LAS float*)(C.lds + EX_OFF)) }

#define PBODY_0 { IN_LOAD(); p0_prologue(C, in, ws, out); }
#define PBODY_1 GEMM_PHASE(EpiG1, WS_XM, WS_W1CAT, 3840, D, RB16, (float*)(ws + WS_R), (bf16*)(ws + WS_L2A))
#define PBODY_2 { IN_LOAD(); GEMM_PHASE(EpiL2, WS_L2A, WS_WL2, 3072, 384, 0, (float*)(ws + WS_DC), in.p[14], in.p[17]) }
#define PBODY_3 { IN_LOAD(); scan_phase(C, in, ws, out); }
#define PBODY_4 { IN_LOAD(); scan_post_phase(C, in, ws); }
#define PBODY_5 GEMM_PHASE(EpiF32, WS_YG, WS_WORW, D, D, 0, (float*)(ws + WS_MO), D)
#define PBODY_6 { IN_LOAD(); rowwise_phase(C, in, nullptr, (const float*)(ws + WS_MO), in.p[8] + 1 * D, (float*)(ws + WS_X1), in.p[8] + 2 * D, (bf16*)(ws + WS_XN)); }
#define PBODY_7 UP_PHASE(WS_WUP0, 0)
#define PBODY_8 FIX_PHASE(0)
#define PBODY_9 DOWN_PHASE(WS_WDN0, 0)
#define PBODY_10 { IN_LOAD(); rowwise_phase(C, in, (const float*)(ws + WS_X1), (const float*)(ws + WS_MO), in.p[8] + 3 * D, (float*)(ws + WS_X2), in.p[8] + 4 * D, (bf16*)(ws + WS_XN)); }
#define PBODY_11 GEMM_PHASE(EpiBf16, WS_XN, WS_WQKV, NQKV, D, 0, (bf16*)(ws + WS_QKV), NQKV)
#define PBODY_12 { IN_LOAD(); rope_phase(C, in, ws, out); }
#define PBODY_13 { attn_phase(C, launder_kernarg(), ws, out); }
#define PBODY_14 { merge_phase(C, ws); }
#define PBODY_15 GEMM_PHASE(EpiF32, WS_OM, WS_WOAT, D, AW, 0, (float*)(ws + WS_MO), D)
#define PBODY_16 { IN_LOAD(); rowwise_phase(C, in, (const float*)(ws + WS_X2), (const float*)(ws + WS_MO), in.p[8] + 5 * D, (float*)(ws + WS_X3), in.p[8] + 6 * D, (bf16*)(ws + WS_XN)); }
#define PBODY_17 UP_PHASE(WS_WUP1, 1)
#define PBODY_18 FIX_PHASE(1)
#define PBODY_19 DOWN_PHASE(WS_WDN1, 1)
#define PBODY_20 { IN_LOAD(); rowwise_phase(C, in, (const float*)(ws + WS_X3), (const float*)(ws + WS_MO), in.p[8] + 7 * D, out + O_YP, nullptr, nullptr); }

__global__ void __launch_bounds__(NWAVES * 64, 2) fwd(Args args) {
    extern __shared__ __attribute__((aligned(16))) unsigned char lds[];
    Ctx C; C.lds = (LAS unsigned char*)lds; C.tid = threadIdx.x; C.lane = C.tid & 63; C.wave = __builtin_amdgcn_readfirstlane(C.tid >> 6);
    C.G = gridDim.x; C.bid = blockIdx.x; C.gw = C.bid * NWAVES + C.wave; C.NGW = C.G * NWAVES;
    unsigned char* ws = args.ws; float* out = args.out;
    volatile LAS unsigned* MISC = (volatile LAS unsigned*)(C.lds + MISC_OFF);
    for (int u = C.tid; u < (LDS_BYTES - LDSCTL_OFF) / 4; u += NWAVES * 64) ((LAS unsigned*)(C.lds + LDSCTL_OFF))[u] = 0u;
    __syncthreads();
    XcdBarrier bar; bar.bar = (unsigned*)(ws + WS_CTL) + CW_BAR; bar.x = 0; bar.st = nullptr;
    const int lo = args.ph_lo, hi = args.ph_hi;
    if (hi - lo > 1) bar = xcd_barrier_post((unsigned*)(ws + WS_CTL) + CW_BAR, MISC + 8);
    LAS unsigned char* ring = C.lds + RING_OFF;
#define IN(k) ((ONLY < 0 || ONLY == (k)) && lo <= (k) && (k) < hi)
#define PHASE(k) if (IN(k)) PBODY_##k if (IN(k) && ((REP_MASK >> (k)) & 1)) { if (hi - lo > 1) xcd_barrier(bar); PBODY_##k } if (IN(k) && IN((k) + 1)) xcd_barrier(bar);
    PHASE(0) PHASE(1) PHASE(2) PHASE(3) PHASE(4) PHASE(5) PHASE(6) PHASE(7) PHASE(8) PHASE(9) PHASE(10) PHASE(11) PHASE(12) PHASE(13) PHASE(14) PHASE(15) PHASE(16) PHASE(17) PHASE(18) PHASE(19) PHASE(20)
#undef IN
#undef PHASE
}

extern "C" void kernel_launch(void* const* d_in, const int* in_sizes, int n_in, void* d_out, int out_size, void* d_ws, size_t ws_size, hipStream_t stream) {
    static int grid = 0;
    if (grid == 0) {
        if (n_in != 33 || (size_t)out_size != O_END || ws_size < WS_END) { fprintf(stderr, "kernel_launch: unexpected sizes: n_in %d out %d ws %zu (need %zu)\n", n_in, out_size, ws_size, (size_t)WS_END); grid = -1; return; }
        int dev = 0, cus = 0, per_cu = 0;
        if (hipGetDevice(&dev) != hipSuccess || hipDeviceGetAttribute(&cus, hipDeviceAttributeMultiprocessorCount, dev) != hipSuccess) { grid = -1; return; }
        if (hipFuncSetAttribute((const void*)fwd, hipFuncAttributeMaxDynamicSharedMemorySize, LDS_BYTES) != hipSuccess) { fprintf(stderr, "kernel_launch: hipFuncSetAttribute failed\n"); grid = -1; return; }
        if (hipOccupancyMaxActiveBlocksPerMultiprocessor(&per_cu, (const void*)fwd, NWAVES * 64, LDS_BYTES) != hipSuccess || per_cu < 1) { fprintf(stderr, "kernel_launch: occupancy query says %d\n", per_cu); }
        (void)hipGetLastError();
        grid = cus;
    }
    if (grid < 0) return;
    (void)hipMemsetAsync((char*)d_ws + WS_CTL, 0, CTL_ZERO_BYTES, stream);
    Args a{};
    for (int i = 0; i < 33; ++i) a.in.p[i] = (const float*)d_in[i];
    a.out = (float*)d_out; a.ws = (unsigned char*)d_ws;
#if MK_ONE_LAUNCH
    a.ph_lo = 0; a.ph_hi = N_PHASES;
    hipLaunchKernelGGL(fwd, dim3(grid), dim3(NWAVES * 64), LDS_BYTES, stream, a);
#else
    for (int ph = 0; ph < N_PHASES; ++ph) { a.ph_lo = ph; a.ph_hi = ph + 1; hipLaunchKernelGGL(fwd, dim3(grid), dim3(NWAVES * 64), LDS_BYTES, stream, a); }
#endif
}
```

```cpp
#include <hip/hip_runtime.h>
#include <cstdio>
#include <cstdint>
namespace pg8 {
#define PG8_LAS __attribute__((address_space(3)))
typedef unsigned short bf16_t;
typedef short bf16x8 __attribute__((ext_vector_type(8)));
typedef float f32x4 __attribute__((ext_vector_type(4)));
typedef float f32x2 __attribute__((ext_vector_type(2)));
typedef unsigned u32x4 __attribute__((ext_vector_type(4)));
typedef unsigned u32x2 __attribute__((ext_vector_type(2)));
constexpr int BM = 256, BK = 64, HALF = 128, HTB = HALF * BK * 2  , STAGE_BYTES = 8 * HTB, NXCD = 8, WGM = 8;

__host__ __device__ __forceinline__ int lds_byte(int r, int c) { const int st = (r >> 4) * 2 + (c >> 5), rr = r & 15, cc = c & 31, ob = rr * 64 + cc * 2; return st * 1024 + (ob ^ (((ob >> 9) & 1) << 5)); }
__host__ __device__ __forceinline__ void stage_rc(int b, int& R, int& C) { const int st = b / 1024, sb = b % 1024, swz = sb ^ (((sb >> 9) & 1) << 5); R = (st >> 1) * 16 + swz / 64; C = (st & 1) * 32 + (swz % 64) / 2; }
__host__ __device__ __forceinline__ int perm32(int rho) { const int n = rho >> 4, i = rho & 15; return 8 * (i >> 2) + 4 * n + (i & 3); }

struct Unit { int pm, pn, kt0, nkt, slab; };
struct Gemm { const bf16_t* A; const bf16_t* Bt; int M, N, K; size_t a_sel_bytes; };

struct StaticOrder {
    int nM, nN, nwg, G, c, KT;
    __host__ __device__ __forceinline__ void init(int M, int N, int G_, int c_, int K) { nM = M / BM; nN = N / BM; nwg = nM * nN; G = G_; c = c_; KT = K / BK; }
    __host__ __device__ __forceinline__ bool next(int i, Unit& u) const {
        const long L = (long)i * G + c; if (L >= nwg) return false;
        int wgid = (int)L; { const int q = nwg / NXCD, r = nwg % NXCD, xcd = wgid % NXCD, off = wgid / NXCD; wgid = (xcd < r ? xcd * (q + 1) : r * (q + 1) + (xcd - r) * q) + off; }
        const int nig = WGM * nN, gid = wgid / nig, fm = gid * WGM, gsz = (nM - fm) < WGM ? (nM - fm) : WGM;
        u.pm = fm + ((wgid % nig) % gsz); u.pn = (wgid % nig) / gsz; u.kt0 = 0; u.nkt = KT; u.slab = -1; return true;
    }
    __device__ __forceinline__ void a_ready(const Unit&) const {}
    __device__ __forceinline__ void done(const Unit&) const {}
};
struct SplitOrder {
    StaticOrder P; int nsl, G, c;
    __host__ __device__ __forceinline__ void init(int G_, int c_, int K) { P.init(64 * BM, 1024, G_, c_, K); G = G_; c = c_; nsl = K / (4 * BK); }
    __host__ __device__ __forceinline__ bool next(int i, Unit& u) const {
        const int nreg = c < P.nwg ? (P.nwg - c + G - 1) / G : 0;
        if (i < nreg) return P.next(i, u);
        const int j = (i - nreg) * G + c; if (j >= 16 * nsl) return false;
        const int su = j / nsl, sl = j % nsl; u.pm = 64 + (su >> 2); u.pn = su & 3; u.kt0 = 4 * sl; u.nkt = 4; u.slab = sl; return true;
    }
    __device__ __forceinline__ void a_ready(const Unit&) const {}
    __device__ __forceinline__ void done(const Unit&) const {}
};

__device__ __forceinline__ unsigned cvt_pk_bf16(float lo, float hi) { unsigned r; asm volatile("v_cvt_pk_bf16_f32 %0, %1, %2" : "=v"(r) : "v"(lo), "v"(hi)); return r; }
__device__ __forceinline__ float fast_tanh(float x) { return 1.0f - 2.0f / (1.0f + __expf(2.0f * x)); }
__device__ __forceinline__ float fast_sigmoid(float x) { return 1.0f / (1.0f + __expf(-x)); }

struct EpiF32 {
    static constexpr bool PERM = false, AFTER_DRAIN = false;
    static __device__ __forceinline__ int asel(int) { return 0; }
    float* C; int ldc;
    __device__ __forceinline__ void operator()(const f32x4 (&acc)[2][2][4][2], const Unit& u, int wr, int wc, int fr, int fq) const {
        const int row0 = u.pm * BM + wr * 64 + fr, col0 = u.pn * BM + wc * 32 + 4 * fq;
#pragma unroll
        for (int ai = 0; ai < 2; ++ai)
#pragma unroll
            for (int m = 0; m < 4; ++m) { float* rowp = C + (size_t)(row0 + ai * HALF + m * 16) * ldc + col0;
#pragma unroll
                for (int bj = 0; bj < 2; ++bj)
#pragma unroll
                    for (int n = 0; n < 2; ++n) *(f32x4*)(rowp + bj * HALF + n * 16) = acc[ai][bj][m][n]; }
    }
};
struct EpiF32S {
    static constexpr bool PERM = false, AFTER_DRAIN = false;
    static __device__ __forceinline__ int asel(int) { return 0; }
    float* C; float* SLAB;
    __device__ __forceinline__ void operator()(const f32x4 (&acc)[2][2][4][2], const Unit& u, int wr, int wc, int fr, int fq) const {
        const int row0 = u.pm * BM + wr * 64 + fr, col0 = u.pn * BM + wc * 32 + 4 * fq;
        float* base = u.slab < 0 ? C + (size_t)row0 * 1024 + col0 : SLAB + ((size_t)u.slab * 1024 + (row0 - 16384)) * 1024 + col0;
#pragma unroll
        for (int ai = 0; ai < 2; ++ai)
#pragma unroll
            for (int m = 0; m < 4; ++m) { float* rowp = base + (size_t)(ai * HALF + m * 16) * 1024;
#pragma unroll
                for (int bj = 0; bj < 2; ++bj)
#pragma unroll
                    for (int n = 0; n < 2; ++n) *(f32x4*)(rowp + bj * HALF + n * 16) = acc[ai][bj][m][n]; }
    }
};
struct EpiBf16 {
    static constexpr bool PERM = true, AFTER_DRAIN = false;
    static __device__ __forceinline__ int asel(int) { return 0; }
    bf16_t* O; int ldc;
    __device__ __forceinline__ void operator()(const f32x4 (&acc)[2][2][4][2], const Unit& u, int wr, int wc, int fr, int fq) const {
        const int row0 = u.pm * BM + wr * 64 + fr, col0 = u.pn * BM + wc * 32 + 8 * fq;
#pragma unroll
        for (int ai = 0; ai < 2; ++ai)
#pragma unroll
            for (int m = 0; m < 4; ++m) { bf16_t* rowp = O + (size_t)(row0 + ai * HALF + m * 16) * ldc + col0;
#pragma unroll
                for (int bj = 0; bj < 2; ++bj) { const f32x4 v0 = acc[ai][bj][m][0], v1 = acc[ai][bj][m][1];
                    u32x4 w; w.x = cvt_pk_bf16(v0[0], v0[1]); w.y = cvt_pk_bf16(v0[2], v0[3]); w.z = cvt_pk_bf16(v1[0], v1[1]); w.w = cvt_pk_bf16(v1[2], v1[3]);
                    *(u32x4*)(rowp + bj * HALF) = w; } }
    }
};
constexpr size_t RKV_STRIDE = (size_t)17408 * 1024;
struct EpiG1 {
    static constexpr bool PERM = false, AFTER_DRAIN = false;
    static __device__ __forceinline__ int asel(int pn) { return pn < 12 ? (pn >> 2) : pn - 9; }
    float* RKV; bf16_t* L2A;
    __device__ __forceinline__ void operator()(const f32x4 (&acc)[2][2][4][2], const Unit& u, int wr, int wc, int fr, int fq) const {
        const int row0 = u.pm * BM + wr * 64 + fr;
        if (u.pn < 12) {
            float* base = RKV + (size_t)(u.pn >> 2) * RKV_STRIDE; const int col0 = (u.pn & 3) * BM + wc * 32 + 4 * fq;
#pragma unroll
            for (int ai = 0; ai < 2; ++ai)
#pragma unroll
                for (int m = 0; m < 4; ++m) { float* rowp = base + (size_t)(row0 + ai * HALF + m * 16) * 1024 + col0;
#pragma unroll
                    for (int bj = 0; bj < 2; ++bj)
#pragma unroll
                        for (int n = 0; n < 2; ++n) *(f32x4*)(rowp + bj * HALF + n * 16) = acc[ai][bj][m][n]; }
        } else {
            const int mode = u.pn - 12, cbase = mode == 0 ? 0 : (mode == 1 ? 64 : 128);
#pragma unroll
            for (int ai = 0; ai < 2; ++ai)
#pragma unroll
                for (int m = 0; m < 4; ++m) { bf16_t* rowp = L2A + (size_t)(row0 + ai * HALF + m * 16) * 384 + cbase;
#pragma unroll
                    for (int bj = 0; bj < 2; ++bj)
#pragma unroll
                        for (int n = 0; n < 2; ++n) { const int lc = bj * HALF + wc * 32 + n * 16 + 4 * fq;
                            if (mode < 2 && lc >= 64) continue;
                            f32x4 v = acc[ai][bj][m][n];
                            if (mode == 0) { v[0] = fast_tanh(v[0]); v[1] = fast_tanh(v[1]); v[2] = fast_tanh(v[2]); v[3] = fast_tanh(v[3]); }
                            if (mode == 2) { v[0] = fast_sigmoid(v[0]); v[1] = fast_sigmoid(v[1]); v[2] = fast_sigmoid(v[2]); v[3] = fast_sigmoid(v[3]); }
                            u32x2 w; w.x = cvt_pk_bf16(v[0], v[1]); w.y = cvt_pk_bf16(v[2], v[3]); *(u32x2*)(rowp + lc) = w; } }
        }
    }
};
struct EpiL2 {
    static constexpr bool PERM = false, AFTER_DRAIN = false;
    static __device__ __forceinline__ int asel(int) { return 0; }
    float* DAG; const float* w0; const float* a0;
    __device__ __forceinline__ void operator()(const f32x4 (&acc)[2][2][4][2], const Unit& u, int wr, int wc, int fr, int fq) const {
        const int row0 = u.pm * BM + wr * 64 + fr, mode = u.pn >> 2, col0 = (u.pn & 3) * BM + wc * 32 + 4 * fq;
        float* base = DAG + (size_t)mode * RKV_STRIDE + (size_t)row0 * 1024 + col0;
        if (mode == 0) {
#pragma unroll
            for (int bj = 0; bj < 2; ++bj)
#pragma unroll
                for (int n = 0; n < 2; ++n) { const f32x4 bv = *(const f32x4*)(w0 + col0 + bj * HALF + n * 16);
#pragma unroll
                    for (int ai = 0; ai < 2; ++ai)
#pragma unroll
                        for (int m = 0; m < 4; ++m) { f32x4 v = acc[ai][bj][m][n] + bv;
#pragma unroll
                            for (int j = 0; j < 4; ++j) { const float z = v[j], sp = fmaxf(-z, 0.f) + __logf(1.0f + __expf(-fabsf(z))); v[j] = __expf(-__expf(-sp - 0.5f)); }
                            *(f32x4*)(base + (size_t)(ai * HALF + m * 16) * 1024 + bj * HALF + n * 16) = v; } }
        } else if (mode == 1) {
#pragma unroll
            for (int bj = 0; bj < 2; ++bj)
#pragma unroll
                for (int n = 0; n < 2; ++n) { const f32x4 bv = *(const f32x4*)(a0 + col0 + bj * HALF + n * 16);
#pragma unroll
                    for (int ai = 0; ai < 2; ++ai)
#pragma unroll
                        for (int m = 0; m < 4; ++m) { f32x4 v = acc[ai][bj][m][n] + bv;
#pragma unroll
                            for (int j = 0; j < 4; ++j) v[j] = fast_sigmoid(v[j]);
                            *(f32x4*)(base + (size_t)(ai * HALF + m * 16) * 1024 + bj * HALF + n * 16) = v; } }
        } else {
#pragma unroll
            for (int ai = 0; ai < 2; ++ai)
#pragma unroll
                for (int m = 0; m < 4; ++m)
#pragma unroll
                    for (int bj = 0; bj < 2; ++bj)
#pragma unroll
                        for (int n = 0; n < 2; ++n) *(f32x4*)(base + (size_t)(ai * HALF + m * 16) * 1024 + bj * HALF + n * 16) = acc[ai][bj][m][n];
        }
    }
};
constexpr int EX_FLOATS_PER_BLK = 2 * 2 * 128;
__device__ __forceinline__ float gelu_tanh_f(float x) { const float u = 0.7978845608028654f * (x + 0.044715f * x * x * x); return 0.5f * x * (1.0f + fast_tanh(u)); }
#define PG8_ROR(x, n) __builtin_bit_cast(float, __builtin_amdgcn_mov_dpp(__builtin_bit_cast(int, (x)), 0x120 + (n), 0xF, 0xF, false))
struct EpiConv {
    static constexpr bool PERM = true, AFTER_DRAIN = false;
    static __device__ __forceinline__ int asel(int) { return 0; }
    bf16_t* ACT; float* HALO; float* RAWS; float* pconv; float* sconv; const float* cw; const float* cb; PG8_LAS float* X;
    __device__ __forceinline__ void operator()(f32x4 (&acc)[2][2][4][2], const Unit& u, int wr, int wc, int fr, int fq) const {
        constexpr int FFc = 2816, F2c = 5632, MPc = 16384;
        const int lcb = wc * 32 + 8 * fq, cg = u.pn * 128 + lcb;
        if (fr >= 14) {
#pragma unroll
            for (int ai = 0; ai < 2; ++ai)
#pragma unroll
                for (int bj = 0; bj < 2; ++bj)
#pragma unroll
                    for (int n = 0; n < 2; ++n) *(PG8_LAS f32x4*)(X + (ai * 2 + wr) * EX_FLOATS_PER_BLK + ((fr - 14) * 2 + bj) * 128 + lcb + 4 * n) = acc[ai][bj][3][n];
        }
        asm volatile("s_waitcnt lgkmcnt(0)" ::: "memory"); __builtin_amdgcn_s_barrier(); asm volatile("" ::: "memory");
        const int row0 = u.pm * BM + wr * 64 + fr;
        if (u.pm >= 64) {
            const int t = fr & 7;
            if (t < 2 || t >= 6) {
#pragma unroll
                for (int ai = 0; ai < 2; ++ai)
#pragma unroll
                    for (int m = 0; m < 4; ++m) { const int rs = row0 + ai * HALF + m * 16 - MPc; float* dst = t < 2 ? RAWS + (size_t)rs * F2c : sconv + ((size_t)(rs >> 3) * 2 + (t - 6)) * F2c;
#pragma unroll
                        for (int bj = 0; bj < 2; ++bj)
#pragma unroll
                            for (int n = 0; n < 2; ++n) *(f32x4*)(dst + bj * FFc + cg + 4 * n) = acc[ai][bj][m][n]; }
            }
        } else {
            if (wr == 0 && fr < 2) {
#pragma unroll
                for (int bj = 0; bj < 2; ++bj)
#pragma unroll
                    for (int n = 0; n < 2; ++n) *(f32x4*)(HALO + ((size_t)u.pm * 4 + fr) * F2c + bj * FFc + cg + 4 * n) = acc[0][bj][0][n]; }
            if (wr == 1 && fr >= 14) {
#pragma unroll
                for (int bj = 0; bj < 2; ++bj)
#pragma unroll
                    for (int n = 0; n < 2; ++n) { *(f32x4*)(HALO + ((size_t)u.pm * 4 + fr - 12) * F2c + bj * FFc + cg + 4 * n) = acc[1][bj][3][n];
                        if ((u.pm & 7) == 7) *(f32x4*)(pconv + ((size_t)(u.pm >> 3) * 2 + (fr - 14)) * F2c + bj * FFc + cg + 4 * n) = acc[1][bj][3][n]; } }
        }
        asm volatile("" ::: "memory"); __builtin_amdgcn_sched_barrier(0);
#pragma unroll
        for (int n = 0; n < 2; ++n)
#pragma unroll
            for (int s = 0; s < 2; ++s) {
                const int c = s * FFc + cg + 4 * n;
                const f32x4 bb = *(const f32x4*)(cb + c), w0 = *(const f32x4*)(cw + c), w1 = *(const f32x4*)(cw + F2c + c), w2 = *(const f32x4*)(cw + 2 * F2c + c);
#pragma unroll
                for (int ai = 0; ai < 2; ++ai) {
                    const int pblk = wr == 1 ? ai * 2 : 1; const bool has_prev = (wr == 1 || ai == 1);
                    f32x4 e1 = *(const PG8_LAS f32x4*)(X + pblk * EX_FLOATS_PER_BLK + (1 * 2 + s) * 128 + lcb + 4 * n), e2 = *(const PG8_LAS f32x4*)(X + pblk * EX_FLOATS_PER_BLK + (0 * 2 + s) * 128 + lcb + 4 * n);
                    if (!has_prev) { e1 = (f32x4){0.f, 0.f, 0.f, 0.f}; e2 = e1; }
                    f32x4 p1, p2;
#pragma unroll
                    for (int m = 0; m < 4; ++m) {
                        const f32x4 a = acc[ai][s][m][n]; f32x4 r1, r2, h1, h2;
                        asm volatile("s_nop 1\n\tv_mov_b32_dpp %0, %8 row_ror:1 row_mask:0xf bank_mask:0xf\n\tv_mov_b32_dpp %1, %9 row_ror:1 row_mask:0xf bank_mask:0xf\n\tv_mov_b32_dpp %2, %10 row_ror:1 row_mask:0xf bank_mask:0xf\n\tv_mov_b32_dpp %3, %11 row_ror:1 row_mask:0xf bank_mask:0xf\n\t"
                                     "v_mov_b32_dpp %4, %8 row_ror:2 row_mask:0xf bank_mask:0xf\n\tv_mov_b32_dpp %5, %9 row_ror:2 row_mask:0xf bank_mask:0xf\n\tv_mov_b32_dpp %6, %10 row_ror:2 row_mask:0xf bank_mask:0xf\n\tv_mov_b32_dpp %7, %11 row_ror:2 row_mask:0xf bank_mask:0xf"
                                     : "=&v"(r1[0]), "=&v"(r1[1]), "=&v"(r1[2]), "=&v"(r1[3]), "=&v"(r2[0]), "=&v"(r2[1]), "=&v"(r2[2]), "=&v"(r2[3]) : "v"(a[0]), "v"(a[1]), "v"(a[2]), "v"(a[3]));
                        if (m == 0) { h1 = fr >= 1 ? r1 : e1; h2 = fr >= 2 ? r2 : (fr == 0 ? e2 : e1); }
                        else { h1 = fr >= 1 ? r1 : p1; h2 = fr >= 2 ? r2 : p2; }
                        p1 = r1; p2 = r2;
                        acc[ai][s][m][n] = bb + w0 * h2 + w1 * h1 + w2 * a;
                        __builtin_amdgcn_sched_barrier(0);
                    }
                }
                asm volatile("" ::: "memory"); __builtin_amdgcn_sched_barrier(0);
            }
#pragma unroll
        for (int ai = 0; ai < 2; ++ai)
#pragma unroll
            for (int m = 0; m < 4; ++m) { const int row = row0 + ai * HALF + m * 16; u32x4 o;
                { const f32x4 g = acc[ai][0][m][0], v = acc[ai][1][m][0]; o.x = cvt_pk_bf16(gelu_tanh_f(g[0]) * v[0], gelu_tanh_f(g[1]) * v[1]); o.y = cvt_pk_bf16(gelu_tanh_f(g[2]) * v[2], gelu_tanh_f(g[3]) * v[3]); }
                { const f32x4 g = acc[ai][0][m][1], v = acc[ai][1][m][1]; o.z = cvt_pk_bf16(gelu_tanh_f(g[0]) * v[0], gelu_tanh_f(g[1]) * v[1]); o.w = cvt_pk_bf16(gelu_tanh_f(g[2]) * v[2], gelu_tanh_f(g[3]) * v[3]); }
                *(u32x4*)(ACT + (size_t)row * FFc + cg) = o; }
    }
};
template <class Epi, class Sched, bool ALIGN_EPI = false, bool SP2 = false>
__device__ __forceinline__ void gemm_phase(PG8_LAS unsigned char* lds, const Gemm g, const Sched& S, const Epi& E) {
    const int tid = threadIdx.x, wid = __builtin_amdgcn_readfirstlane(tid >> 6), lane = tid & 63, wr = wid >> 2, wc = wid & 3, fr = lane & 15, fq = lane >> 4;
    int K = g.K; asm volatile("" : "+s"(K));
    unsigned voffA[2], voffB[2];
#pragma unroll
    for (int i = 0; i < 2; ++i) { int R, C; stage_rc(tid * 16 + i * 8192, R, C); const int Rb = Epi::PERM ? ((R & ~31) + perm32(R & 31)) : R;
        voffA[i] = (unsigned)(R * K + C) * 2u; voffB[i] = (unsigned)(Rb * K + C) * 2u; }
    const size_t kstep = (size_t)(BK * 2);
    const size_t hstep = (size_t)HALF * K * 2;
    const size_t tstep = 2 * hstep;
    const unsigned ldsw = (unsigned)wid * 1024u;
    const int aoff = lds_byte(wr * 64 + fr, fq * 8), boff = lds_byte(wc * 32 + fr, fq * 8);
#define PG8_SA(b, h) (((b) * 2 + (h)) * HTB)
#define PG8_SB(b, h) ((4 + (b) * 2 + (h)) * HTB)
#define PG8_STAGE(bufoff, gbase, voff) do { _Pragma("unroll") for (int _i = 0; _i < 2; ++_i) \
        __builtin_amdgcn_global_load_lds((const unsigned*)((const char*)(gbase) + (voff)[_i]), (PG8_LAS unsigned*)(lds + (bufoff) + ldsw + _i * 8192), 16, 0, 0); } while (0)
#define PG8_LDA(dst, b, h) do { _Pragma("unroll") for (int m = 0; m < 4; ++m) _Pragma("unroll") for (int k = 0; k < 2; ++k) dst[m][k] = *(const PG8_LAS bf16x8*)(lds + PG8_SA(b, h) + aoff + m * 2048 + k * 1024); } while (0)
#define PG8_LDB(dst, b, h) do { _Pragma("unroll") for (int n = 0; n < 2; ++n) _Pragma("unroll") for (int k = 0; k < 2; ++k) dst[n][k] = *(const PG8_LAS bf16x8*)(lds + PG8_SB(b, h) + boff + n * 2048 + k * 1024); } while (0)
#define PG8_MMA(ai, bj, At, Bt) do { __builtin_amdgcn_s_setprio(1); _Pragma("unroll") for (int m = 0; m < 4; ++m) _Pragma("unroll") for (int n = 0; n < 2; ++n) _Pragma("unroll") for (int k = 0; k < 2; ++k) \
        acc[ai][bj][m][n] = __builtin_amdgcn_mfma_f32_16x16x32_bf16(Bt[n][k], At[m][k], acc[ai][bj][m][n], 0, 0, 0); __builtin_amdgcn_s_setprio(0); } while (0)
#define PG8_WAIT_V(n) asm volatile("s_waitcnt vmcnt(" #n ")" ::: "memory")
#define PG8_WAIT_L(n) asm volatile("s_waitcnt lgkmcnt(" #n ")" ::: "memory")
#define PG8_BAR __builtin_amdgcn_s_barrier()
#define PG8_SCHED __builtin_amdgcn_sched_barrier(0)
    Unit cur, nxt; int ui = 0;
    if (!S.next(0, cur)) return;
    f32x4 acc[2][2][4][2];
#pragma unroll
    for (int a = 0; a < 2; ++a)
#pragma unroll
        for (int b = 0; b < 2; ++b)
#pragma unroll
            for (int m = 0; m < 4; ++m)
#pragma unroll
                for (int n = 0; n < 2; ++n) acc[a][b][m][n] = (f32x4){0.f, 0.f, 0.f, 0.f};
    bf16x8 At[4][2], B0[2][2], B1[2][2];
    const char* cA = (const char*)g.A + (size_t)Epi::asel(cur.pn) * g.a_sel_bytes + (size_t)cur.pm * tstep + (size_t)cur.kt0 * kstep; const char* cB = (const char*)g.Bt + (size_t)cur.pn * tstep + (size_t)cur.kt0 * kstep;
    S.a_ready(cur);
    if constexpr (SP2) {
        PG8_STAGE(PG8_SB(0, 0), cB, voffB); PG8_STAGE(PG8_SB(0, 1), cB + hstep, voffB); PG8_STAGE(PG8_SA(0, 0), cA, voffA); PG8_STAGE(PG8_SA(0, 1), cA + hstep, voffA);
        if (wr == 1) PG8_BAR;
        PG8_WAIT_V(2); PG8_BAR;
        PG8_STAGE(PG8_SB(1, 0), cB + kstep, voffB); PG8_STAGE(PG8_SA(1, 0), cA + kstep, voffA); PG8_STAGE(PG8_SB(1, 1), cB + hstep + kstep, voffB);
        PG8_WAIT_V(6); PG8_BAR;
    } else {
        PG8_STAGE(PG8_SB(0, 0), cB, voffB); PG8_STAGE(PG8_SA(0, 0), cA, voffA); PG8_STAGE(PG8_SB(0, 1), cB + hstep, voffB); PG8_STAGE(PG8_SA(0, 1), cA + hstep, voffA);
        if (wr == 1) PG8_BAR;
        PG8_WAIT_V(4); PG8_BAR;
        PG8_STAGE(PG8_SB(1, 0), cB + kstep, voffB); PG8_STAGE(PG8_SA(1, 0), cA + kstep, voffA); PG8_STAGE(PG8_SB(1, 1), cB + hstep + kstep, voffB);
        PG8_WAIT_V(6); PG8_BAR;
    }
    for (;;) {
        const bool has_next = S.next(ui + 1, nxt);
        const char* nA = has_next ? (const char*)g.A + (size_t)Epi::asel(nxt.pn) * g.a_sel_bytes + (size_t)nxt.pm * tstep + (size_t)nxt.kt0 * kstep : cA; const char* nB = has_next ? (const char*)g.Bt + (size_t)nxt.pn * tstep + (size_t)nxt.kt0 * kstep : cB;
        int nt = cur.nkt; asm volatile("" : "+s"(nt));
        for (int t = 0; t < nt; t += 2) {
            const bool last = (t == nt - 2);
            const char* a1 = cA + (size_t)(t + 1) * kstep;
            const char* a2 = last ? nA : cA + (size_t)(t + 2) * kstep; const char* b2 = last ? nB : cB + (size_t)(t + 2) * kstep;
            const char* a3 = a2 + kstep; const char* b3 = b2 + kstep;
            if (last && has_next) S.a_ready(nxt);
            if constexpr (SP2) {
            PG8_LDB(B0, 0, 0); PG8_LDB(B1, 0, 1); PG8_SCHED; PG8_LDA(At, 0, 0); PG8_STAGE(PG8_SA(1, 1), a1 + hstep, voffA);
            PG8_WAIT_V(8); PG8_WAIT_L(0); PG8_BAR; PG8_MMA(0, 0, At, B0); PG8_MMA(0, 1, At, B1); PG8_BAR; PG8_SCHED;
            PG8_LDA(At, 0, 1); PG8_STAGE(PG8_SB(0, 0), b2, voffB); PG8_STAGE(PG8_SB(0, 1), b2 + hstep, voffB); PG8_STAGE(PG8_SA(0, 0), a2, voffA);
            PG8_WAIT_V(8); PG8_WAIT_L(0); PG8_BAR; PG8_MMA(1, 0, At, B0); PG8_MMA(1, 1, At, B1); PG8_BAR; PG8_SCHED;
            PG8_LDB(B0, 1, 0); PG8_LDB(B1, 1, 1); PG8_SCHED; PG8_LDA(At, 1, 0); PG8_STAGE(PG8_SA(0, 1), a2 + hstep, voffA);
            PG8_WAIT_V(8); PG8_WAIT_L(0); PG8_BAR; PG8_MMA(0, 0, At, B0); PG8_MMA(0, 1, At, B1); PG8_BAR; PG8_SCHED;
            PG8_LDA(At, 1, 1); PG8_STAGE(PG8_SB(1, 0), b3, voffB); PG8_STAGE(PG8_SB(1, 1), b3 + hstep, voffB); PG8_STAGE(PG8_SA(1, 0), a3, voffA);
            PG8_WAIT_V(8); PG8_WAIT_L(0); PG8_BAR; PG8_MMA(1, 0, At, B0); PG8_MMA(1, 1, At, B1); PG8_BAR; PG8_SCHED;
            } else {
            PG8_LDB(B0, 0, 0); PG8_SCHED; PG8_LDA(At, 0, 0); PG8_STAGE(PG8_SA(1, 1), a1 + hstep, voffA);
            PG8_WAIT_L(8); PG8_BAR; PG8_WAIT_L(0); PG8_MMA(0, 0, At, B0); PG8_BAR; PG8_SCHED;
            PG8_LDB(B1, 0, 1); PG8_STAGE(PG8_SB(0, 0), b2, voffB);
            PG8_BAR; PG8_WAIT_L(0); PG8_MMA(0, 1, At, B1); PG8_BAR;
            PG8_LDA(At, 0, 1); PG8_STAGE(PG8_SA(0, 0), a2, voffA);
            PG8_BAR; PG8_WAIT_L(0); PG8_MMA(1, 0, At, B0); PG8_BAR; PG8_SCHED;
            PG8_STAGE(PG8_SB(0, 1), b2 + hstep, voffB);
            PG8_WAIT_V(6); PG8_BAR; PG8_MMA(1, 1, At, B1); PG8_BAR;
            PG8_LDB(B0, 1, 0); PG8_SCHED; PG8_LDA(At, 1, 0); PG8_STAGE(PG8_SA(0, 1), a2 + hstep, voffA);
            PG8_WAIT_L(8); PG8_BAR; PG8_WAIT_L(0); PG8_MMA(0, 0, At, B0); PG8_BAR; PG8_SCHED;
            PG8_LDB(B1, 1, 1); PG8_STAGE(PG8_SB(1, 0), b3, voffB);
            PG8_BAR; PG8_WAIT_L(0); PG8_MMA(0, 1, At, B1); PG8_BAR;
            PG8_LDA(At, 1, 1); PG8_STAGE(PG8_SA(1, 0), a3, voffA);
            PG8_BAR; PG8_WAIT_L(0); PG8_MMA(1, 0, At, B0); PG8_BAR; PG8_SCHED;
            PG8_STAGE(PG8_SB(1, 1), b3 + hstep, voffB);
            PG8_WAIT_V(6); PG8_BAR; PG8_MMA(1, 1, At, B1); PG8_BAR;
            }
        }
        if constexpr (ALIGN_EPI) { if (wr == 0) PG8_BAR; }
        if constexpr (!Epi::AFTER_DRAIN) { E(acc, cur, wr, wc, fr, fq); S.done(cur); }
        if (!has_next) break;
#pragma unroll
        for (int a = 0; a < 2; ++a)
#pragma unroll
            for (int b = 0; b < 2; ++b)
#pragma unroll
                for (int m = 0; m < 4; ++m)
#pragma unroll
                    for (int n = 0; n < 2; ++n) acc[a][b][m][n] = (f32x4){0.f, 0.f, 0.f, 0.f};
        cur = nxt; cA = nA; cB = nB; ++ui;
        if constexpr (ALIGN_EPI) { if (wr == 1) PG8_BAR; }
    }
    PG8_WAIT_V(0);
    if constexpr (!ALIGN_EPI) { if (wr == 0) PG8_BAR; }
    PG8_BAR;
    if constexpr (Epi::AFTER_DRAIN) { E.fused(acc, cur, wr, wc, fr, fq, lds, wid, lane); S.done(cur); }
#undef PG8_SA
#undef PG8_SB
#undef PG8_STAGE
#undef PG8_LDA
#undef PG8_LDB
#undef PG8_MMA
#undef PG8_WAIT_V
#undef PG8_WAIT_L
#undef PG8_BAR
#undef PG8_SCHED
}
}
using pg8::fast_tanh; using pg8::fast_sigmoid;

constexpr int D = 1024, PB = 8, PT = 2048, SBN = 128, STN = 8;
constexpr int MP = PB * PT, MS = SBN * STN, M = MP + MS;
constexpr int RH = 16, FF = 2816, F2 = 5632, AH = 8, AW = 512, NQKV = 4608;
constexpr float NORM_EPS = 1e-6f, GN_EPS = 64e-5f;
constexpr size_t O_YP = 0, O_YS = O_YP + (size_t)MP * D, O_PSHIFT = O_YS + (size_t)MS * D, O_PWKV = O_PSHIFT + (size_t)PB * D,
    O_PKV128 = O_PWKV + (size_t)PB * RH * 64 * 64, O_PKV512 = O_PKV128 + (size_t)PB * 128 * 1024, O_PKV2048 = O_PKV512 + (size_t)PB * 512 * 1024,
    O_PCONV = O_PKV2048 + (size_t)PB * 2048 * 1024, O_SSHIFT = O_PCONV + (size_t)2 * PB * 2 * F2, O_SWKV = O_SSHIFT + (size_t)SBN * D,
    O_SKV128 = O_SWKV + (size_t)SBN * RH * 64 * 64, O_SKV512 = O_SKV128 + (size_t)SBN * 8 * 1024, O_SKV2048 = O_SKV512 + (size_t)SBN * 8 * 1024,
    O_SCONV = O_SKV2048 + (size_t)SBN * 8 * 1024, O_END = O_SCONV + (size_t)2 * SBN * 2 * F2;
static_assert(O_END == 55107584, "output size");
constexpr size_t MiB = 1u << 20;
constexpr size_t WS_CTL = 0, CTL_ZERO_BYTES = 1 * MiB;
constexpr size_t WS_ROPE = 1 * MiB;
constexpr size_t WS_W1CAT = 2 * MiB, WS_WL2 = 10 * MiB, WS_WORW = 13 * MiB, WS_WUP0 = 15 * MiB, WS_WDN0 = 26 * MiB, WS_WQKV = 32 * MiB, WS_WOAT = 41 * MiB, WS_WUP1 = 42 * MiB, WS_WDN1 = 53 * MiB;
constexpr size_t RB16 = (size_t)M * D * 2, RF32 = (size_t)M * D * 4;
constexpr size_t WS_XM = 64 * MiB;
constexpr size_t WS_R = WS_XM + 6 * RB16, WS_K = WS_R + RF32, WS_V = WS_K + RF32, WS_DC = WS_V + RF32, WS_AA = WS_DC + RF32, WS_GG = WS_AA + RF32;
constexpr size_t WS_L2A = WS_GG + RF32;
constexpr size_t WS_Y = WS_L2A + 13 * MiB, WS_BONUS = WS_Y + RF32, WS_YG = WS_BONUS + 2 * MiB, WS_MO = WS_YG + RB16;
constexpr size_t WS_X1 = WS_MO + RF32, WS_X2 = WS_X1 + RF32, WS_X3 = WS_X2 + RF32, WS_XN = WS_X3 + RF32;
constexpr size_t WS_HID = WS_XN + RB16;
constexpr size_t WS_SLAB = WS_HID + 32 * MiB;
constexpr size_t WS_ACT = WS_HID + (size_t)M * F2 * 2;
constexpr size_t WS_QKV = WS_ACT + (size_t)M * FF * 2;
constexpr size_t WS_OG = WS_QKV + (size_t)M * NQKV * 2;
constexpr size_t WS_LSE = WS_OG + (size_t)3 * M * AW * 2;
constexpr size_t WS_OM = WS_LSE + 2 * MiB;
constexpr size_t WS_END = WS_OM + (size_t)M * AW * 2 + MiB;
static_assert(WS_W1CAT + (size_t)3840 * 1024 * 2 <= WS_WL2 && WS_WL2 + (size_t)3072 * 384 * 2 <= WS_WORW && WS_WUP0 + (size_t)F2 * D * 2 <= WS_WDN0 && WS_WDN0 + (size_t)D * FF * 2 <= WS_WQKV &&
              WS_WQKV + (size_t)NQKV * D * 2 <= WS_WOAT && WS_WUP1 + (size_t)F2 * D * 2 <= WS_WDN1 && WS_WDN1 + (size_t)D * FF * 2 <= WS_XM && (size_t)M * 384 * 2 <= 13 * MiB && (size_t)3 * M * 8 * 4 <= 2 * MiB, "ws map");
constexpr int CW_TMO = 0, CW_BAR = 4096;

constexpr int NWAVES = 8;
constexpr int RING_OFF = 0, RING_BYTES = 131072;
constexpr int LDSCTL_OFF = RING_BYTES, MISC_OFF = LDSCTL_OFF + 320;
constexpr int EX_OFF = MISC_OFF + 128;
constexpr int LDS_BYTES = 147456;

#define GAS __attribute__((address_space(1)))
#define LAS __attribute__((address_space(3)))
typedef unsigned short bf16;
typedef unsigned v4u __attribute__((ext_vector_type(4)));
typedef unsigned v2u __attribute__((ext_vector_type(2)));
typedef float f32x4 __attribute__((ext_vector_type(4)));
typedef float f32x2 __attribute__((ext_vector_type(2)));
typedef short bf16x8 __attribute__((ext_vector_type(8)));
typedef GAS unsigned gu32;
#define RLX_AGENT __ATOMIC_RELAXED, __HIP_MEMORY_SCOPE_AGENT
#define LDS_WAIT() asm volatile("s_waitcnt lgkmcnt(0)" ::: "memory")
#define VM_WAIT() asm volatile("s_waitcnt vmcnt(0)" ::: "memory")
__device__ __forceinline__ unsigned f2bf(float f) { unsigned u = __builtin_bit_cast(unsigned, f); return (u + 0x7fffu + ((u >> 16) & 1u)) >> 16; }
__device__ __forceinline__ unsigned pk2(float lo, float hi) { return f2bf(lo) | (f2bf(hi) << 16); }
__device__ __forceinline__ float bflo(unsigned w) { return __builtin_bit_cast(float, w << 16); }
__device__ __forceinline__ float bfhi(unsigned w) { return __builtin_bit_cast(float, w & 0xffff0000u); }
__device__ __forceinline__ float wave_sum(float v) {
#pragma unroll
    for (int o = 1; o < 64; o <<= 1) v += __shfl_xor(v, o);
    return v;
}
#define DPP_F(x, ctrl) __builtin_bit_cast(float, __builtin_amdgcn_mov_dpp(__builtin_bit_cast(int, (x)), (ctrl), 0xF, 0xF, true))
__device__ __forceinline__ float row16_sum(float x) {
    x += DPP_F(x, 0xB1);
    x += DPP_F(x, 0x4E);
    x += DPP_F(x, 0x141);
    x += DPP_F(x, 0x140);
    return x;
}
#define XB_TMO      128
#define XB_XCNT(j)  (256  + 64 * (j))
#define XB_XSUB(j)  (1280 + 64 * (j))
#define XB_XGEN(j)  (2304 + 64 * (j))
#define XB_TOP      3328
#define XB_TOPGEN   3392
#define XCD_BAR_WORDS 3456
#define XB_SPIN_CAP (1u << 18)

__device__ __forceinline__ unsigned xb_ld(unsigned* p)              { return __hip_atomic_load(p, __ATOMIC_RELAXED, __HIP_MEMORY_SCOPE_AGENT); }
__device__ __forceinline__ unsigned xb_add(unsigned* p, unsigned v) { return __hip_atomic_fetch_add(p, v, __ATOMIC_RELAXED, __HIP_MEMORY_SCOPE_AGENT); }
__device__ __forceinline__ unsigned xb_xcc_id() { return (unsigned)__builtin_amdgcn_s_getreg((3 << 11) | 20) & 0xFu; }
#define XB_SPIN(cond, bar) do { unsigned _sp = 0; while (cond) { __builtin_amdgcn_s_sleep(1); \
    if ((++_sp & 255u) == 0u) { if (xb_ld(&(bar)[XB_TMO])) break; if (_sp > XB_SPIN_CAP) { atomicAdd(&(bar)[XB_TMO], 1u); break; } } } } while (0)

struct XcdBarrier {
    unsigned* bar; unsigned x;
    volatile LAS unsigned* st;
};

__device__ __forceinline__ XcdBarrier xcd_barrier_post(unsigned* bar, volatile LAS unsigned* st) {
    XcdBarrier b; b.bar = bar; b.x = xb_xcc_id(); b.st = st;
    if (threadIdx.x == 0) (void)xb_add(&bar[XB_XCNT(b.x)], 1u);
    return b;
}
__device__ __forceinline__ void xcd_barrier_complete(unsigned* bar, unsigned x, unsigned& nloc, unsigned& nx) {
    const unsigned G = gridDim.x * gridDim.y * gridDim.z;
    unsigned sum, cnt, mine, sp = 0u;
    for (;;) {
        sum = 0u; cnt = 0u; mine = 0u;
#pragma unroll
        for (unsigned j = 0; j < 16; ++j) { const unsigned c = xb_ld(&bar[XB_XCNT(j)]); sum += c; cnt += (c > 0u) ? 1u : 0u; mine = (j == x) ? c : mine; }
        if (sum == G) break;
        __builtin_amdgcn_s_sleep(1);
        if ((++sp & 255u) == 0u) { if (xb_ld(&bar[XB_TMO])) break; if (sp > XB_SPIN_CAP) { atomicAdd(&bar[XB_TMO], 1u); break; } }
    }
    nloc = mine > 0u ? mine : 1u; nx = cnt > 0u ? cnt : 1u;
}

__device__ __forceinline__ void xcd_barrier(const XcdBarrier& b) {
    asm volatile("s_waitcnt vmcnt(0)" ::: "memory");
    __syncthreads();
    if (threadIdx.x == 0) {
        unsigned* bar = b.bar;
        __builtin_amdgcn_s_waitcnt(0);
        unsigned nloc = b.st[0], nx = b.st[1];
        if (nloc == 0u) { xcd_barrier_complete(bar, b.x, nloc, nx); b.st[0] = nloc; b.st[1] = nx; }
        const unsigned old = xb_add(&bar[XB_XSUB(b.x)], 1u);
        const unsigned gen = old / nloc;
        if (old + 1u == (gen + 1u) * nloc) {
            __builtin_amdgcn_fence(__ATOMIC_RELEASE, "agent");
            asm volatile("s_waitcnt vmcnt(0)" ::: "memory");
            const unsigned og = xb_add(&bar[XB_TOP], 1u);
            const unsigned tg = og / nx;
            if (og + 1u == (tg + 1u) * nx) xb_add(&bar[XB_TOPGEN], 1u);
            else XB_SPIN(xb_ld(&bar[XB_TOPGEN]) == tg, bar);
            __builtin_amdgcn_fence(__ATOMIC_ACQUIRE, "agent");
            xb_add(&bar[XB_XGEN(b.x)], 1u);
            asm volatile("s_waitcnt vmcnt(0)" ::: "memory");
        } else {
            XB_SPIN(xb_ld(&bar[XB_XGEN(b.x)]) == gen, bar);
            __builtin_amdgcn_fence(__ATOMIC_ACQUIRE, "agent");
            asm volatile("s_waitcnt vmcnt(0)" ::: "memory");
        }
    }
    __syncthreads();
}

struct Ctx { LAS unsigned char* lds; int tid, lane, wave, gw, NGW, G, bid; };

__device__ __forceinline__ void transpose_item(const float* W, int ldw, int Kvalid, bf16* WT, int ldt, int drow0, int dcol0, int k0, int n0, LAS float* scr, int lane) {
#pragma unroll 8
    for (int i = 0; i < 32; ++i) { const int kk = 2 * i + (lane >> 5), k = k0 + kk; scr[kk * 33 + (lane & 31)] = (k < Kvalid) ? W[(size_t)k * ldw + n0 + (lane & 31)] : 0.f; }
    LDS_WAIT(); asm volatile("" ::: "memory");
    const int c = lane & 7;
#pragma unroll
    for (int j = 0; j < 4; ++j) { const int n = (lane >> 3) + 8 * j; const LAS float* s = scr + (8 * c) * 33 + n;
        v4u o; o.x = pk2(s[0 * 33], s[1 * 33]); o.y = pk2(s[2 * 33], s[3 * 33]); o.z = pk2(s[4 * 33], s[5 * 33]); o.w = pk2(s[6 * 33], s[7 * 33]);
        *(GAS v4u*)(WT + (size_t)(drow0 + n) * ldt + dcol0 + 8 * c) = o; }
    LDS_WAIT(); asm volatile("" ::: "memory");
}
template <bool GLU = false> __device__ __forceinline__ void transpose_mat(const Ctx& C, const float* W, int K, int N, bf16* WT, int ldt, int row_off, int& base, LAS float* scr) {
    const int nblk = N / 32, nit = ((K + 63) / 64) * nblk;
    int start = (C.gw - base) % C.NGW; if (start < 0) start += C.NGW;
    for (int it = start; it < nit; it += C.NGW) { const int kb = it / nblk, nb = it % nblk, n0 = 32 * nb;
        const int drow = GLU ? (n0 < FF ? (n0 / 128) * 256 + (n0 % 128) : ((n0 - FF) / 128) * 256 + 128 + ((n0 - FF) % 128)) : n0;
        transpose_item(W, N, K, WT, ldt, row_off + drow, 64 * kb, 64 * kb, n0, scr, C.lane); }
    base += nit;
}
__device__ __forceinline__ void zero_rows(const Ctx& C, bf16* WT, int ldt, int r0, int r1) {
    const size_t n16 = (size_t)(r1 - r0) * ldt / 8; GAS v4u* p = (GAS v4u*)(WT + (size_t)r0 * ldt);
    for (size_t i = (size_t)C.bid * 512 + C.tid; i < n16; i += (size_t)C.G * 512) p[i] = (v4u){0u, 0u, 0u, 0u};
}

struct In { const float* p[33]; };

__device__ __forceinline__ void p0_prologue(const Ctx& C, const In& in, unsigned char* ws, float* out) {
    LAS float* scr = (LAS float*)(C.lds + RING_OFF + C.wave * 16384);
    bf16* W1CAT = (bf16*)(ws + WS_W1CAT); bf16* WL2 = (bf16*)(ws + WS_WL2);
    int base = 0;
    transpose_mat(C, in.p[10], D, D, W1CAT, D, 0, base, scr);
    transpose_mat(C, in.p[11], D, D, W1CAT, D, 1024, base, scr);
    transpose_mat(C, in.p[12], D, D, W1CAT, D, 2048, base, scr);
    transpose_mat(C, in.p[15], D, 64, W1CAT, D, 3072, base, scr);
    transpose_mat(C, in.p[18], D, 64, W1CAT, D, 3328, base, scr);
    transpose_mat(C, in.p[20], D, 160, W1CAT, D, 3584, base, scr);
    transpose_mat(C, in.p[13], D, D, (bf16*)(ws + WS_WORW), D, 0, base, scr);
    transpose_mat<true>(C, in.p[29], D, F2, (bf16*)(ws + WS_WUP0), D, 0, base, scr);
    transpose_mat<true>(C, in.p[29] + (size_t)D * F2, D, F2, (bf16*)(ws + WS_WUP1), D, 0, base, scr);
    transpose_mat(C, in.p[32], FF, D, (bf16*)(ws + WS_WDN0), FF, 0, base, scr);
    transpose_mat(C, in.p[32] + (size_t)FF * D, FF, D, (bf16*)(ws + WS_WDN1), FF, 0, base, scr);
    transpose_mat(C, in.p[27], D, NQKV, (bf16*)(ws + WS_WQKV), D, 0, base, scr);
    transpose_mat(C, in.p[28], AW, D, (bf16*)(ws + WS_WOAT), AW, 0, base, scr);
    zero_rows(C, W1CAT, D, 3072 + 64, 3328); zero_rows(C, W1CAT, D, 3328 + 64, 3584); zero_rows(C, W1CAT, D, 3584 + 160, 3840);
    { const float* w2 = in.p[16]; const float* a2 = in.p[19]; const float* g2 = in.p[21];
      for (int idx = C.bid * 512 + C.tid; idx < 48 * 3072; idx += C.G * 512) { const int kc = idx / 3072, n = idx % 3072, k0 = 8 * kc; float v[8];
#pragma unroll
          for (int j = 0; j < 8; ++j) { const int k = k0 + j; float x = 0.f;
              if (n < 1024) { if (k < 64) x = w2[(size_t)k * D + n]; }
              else if (n < 2048) { if (k >= 64 && k < 128) x = a2[(size_t)(k - 64) * D + (n - 1024)]; }
              else { if (k >= 128 && k < 288) x = g2[(size_t)(k - 128) * D + (n - 2048)]; }
              v[j] = x; }
          v4u o; o.x = pk2(v[0], v[1]); o.y = pk2(v[2], v[3]); o.z = pk2(v[4], v[5]); o.w = pk2(v[6], v[7]);
          *(GAS v4u*)(WL2 + (size_t)n * 384 + k0) = o; } }
    { float* rope = (float*)(ws + WS_ROPE);
      for (int idx = C.bid * 512 + C.tid; idx < 2056 * 8; idx += C.G * 512) { const int pos = idx >> 3, i = idx & 7;
          const double c = i == 0 ? 0.15915494309189535 : i == 1 ? 0.03086376340470123 : i == 2 ? 0.005985185712713705 : i == 3 ? 0.001160663641240061 :
                           i == 4 ? 0.00022507907903927653 : i == 5 ? 4.364795279280289e-05 : i == 6 ? 8.464330808241401e-06 : 1.6414262627950345e-06;
          const double rev = (double)pos * c; const float fr = (float)(rev - __builtin_floor(rev));
          rope[2 * idx] = __builtin_amdgcn_cosf(fr); rope[2 * idx + 1] = __builtin_amdgcn_sinf(fr); } }
    { const float* g0 = in.p[8]; const float* mu = in.p[9]; bf16* XM = (bf16*)(ws + WS_XM);
      for (int m = C.gw; m < M; m += C.NGW) {
          const bool pr = m < MP; const int t = pr ? (m & (PT - 1)) : ((m - MP) & (STN - 1)), b = pr ? (m >> 11) : ((m - MP) >> 3);
          const float* xr = pr ? in.p[0] + (size_t)m * D : in.p[1] + (size_t)(m - MP) * D;
          f32x4 v[4], pv[4]; float ss = 0.f, ps = 0.f;
#pragma unroll
          for (int j = 0; j < 4; ++j) { v[j] = *(const GAS f32x4*)(xr + 4 * C.lane + 256 * j); ss += (v[j].x * v[j].x + v[j].y * v[j].y) + (v[j].z * v[j].z + v[j].w * v[j].w); }
          if (t > 0) {
#pragma unroll
              for (int j = 0; j < 4; ++j) { pv[j] = *(const GAS f32x4*)(xr - D + 4 * C.lane + 256 * j); ps += (pv[j].x * pv[j].x + pv[j].y * pv[j].y) + (pv[j].z * pv[j].z + pv[j].w * pv[j].w); }
          } else {
#pragma unroll
              for (int j = 0; j < 4; ++j) pv[j] = pr ? (f32x4){0.f, 0.f, 0.f, 0.f} : *(const GAS f32x4*)(in.p[2] + (size_t)b * D + 4 * C.lane + 256 * j);
          }
          const float rs = 1.0f / sqrtf(wave_sum(ss) * (1.f / D) + NORM_EPS), prs = 1.0f / sqrtf(wave_sum(ps) * (1.f / D) + NORM_EPS);
          const bool last = pr ? (t == PT - 1) : (t == STN - 1);
#pragma unroll
          for (int j = 0; j < 4; ++j) { const int col = 4 * C.lane + 256 * j; const f32x4 g = *(const GAS f32x4*)(g0 + col);
              const f32x4 hn = v[j] * rs * g; const f32x4 hp = t > 0 ? pv[j] * prs * g : pv[j]; const f32x4 xx = hp - hn;
              if (last) *(GAS f32x4*)(out + (pr ? O_PSHIFT : O_SSHIFT) + (size_t)b * D + col) = hn;
#pragma unroll
              for (int i = 0; i < 6; ++i) { const f32x4 mm = *(const GAS f32x4*)(mu + i * D + col); const f32x4 r = hn + xx * mm;
                  const int slot = i == 1 ? 3 : (i == 2 ? 1 : (i == 3 ? 2 : i));
                  v2u o; o.x = pk2(r.x, r.y); o.y = pk2(r.z, r.w); *(GAS v2u*)(XM + (size_t)slot * M * D + (size_t)m * D + col) = o; } }
      } }
}

constexpr int SC_OPS = 0, SC_OPS_BYTES = 16 * 16 * 20 * 4, SC_VV = 2 * SC_OPS_BYTES, SC_VV_BYTES = 16 * 32 * 4, SC_YB = SC_VV + 2 * SC_VV_BYTES, SC_YB_BYTES = 16 * 32 * 4;
struct ScanItem { size_t tok; int b, h, vh, nt; bool prompt, first, last, valid; };
__device__ __forceinline__ ScanItem scan_item(int q, int bid, int G) {
    ScanItem it; const int npu = (PB * RH * 2 - bid + G - 1) / G, npi = npu > 0 ? npu * 128 : 0;
    if (q < npi) { const int u = bid + (q >> 7) * G, c = q & 127; it.b = u >> 5; it.h = (u >> 1) & 15; it.vh = u & 1; it.tok = (size_t)it.b * PT + 16 * c; it.nt = 16; it.prompt = true; it.first = c == 0; it.last = c == 127; it.valid = true; }
    else { const int su = bid + (q - npi) * G; it.valid = su < SBN * RH * 2; it.b = su >> 5; it.h = (su >> 1) & 15; it.vh = su & 1; it.tok = (size_t)MP + (size_t)it.b * STN; it.nt = 8; it.prompt = false; it.first = true; it.last = true; }
    return it;
}
__device__ __forceinline__ void scan_phase(const Ctx& C, const In& in, unsigned char* ws, float* out) {
    const float* Rb = (const float*)(ws + WS_R); const float* Kb = (const float*)(ws + WS_K); const float* Vb = (const float*)(ws + WS_V);
    const float* Db = (const float*)(ws + WS_DC); const float* Ab = (const float*)(ws + WS_AA); float* Yb = (float*)(ws + WS_Y); float* Bon = (float*)(ws + WS_BONUS);
    const int row = C.tid >> 4, p = C.tid & 15;
    LAS float* OPS = (LAS float*)(C.lds + SC_OPS); LAS float* VV = (LAS float*)(C.lds + SC_VV); LAS float* YB = (LAS float*)(C.lds + SC_YB);
    const bool stg = C.tid < 256, stv = C.tid >= 256 && C.tid < 384; const int vt = (C.tid - 256) >> 3, vq = (C.tid - 256) & 7;
    f32x4 lr, lk, ld, la, lv, Snext, pka, pkw, prk, nka, nkw, nrk; lr = lk = ld = la = lv = Snext = pka = pkw = prk = nka = nkw = nrk = (f32x4){0.f, 0.f, 0.f, 0.f};
#define SC_FETCH(it) do { if ((it).valid) { \
        if (stg && row < (it).nt) { const size_t o = ((it).tok + row) * D + (it).h * 64 + 4 * p; lr = *(const GAS f32x4*)(Rb + o); lk = *(const GAS f32x4*)(Kb + o); ld = *(const GAS f32x4*)(Db + o); la = *(const GAS f32x4*)(Ab + o); } \
        if (stv && vt < (it).nt) lv = *(const GAS f32x4*)(Vb + ((it).tok + vt) * D + (it).h * 64 + 32 * (it).vh + 4 * vq); \
        if (stg && (it).first) { const int col_ = (it).h * 64 + 4 * p; nka = *(const GAS f32x4*)(in.p[23] + col_); nkw = *(const GAS f32x4*)(in.p[22] + col_); nrk = *(const GAS f32x4*)(in.p[24] + col_); } \
        if ((it).first && !(it).prompt) Snext = *(const GAS f32x4*)(in.p[3] + ((((size_t)(it).b * RH + (it).h) * 64 + 32 * (it).vh + row) * 64 + 4 * p)); } } while (0)
#define SC_STAGE(it, buf) do { if ((it).valid) { if ((it).first) { pka = nka; pkw = nkw; prk = nrk; } \
        if (stg && row < (it).nt) { \
            const f32x4 kp = lk * (1.0f + (la - 1.0f) * pka), kr = lk * pkw; const float n2 = row16_sum((kr.x * kr.x + kr.y * kr.y) + (kr.z * kr.z + kr.w * kr.w)); \
            const f32x4 kn = kr * __builtin_amdgcn_rsqf(fmaxf(n2, 1e-24f)); const f32x4 rb = lr * kp * prk; const float bon = row16_sum((rb.x + rb.y) + (rb.z + rb.w)); \
            LAS f32x4* o = (LAS f32x4*)(OPS + (buf) * (SC_OPS_BYTES / 4) + (row * 16 + p) * 20); o[0] = kn; o[1] = ld; o[2] = kp; o[3] = lr; o[4] = kn * la; \
            if ((it).vh == 0 && p == 0) Bon[((it).tok + row) * 16 + (it).h] = bon; } \
        if (stv && vt < (it).nt) *(LAS f32x4*)(VV + (buf) * (SC_VV_BYTES / 4) + vt * 32 + 4 * vq) = lv; } } while (0)
#define SC_STEP(tl) do { const f32x4 kk = op[(tl) * 80 + 0], dd = op[(tl) * 80 + 1], kp = op[(tl) * 80 + 2], rr = op[(tl) * 80 + 3], kka = op[(tl) * 80 + 4]; const float vv = vvp[(tl) * 32]; \
        f32x2 t_ = S01 * kk.lo; t_ = S23 * kk.hi + t_; const float sk = row16_sum(t_.x + t_.y); const f32x2 vv2 = (f32x2){vv, vv}, sk2 = (f32x2){sk, sk}; \
        S01 = S01 * dd.lo; S01 = kp.lo * vv2 + S01; S01 = S01 - kka.lo * sk2; S23 = S23 * dd.hi; S23 = kp.hi * vv2 + S23; S23 = S23 - kka.hi * sk2; \
        f32x2 u_ = S01 * rr.lo; u_ = S23 * rr.hi + u_; const float y = row16_sum(u_.x + u_.y); ykeep = (p == (tl)) ? y : ykeep; } while (0)
    ScanItem cur = scan_item(0, C.bid, C.G);
    if (!cur.valid) return;
    SC_FETCH(cur); SC_STAGE(cur, 0);
    f32x4 S = cur.prompt ? (f32x4){0.f, 0.f, 0.f, 0.f} : Snext; f32x2 S01 = S.lo, S23 = S.hi;
    __syncthreads();
#ifdef SCAN_DUP_STEPS
    f32x2 D01 = (f32x2){0.f, 0.f}, D23 = D01; float dacc = 0.f;
#endif
    for (int q = 0; cur.valid; ++q) {
        const int buf = q & 1; const ScanItem nxt = scan_item(q + 1, C.bid, C.G);
        SC_FETCH(nxt);
        float ykeep = 0.f;
        const LAS f32x4* op = (const LAS f32x4*)(OPS + buf * (SC_OPS_BYTES / 4) + p * 20); const LAS float* vvp = VV + buf * (SC_VV_BYTES / 4) + row;
        SC_STEP(0); SC_STEP(1); SC_STEP(2); SC_STEP(3); SC_STEP(4); SC_STEP(5); SC_STEP(6); SC_STEP(7);
        if (cur.nt == 16) { SC_STEP(8); SC_STEP(9); SC_STEP(10); SC_STEP(11); SC_STEP(12); SC_STEP(13); SC_STEP(14); SC_STEP(15); }
#ifdef SCAN_DUP_STEPS
        { f32x2 k01 = S01, k23 = S23; float yk2 = ykeep; S01 = D01; S23 = D23;
          SC_STEP(0); SC_STEP(1); SC_STEP(2); SC_STEP(3); SC_STEP(4); SC_STEP(5); SC_STEP(6); SC_STEP(7);
          if (cur.nt == 16) { SC_STEP(8); SC_STEP(9); SC_STEP(10); SC_STEP(11); SC_STEP(12); SC_STEP(13); SC_STEP(14); SC_STEP(15); }
          D01 = S01; D23 = S23; dacc += ykeep; S01 = k01; S23 = k23; ykeep = yk2; }
#endif
        if (p < cur.nt) YB[buf * (SC_YB_BYTES / 4) + p * 32 + row] = ykeep;
        if (cur.last) *(GAS f32x4*)(out + (cur.prompt ? O_PWKV : O_SWKV) + ((((size_t)cur.b * RH + cur.h) * 64 + 32 * cur.vh + row) * 64 + 4 * p)) = (f32x4){S01.x, S01.y, S23.x, S23.y};
        SC_STAGE(nxt, buf ^ 1);
        if (nxt.valid && nxt.first) { S = nxt.prompt ? (f32x4){0.f, 0.f, 0.f, 0.f} : Snext; S01 = S.lo; S23 = S.hi; }
        __syncthreads();
        { const int tl = C.tid >> 5, rr = C.tid & 31; if (tl < cur.nt) Yb[(cur.tok + tl) * D + cur.h * 64 + 32 * cur.vh + rr] = YB[buf * (SC_YB_BYTES / 4) + tl * 32 + rr]; }
        cur = nxt;
    }
#ifdef SCAN_DUP_STEPS
    ((float*)(ws + WS_ACT))[(size_t)C.bid * 512 + C.tid] = dacc + D01.x + D01.y + D23.x + D23.y;
#endif
#undef SC_FETCH
#undef SC_STAGE
#undef SC_STEP
}
__device__ __forceinline__ void scan_post_phase(const Ctx& C, const In& in, unsigned char* ws) {
    const float* Yb = (const float*)(ws + WS_Y); const float* Vb = (const float*)(ws + WS_V); const float* Gb = (const float*)(ws + WS_GG); const float* Bon = (const float*)(ws + WS_BONUS);
    bf16* YG = (bf16*)(ws + WS_YG); const float* lg = in.p[25]; const float* lb = in.p[26];
    for (int m = C.gw; m < M; m += C.NGW) {
#pragma unroll
        for (int j = 0; j < 4; ++j) { const int col = 4 * C.lane + 256 * j, head = 4 * j + (C.lane >> 4); const size_t o = (size_t)m * D + col;
            const f32x4 y = *(const GAS f32x4*)(Yb + o); const float mean = row16_sum((y.x + y.y) + (y.z + y.w)) * (1.f / 64.f);
            const f32x4 d = y - mean; const float var = row16_sum((d.x * d.x + d.y * d.y) + (d.z * d.z + d.w * d.w)) * (1.f / 64.f);
            const float rs = 1.0f / sqrtf(var + GN_EPS), bon = Bon[(size_t)m * 16 + head];
            const f32x4 vv = *(const GAS f32x4*)(Vb + o), gg = *(const GAS f32x4*)(Gb + o), g4 = *(const GAS f32x4*)(lg + col), b4 = *(const GAS f32x4*)(lb + col);
            const f32x4 r = (d * rs * g4 + b4 + vv * bon) * gg;
            v2u w; w.x = pk2(r.x, r.y); w.y = pk2(r.z, r.w); *(GAS v2u*)(YG + o) = w; }
    }
}
__device__ __forceinline__ void rowwise_phase(const Ctx& C, const In& in, const float* xin, const float* mo, const float* g1, float* xout, const float* g2, bf16* xn, int nsl) {
    const float* SLAB = (const float*)(mo) + ((ptrdiff_t)WS_SLAB - (ptrdiff_t)WS_MO) / 4;
    for (int m = C.gw; m < M; m += C.NGW) {
        const float* xr = xin ? xin + (size_t)m * D : (m < MP ? in.p[0] + (size_t)m * D : in.p[1] + (size_t)(m - MP) * D);
        f32x4 a[4], x[4]; float ss = 0.f;
#pragma unroll
        for (int j = 0; j < 4; ++j) {
            if (m < MP) a[j] = *(const GAS f32x4*)(mo + (size_t)m * D + 4 * C.lane + 256 * j);
            else { a[j] = (f32x4){0.f, 0.f, 0.f, 0.f}; for (int s = 0; s < nsl; ++s) a[j] = a[j] + *(const GAS f32x4*)(SLAB + ((size_t)s * 1024 + (m - MP)) * D + 4 * C.lane + 256 * j); }
            x[j] = *(const GAS f32x4*)(xr + 4 * C.lane + 256 * j);
            ss += (a[j].x * a[j].x + a[j].y * a[j].y) + (a[j].z * a[j].z + a[j].w * a[j].w); }
        const float rs = 1.0f / sqrtf(wave_sum(ss) * (1.f / D) + NORM_EPS); float s2 = 0.f;
#pragma unroll
        for (int j = 0; j < 4; ++j) { const int col = 4 * C.lane + 256 * j; x[j] = x[j] + a[j] * rs * *(const GAS f32x4*)(g1 + col);
            *(GAS f32x4*)(xout + (size_t)m * D + col) = x[j]; s2 += (x[j].x * x[j].x + x[j].y * x[j].y) + (x[j].z * x[j].z + x[j].w * x[j].w); }
        if (xn) { const float r2 = 1.0f / sqrtf(wave_sum(s2) * (1.f / D) + NORM_EPS);
#pragma unroll
            for (int j = 0; j < 4; ++j) { const int col = 4 * C.lane + 256 * j; const f32x4 r = x[j] * r2 * *(const GAS f32x4*)(g2 + col);
                v2u w; w.x = pk2(r.x, r.y); w.y = pk2(r.z, r.w); *(GAS v2u*)(xn + (size_t)m * D + col) = w; } }
    }
}
__device__ __forceinline__ float gelu_tanh(float x) { const float u = 0.7978845608028654f * (x + 0.044715f * x * x * x); return 0.5f * x * (1.0f + fast_tanh(u)); }
__device__ __forceinline__ void unpack8(const v4u w, float* f) { f[0] = bflo(w.x); f[1] = bfhi(w.x); f[2] = bflo(w.y); f[3] = bfhi(w.y); f[4] = bflo(w.z); f[5] = bfhi(w.z); f[6] = bflo(w.w); f[7] = bfhi(w.w); }
__device__ __forceinline__ void fixup_phase(const Ctx& C, unsigned char* ws, const float* cw, const float* cb, const float* sc) {
    const float* HALO = (const float*)(ws + WS_HID); const float* RAWS = (const float*)(ws + WS_HID + 8 * MiB); bf16* ACT = (bf16*)(ws + WS_ACT);
    constexpr int NC4 = FF / 4, NPROMPT = 56 * 2 * NC4, NSAMPLE = SBN * 2 * NC4;
    for (int idx = C.bid * 512 + C.tid; idx < NPROMPT + NSAMPLE; idx += C.G * 512) {
        const float *p0[2], *p1[2], *p2[2]; int c; size_t orow;
        if (idx < NPROMPT) { const int q = idx / NC4, r = q & 1, pi = q >> 1, pm = (pi / 7) * 8 + 1 + (pi % 7); c = (idx % NC4) * 4; orow = (size_t)pm * 256 + r;
#pragma unroll
            for (int s = 0; s < 2; ++s) { const size_t co = (size_t)s * FF + c; p0[s] = HALO + ((size_t)pm * 4 + r) * F2 + co;
                p1[s] = HALO + (r == 1 ? ((size_t)pm * 4 + 0) : ((size_t)(pm - 1) * 4 + 3)) * F2 + co; p2[s] = HALO + ((size_t)(pm - 1) * 4 + (r == 0 ? 2 : 3)) * F2 + co; }
        } else { const int q = (idx - NPROMPT) / NC4, t = q & 1, b = q >> 1, rs = b * 8 + t; c = ((idx - NPROMPT) % NC4) * 4; orow = (size_t)MP + rs;
#pragma unroll
            for (int s = 0; s < 2; ++s) { const size_t co = (size_t)s * FF + c; p0[s] = RAWS + (size_t)rs * F2 + co;
                p1[s] = t == 0 ? sc + ((size_t)b * 2 + 1) * F2 + co : RAWS + (size_t)(rs - 1) * F2 + co; p2[s] = sc + ((size_t)b * 2 + t) * F2 + co; }
        }
        f32x4 cv[2];
#pragma unroll
        for (int s = 0; s < 2; ++s) { const size_t co = (size_t)s * FF + c; const f32x4 h0 = *(const GAS f32x4*)p0[s], h1 = *(const GAS f32x4*)p1[s], h2 = *(const GAS f32x4*)p2[s];
            cv[s] = *(const GAS f32x4*)(cb + co) + *(const GAS f32x4*)(cw + co) * h2 + *(const GAS f32x4*)(cw + F2 + co) * h1 + *(const GAS f32x4*)(cw + 2 * F2 + co) * h0; }
        v2u o; o.x = pk2(gelu_tanh(cv[0].x) * cv[1].x, gelu_tanh(cv[0].y) * cv[1].y); o.y = pk2(gelu_tanh(cv[0].z) * cv[1].z, gelu_tanh(cv[0].w) * cv[1].w);
        *(GAS v2u*)(ACT + orow * FF + c) = o; }
}

constexpr float QSCALE = 0.125f * 1.4426950408889634f;
__device__ __forceinline__ void rope_phase(const Ctx& C, const In& in, unsigned char* ws, float* out) {
    bf16* QKV = (bf16*)(ws + WS_QKV); const float* rope = (const float*)(ws + WS_ROPE);
    for (int m = C.gw; m < M; m += C.NGW) {
        const bool pr = m < MP; const int t = pr ? (m & (PT - 1)) : ((m - MP) & 7), b = pr ? (m >> 11) : ((m - MP) >> 3), pos = pr ? t : PT + t;
        bf16* rowp = QKV + (size_t)m * NQKV;
        f32x4 cs0 = *(const GAS f32x4*)(rope + (size_t)pos * 16), cs1 = *(const GAS f32x4*)(rope + (size_t)pos * 16 + 4), cs2 = *(const GAS f32x4*)(rope + (size_t)pos * 16 + 8), cs3 = *(const GAS f32x4*)(rope + (size_t)pos * 16 + 12);
        const float cc[8] = {cs0.x, cs0.z, cs1.x, cs1.z, cs2.x, cs2.z, cs3.x, cs3.z}, sn[8] = {cs0.y, cs0.w, cs1.y, cs1.w, cs2.y, cs2.w, cs3.y, cs3.w};
#pragma unroll
        for (int it = 0; it < 9; ++it) {
            const int c8 = C.lane + 64 * it, col0 = 8 * c8, s = col0 / 1536, rem = col0 % 1536, g = rem / 512, h = (rem % 512) / 64, e0 = rem % 64;
            const v4u own = *(const GAS v4u*)(rowp + col0);
            const bool rot = (s < 2) && (e0 < 16);
            v4u par = own; if (rot) par = *(const GAS v4u*)(rowp + col0 + (e0 == 0 ? 8 : -8));
            float x[8], y[8], o[8]; unpack8(own, x); unpack8(par, y);
#pragma unroll
            for (int i = 0; i < 8; ++i) o[i] = !rot ? x[i] : (e0 == 0 ? x[i] * cc[i] - y[i] * sn[i] : x[i] * cc[i] + y[i] * sn[i]);
            if (s == 0) {
#pragma unroll
                for (int i = 0; i < 8; ++i) o[i] *= QSCALE; }
            if (s < 2) { v4u w; w.x = pk2(o[0], o[1]); w.y = pk2(o[2], o[3]); w.z = pk2(o[4], o[5]); w.w = pk2(o[6], o[7]); *(GAS v4u*)(rowp + col0) = w; }
            if (s >= 1) {
                const int L = g == 0 ? 128 : (g == 1 ? 512 : 2048); float* dst = nullptr;
                if (pr) { const int j = t - (PT - L); if (j >= 0) dst = out + (g == 0 ? O_PKV128 : (g == 1 ? O_PKV512 : O_PKV2048)) + ((((size_t)b * L + j) * 2 + (s - 1)) * 8 + h) * 64 + e0; }
                else dst = out + (g == 0 ? O_SKV128 : (g == 1 ? O_SKV512 : O_SKV2048)) + ((((size_t)b * 8 + t) * 2 + (s - 1)) * 8 + h) * 64 + e0;
                if (dst) { *(GAS f32x4*)dst = (f32x4){o[0], o[1], o[2], o[3]}; *(GAS f32x4*)(dst + 4) = (f32x4){o[4], o[5], o[6], o[7]}; } }
        }
    }
}

constexpr int AT_RS = 160;
constexpr int AT_K = 0, AT_V = 256 * AT_RS;
typedef short s16x4 __attribute__((ext_vector_type(4)));
__device__ __forceinline__ s16x4 lds_tr16(const LAS unsigned char* p) { return __builtin_bit_cast(s16x4, __builtin_amdgcn_ds_read_tr16_b64_v4i16((LAS s16x4*)p)); }
struct PUnit { int b, h, g, res, n; };
__device__ __forceinline__ PUnit punit(int u) { PUnit r; const int bh = u / 48, j = u % 48; r.b = bh >> 3; r.h = bh & 7;
    if (j < 16) { r.g = 0; r.res = 0; r.n = j; } else if (j < 32) { r.g = 1; r.res = (j - 16) >> 2; r.n = (j - 16) & 3; } else { r.g = 2; r.res = j - 32; r.n = 0; } return r; }
__device__ __forceinline__ void pattn_load(const Ctx& C, const bf16* QKV, const PUnit& u, v4u (&kr)[4], v4u (&vr)[4]) {
    const int Dl = u.g == 0 ? 1 : (u.g == 1 ? 4 : 16);
#pragma unroll
    for (int i = 0; i < 4; ++i) { const int ch = C.tid + 512 * i, kj = ch >> 3, c = ch & 7; int lk = (u.n - 1) * 128 + kj; lk = lk < 0 ? 0 : lk;
        const bf16* rp = QKV + ((size_t)u.b * PT + u.res + Dl * lk) * NQKV + u.h * 64 + c * 8;
        kr[i] = *(const GAS v4u*)(rp + (3 + u.g) * 512); vr[i] = *(const GAS v4u*)(rp + (6 + u.g) * 512); }
}
__device__ __forceinline__ void pattn_store_lds(const Ctx& C, const v4u (&kr)[4], const v4u (&vr)[4]) {
#pragma unroll
    for (int i = 0; i < 4; ++i) { const int ch = C.tid + 512 * i, kj = ch >> 3, c = ch & 7;
        *(LAS v4u*)(C.lds + AT_K + kj * AT_RS + c * 16) = kr[i]; *(LAS v4u*)(C.lds + AT_V + kj * AT_RS + c * 16) = vr[i]; }
}
__device__ __forceinline__ void pattn_compute(const Ctx& C, unsigned char* ws, const PUnit& u) {
    const bf16* QKV = (const bf16*)(ws + WS_QKV); bf16* OG = (bf16*)(ws + WS_OG); float* LSE = (float*)(ws + WS_LSE);
    const int Dl = u.g == 0 ? 1 : (u.g == 1 ? 4 : 16), q16 = C.lane & 15, g4 = C.lane >> 4, qi = 16 * C.wave + q16;
    const size_t qrow = (size_t)u.b * PT + u.res + Dl * (u.n * 128 + qi);
    const bf16* qp = QKV + qrow * NQKV + u.g * 512 + u.h * 64;
    const bf16x8 qf0 = *(const GAS bf16x8*)(qp + 8 * g4), qf1 = *(const GAS bf16x8*)(qp + 32 + 8 * g4);
    f32x4 sc[16];
    const LAS unsigned char* kbase = C.lds + AT_K + q16 * AT_RS + g4 * 16;
#pragma unroll
    for (int T = 0; T < 16; ++T) { const bf16x8 k0 = *(const LAS bf16x8*)(kbase + T * 16 * AT_RS), k1 = *(const LAS bf16x8*)(kbase + T * 16 * AT_RS + 64);
        f32x4 a = __builtin_amdgcn_mfma_f32_16x16x32_bf16(k0, qf0, (f32x4){0.f, 0.f, 0.f, 0.f}, 0, 0, 0); sc[T] = __builtin_amdgcn_mfma_f32_16x16x32_bf16(k1, qf1, a, 0, 0, 0); }
    const int klo = (u.n == 0 && qi < 128) ? 128 : qi; float mx = -1e30f;
#pragma unroll
    for (int T = 0; T < 16; ++T)
#pragma unroll
        for (int j = 0; j < 4; ++j) { const int kj = 16 * T + 4 * g4 + j; const bool ok = kj >= klo && kj <= qi + 128; sc[T][j] = ok ? sc[T][j] : -1e30f; mx = fmaxf(mx, sc[T][j]); }
    mx = fmaxf(mx, __shfl_xor(mx, 16)); mx = fmaxf(mx, __shfl_xor(mx, 32));
    float sum = 0.f;
#pragma unroll
    for (int T = 0; T < 16; ++T)
#pragma unroll
        for (int j = 0; j < 4; ++j) { const float p = __builtin_amdgcn_exp2f(sc[T][j] - mx); sc[T][j] = p; sum += p; }
    sum += __shfl_xor(sum, 16); sum += __shfl_xor(sum, 32);
    f32x4 oa[4] = {(f32x4){0.f, 0.f, 0.f, 0.f}, (f32x4){0.f, 0.f, 0.f, 0.f}, (f32x4){0.f, 0.f, 0.f, 0.f}, (f32x4){0.f, 0.f, 0.f, 0.f}};
    const LAS unsigned char* vbase = C.lds + AT_V + (4 * g4 + (q16 >> 2)) * AT_RS + (q16 & 3) * 8;
#pragma unroll
    for (int s = 0; s < 8; ++s) {
        pg8::u32x4 pw; pw.x = pg8::cvt_pk_bf16(sc[2 * s][0], sc[2 * s][1]); pw.y = pg8::cvt_pk_bf16(sc[2 * s][2], sc[2 * s][3]); pw.z = pg8::cvt_pk_bf16(sc[2 * s + 1][0], sc[2 * s + 1][1]); pw.w = pg8::cvt_pk_bf16(sc[2 * s + 1][2], sc[2 * s + 1][3]);
        const bf16x8 pf = __builtin_bit_cast(bf16x8, pw);
#pragma unroll
        for (int c = 0; c < 4; ++c) { const s16x4 lo = lds_tr16(vbase + (32 * s) * AT_RS + c * 32), hi = lds_tr16(vbase + (32 * s + 16) * AT_RS + c * 32);
            const bf16x8 vf = (bf16x8){lo[0], lo[1], lo[2], lo[3], hi[0], hi[1], hi[2], hi[3]};
            oa[c] = __builtin_amdgcn_mfma_f32_16x16x32_bf16(vf, pf, oa[c], 0, 0, 0); }
    }
    const float inv = 1.0f / sum;
    bf16* op = OG + ((size_t)u.g * M + qrow) * AW + u.h * 64 + 4 * g4;
#pragma unroll
    for (int c = 0; c < 4; ++c) { v2u w; w.x = pk2(oa[c][0] * inv, oa[c][1] * inv); w.y = pk2(oa[c][2] * inv, oa[c][3] * inv); *(GAS v2u*)(op + 16 * c) = w; }
    if (g4 == 0) LSE[((size_t)u.g * M + qrow) * 8 + u.h] = mx + __builtin_amdgcn_logf(sum);
}
__device__ __forceinline__ void sattn_unit(const Ctx& C, const float* cache_g, unsigned char* ws, const float* out, int b, int g, int h) {
    const bf16* QKV = (const bf16*)(ws + WS_QKV); bf16* OG = (bf16*)(ws + WS_OG); float* LSE = (float*)(ws + WS_LSE);
    const int L = g == 0 ? 128 : (g == 1 ? 512 : 2048), Dl = g == 0 ? 1 : (g == 1 ? 4 : 16), i = C.wave, d16 = C.lane & 15, sub = C.lane >> 4;
    const size_t qrow = (size_t)MP + (size_t)b * 8 + i;
    const v2u qw = *(const GAS v2u*)(QKV + qrow * NQKV + g * 512 + h * 64 + 4 * d16);
    const f32x4 q = (f32x4){bflo(qw.x), bfhi(qw.x), bflo(qw.y), bfhi(qw.y)};
    const float* cache = cache_g + (size_t)b * L * 1024 + h * 64 + 4 * d16;
    const float* fresh = out + (g == 0 ? O_SKV128 : (g == 1 ? O_SKV512 : O_SKV2048)) + (size_t)b * 8 * 1024 + h * 64 + 4 * d16;
    float s[33]; float mx = -1e30f;
#pragma unroll
    for (int it = 0; it < 33; ++it) { const int j = 4 * it + sub; const bool ok = j <= 128; const int idx = L + i - Dl * (ok ? j : 0);
        const float* kp = idx >= L ? fresh + (size_t)(idx - L) * 1024 : cache + (size_t)idx * 1024;
        const f32x4 kv = *(const GAS f32x4*)kp;
        float d = (q.x * kv.x + q.y * kv.y) + (q.z * kv.z + q.w * kv.w); d = row16_sum(d);
        s[it] = ok ? d : -1e30f; mx = fmaxf(mx, s[it]); }
    mx = fmaxf(mx, __shfl_xor(mx, 16)); mx = fmaxf(mx, __shfl_xor(mx, 32));
    float sum = 0.f; f32x4 o = (f32x4){0.f, 0.f, 0.f, 0.f};
#pragma unroll
    for (int it = 0; it < 33; ++it) { const int j = 4 * it + sub; const bool ok = j <= 128; const int idx = L + i - Dl * (ok ? j : 0);
        const float* vp = (idx >= L ? fresh + (size_t)(idx - L) * 1024 : cache + (size_t)idx * 1024) + 512;
        const f32x4 vv = *(const GAS f32x4*)vp; const float p = __builtin_amdgcn_exp2f(s[it] - mx); sum += p; o = o + vv * p; }
    sum += __shfl_xor(sum, 16); sum += __shfl_xor(sum, 32);
#pragma unroll
    for (int e = 0; e < 4; ++e) { o[e] += __shfl_xor(o[e], 16); o[e] += __shfl_xor(o[e], 32); }
    if (sub == 0) { const float inv = 1.0f / sum; v2u w; w.x = pk2(o.x * inv, o.y * inv); w.y = pk2(o.z * inv, o.w * inv);
        *(GAS v2u*)(OG + ((size_t)g * M + qrow) * AW + h * 64 + 4 * d16) = w;
        if (d16 == 0) LSE[((size_t)g * M + qrow) * 8 + h] = mx + __builtin_amdgcn_logf(sum); }
}
typedef const __attribute__((address_space(4))) In* KInP;
__device__ __forceinline__ void attn_phase(const Ctx& C, KInP kp, unsigned char* ws, float* out) {
    const bf16* QKV = (const bf16*)(ws + WS_QKV);
    constexpr int NPU = PB * 8 * 48;
    v4u kr[4], vr[4];
    int u = C.bid;
    if (u < NPU) { const PUnit pu = punit(u); pattn_load(C, QKV, pu, kr, vr); }
    for (; u < NPU; u += C.G) {
        const PUnit pu = punit(u);
        pattn_store_lds(C, kr, vr);
        __syncthreads();
        if (u + C.G < NPU) { const PUnit nu = punit(u + C.G); pattn_load(C, QKV, nu, kr, vr); }
        pattn_compute(C, ws, pu);
        __syncthreads();
    }
#ifndef ATTN_REP_SAMPLE
#define ATTN_REP_SAMPLE 1
#endif
    for (int rep_ = 0; rep_ < ATTN_REP_SAMPLE; ++rep_)
    for (int su = C.bid; su < SBN * 3 * 8; su += C.G) { const int h = su & 7, b = (su >> 3) & 127, g = su >> 10; const float* cache_g = kp->p[4 + (2 - g)];
        sattn_unit(C, cache_g, ws, out, b, 2 - g, h); }
}
__device__ __forceinline__ void merge_phase(const Ctx& C, unsigned char* ws) {
    const bf16* OG = (const bf16*)(ws + WS_OG); const float* LSE = (const float*)(ws + WS_LSE); bf16* OM = (bf16*)(ws + WS_OM);
    for (int idx = C.bid * 512 + C.tid; idx < M * 64; idx += C.G * 512) { const int m = idx >> 6, c8 = idx & 63, h = c8 >> 3;
        const float l0 = LSE[((size_t)0 * M + m) * 8 + h], l1 = LSE[((size_t)1 * M + m) * 8 + h], l2 = LSE[((size_t)2 * M + m) * 8 + h];
        const float mx = fmaxf(l0, fmaxf(l1, l2)); float w0 = __builtin_amdgcn_exp2f(l0 - mx), w1 = __builtin_amdgcn_exp2f(l1 - mx), w2 = __builtin_amdgcn_exp2f(l2 - mx);
        const float inv = 1.0f / (w0 + w1 + w2); w0 *= inv; w1 *= inv; w2 *= inv;
        float a[8], b[8], c[8];
        unpack8(*(const GAS v4u*)(OG + ((size_t)0 * M + m) * AW + 8 * c8), a); unpack8(*(const GAS v4u*)(OG + ((size_t)1 * M + m) * AW + 8 * c8), b); unpack8(*(const GAS v4u*)(OG + ((size_t)2 * M + m) * AW + 8 * c8), c);
        float o[8];
#pragma unroll
        for (int e = 0; e < 8; ++e) o[e] = w0 * a[e] + w1 * b[e] + w2 * c[e];
        v4u w; w.x = pk2(o[0], o[1]); w.y = pk2(o[2], o[3]); w.z = pk2(o[4], o[5]); w.w = pk2(o[6], o[7]);
        *(GAS v4u*)(OM + (size_t)m * AW + 8 * c8) = w; }
}

#ifndef MK_ONE_LAUNCH
#define MK_ONE_LAUNCH 1
#endif
#ifndef REP_MASK
#define REP_MASK 0
#endif
#ifndef ONLY
#define ONLY -1
#endif
constexpr int N_PHASES = 21;
struct Args { In in; float* out; unsigned char* ws; int ph_lo, ph_hi; };
typedef const __attribute__((address_space(4))) In* KIn;
__device__ __forceinline__ KIn launder_kernarg() { unsigned long long p = (unsigned long long)__builtin_amdgcn_kernarg_segment_ptr(); asm volatile("" : "+s"(p)); return (KIn)p; }
#define IN_LOAD() In in; { KIn kp_ = launder_kernarg(); _Pragma("unroll") for (int i_ = 0; i_ < 33; ++i_) in.p[i_] = kp_->p[i_]; }
#define GEMM_PHASE(EPI, Aoff, Boff, Nn, Kk, ASEL, ...) { pg8::Gemm g{(const bf16*)(ws + (Aoff)), (const bf16*)(ws + (Boff)), M, (Nn), (Kk), (ASEL)}; pg8::StaticOrder S; S.init(M, (Nn), C.G, C.bid, (Kk)); \
        pg8::EPI E{__VA_ARGS__}; pg8::gemm_phase<pg8::EPI, pg8::StaticOrder, true, true>(ring, g, S, E); }
#define SPLIT_PHASE(Aoff, Boff, Kk) { pg8::Gemm g{(const bf16*)(ws + (Aoff)), (const bf16*)(ws + (Boff)), M, D, (Kk), 0}; pg8::SplitOrder S; S.init(C.G, C.bid, (Kk)); \
        pg8::EpiF32S E{(float*)(ws + WS_MO), (float*)(ws + WS_SLAB)}; pg8::gemm_phase<pg8::EpiF32S, pg8::SplitOrder, true, true>(ring, g, S, E); }
#define DOWN_PHASE(Boff, layer) SPLIT_PHASE(WS_ACT, Boff, FF)
#define FIX_PHASE(layer) { IN_LOAD(); fixup_phase(C, ws, in.p[30] + (size_t)(layer) * 3 * F2, in.p[31] + (size_t)(layer) * F2, in.p[7] + (size_t)(layer) * SBN * 2 * F2); }
#define UP_PHASE(Boff, layer) { IN_LOAD(); GEMM_PHASE(EpiConv, WS_XN, Boff, F2, D, 0, (bf16*)(ws + WS_ACT), (float*)(ws + WS_HID), (float*)(ws + WS_HID + 8 * MiB), out + O_PCONV + (size_t)(layer) * PB * 2 * F2, out + O_SCONV + (size_t)(layer) * SBN * 2 * F2, \
        in.p[30] + (size_t)(layer) * 3 * F2, in.p[31] + (size_t)(layer) * F2, (LAS float*)(C.lds + EX_OFF)) }

#define PBODY_0 { IN_LOAD(); p0_prologue(C, in, ws, out); }
#define PBODY_1 GEMM_PHASE(EpiG1, WS_XM, WS_W1CAT, 3840, D, RB16, (float*)(ws + WS_R), (bf16*)(ws + WS_L2A))
#define PBODY_2 { IN_LOAD(); GEMM_PHASE(EpiL2, WS_L2A, WS_WL2, 3072, 384, 0, (float*)(ws + WS_DC), in.p[14], in.p[17]) }
#define PBODY_3 { IN_LOAD(); scan_phase(C, in, ws, out); }
#define PBODY_4 { IN_LOAD(); scan_post_phase(C, in, ws); }
#define PBODY_5 SPLIT_PHASE(WS_YG, WS_WORW, D)
#define PBODY_6 { IN_LOAD(); rowwise_phase(C, in, nullptr, (const float*)(ws + WS_MO), in.p[8] + 1 * D, (float*)(ws + WS_X1), in.p[8] + 2 * D, (bf16*)(ws + WS_XN), D / 256); }
#define PBODY_7 UP_PHASE(WS_WUP0, 0)
#define PBODY_8 FIX_PHASE(0)
#define PBODY_9 DOWN_PHASE(WS_WDN0, 0)
#define PBODY_10 { IN_LOAD(); rowwise_phase(C, in, (const float*)(ws + WS_X1), (const float*)(ws + WS_MO), in.p[8] + 3 * D, (float*)(ws + WS_X2), in.p[8] + 4 * D, (bf16*)(ws + WS_XN), FF / 256); }
#define PBODY_11 GEMM_PHASE(EpiBf16, WS_XN, WS_WQKV, NQKV, D, 0, (bf16*)(ws + WS_QKV), NQKV)
#define PBODY_12 { IN_LOAD(); rope_phase(C, in, ws, out); }
#define PBODY_13 { attn_phase(C, launder_kernarg(), ws, out); }
#define PBODY_14 { merge_phase(C, ws); }
#define PBODY_15 SPLIT_PHASE(WS_OM, WS_WOAT, AW)
#define PBODY_16 { IN_LOAD(); rowwise_phase(C, in, (const float*)(ws + WS_X2), (const float*)(ws + WS_MO), in.p[8] + 5 * D, (float*)(ws + WS_X3), in.p[8] + 6 * D, (bf16*)(ws + WS_XN), AW / 256); }
#define PBODY_17 UP_PHASE(WS_WUP1, 1)
#define PBODY_18 FIX_PHASE(1)
#define PBODY_19 DOWN_PHASE(WS_WDN1, 1)
#define PBODY_20 { IN_LOAD(); rowwise_phase(C, in, (const float*)(ws + WS_X3), (const float*)(ws + WS_MO), in.p[8] + 7 * D, out + O_YP, nullptr, nullptr, FF / 256); }

__global__ void __launch_bounds__(NWAVES * 64, 2) fwd(Args args) {
    extern __shared__ __attribute__((aligned(16))) unsigned char lds[];
    Ctx C; C.lds = (LAS unsigned char*)lds; C.tid = threadIdx.x; C.lane = C.tid & 63; C.wave = __builtin_amdgcn_readfirstlane(C.tid >> 6);
    C.G = gridDim.x; C.bid = blockIdx.x; C.gw = C.bid * NWAVES + C.wave; C.NGW = C.G * NWAVES;
    unsigned char* ws = args.ws; float* out = args.out;
    volatile LAS unsigned* MISC = (volatile LAS unsigned*)(C.lds + MISC_OFF);
    for (int u = C.tid; u < (LDS_BYTES - LDSCTL_OFF) / 4; u += NWAVES * 64) ((LAS unsigned*)(C.lds + LDSCTL_OFF))[u] = 0u;
    __syncthreads();
    XcdBarrier bar; bar.bar = (unsigned*)(ws + WS_CTL) + CW_BAR; bar.x = 0; bar.st = nullptr;
    const int lo = args.ph_lo, hi = args.ph_hi;
    if (hi - lo > 1) bar = xcd_barrier_post((unsigned*)(ws + WS_CTL) + CW_BAR, MISC + 8);
    LAS unsigned char* ring = C.lds + RING_OFF;
#define IN(k) ((ONLY < 0 || ONLY == (k)) && lo <= (k) && (k) < hi)
#define PHASE(k) if (IN(k)) PBODY_##k if (IN(k) && ((REP_MASK >> (k)) & 1)) { if (hi - lo > 1) xcd_barrier(bar); PBODY_##k } if (IN(k) && IN((k) + 1)) xcd_barrier(bar);
    PHASE(0) PHASE(1) PHASE(2) PHASE(3) PHASE(4) PHASE(5) PHASE(6) PHASE(7) PHASE(8) PHASE(9) PHASE(10) PHASE(11) PHASE(12) PHASE(13) PHASE(14) PHASE(15) PHASE(16) PHASE(17) PHASE(18) PHASE(19) PHASE(20)
#undef IN
#undef PHASE
}

extern "C" void kernel_launch(void* const* d_in, const int* in_sizes, int n_in, void* d_out, int out_size, void* d_ws, size_t ws_size, hipStream_t stream) {
    static int grid = 0;
    if (grid == 0) {
        if (n_in != 33 || (size_t)out_size != O_END || ws_size < WS_END) { fprintf(stderr, "kernel_launch: unexpected sizes: n_in %d out %d ws %zu (need %zu)\n", n_in, out_size, ws_size, (size_t)WS_END); grid = -1; return; }
        int dev = 0, cus = 0, per_cu = 0;
        if (hipGetDevice(&dev) != hipSuccess || hipDeviceGetAttribute(&cus, hipDeviceAttributeMultiprocessorCount, dev) != hipSuccess) { grid = -1; return; }
        if (hipFuncSetAttribute((const void*)fwd, hipFuncAttributeMaxDynamicSharedMemorySize, LDS_BYTES) != hipSuccess) { fprintf(stderr, "kernel_launch: hipFuncSetAttribute failed\n"); grid = -1; return; }
        if (hipOccupancyMaxActiveBlocksPerMultiprocessor(&per_cu, (const void*)fwd, NWAVES * 64, LDS_BYTES) != hipSuccess || per_cu < 1) { fprintf(stderr, "kernel_launch: occupancy query says %d\n", per_cu); }
        (void)hipGetLastError();
        grid = cus;
    }
    if (grid < 0) return;
    (void)hipMemsetAsync((char*)d_ws + WS_CTL, 0, CTL_ZERO_BYTES, stream);
    Args a{};
    for (int i = 0; i < 33; ++i) a.in.p[i] = (const float*)d_in[i];
    a.out = (float*)d_out; a.ws = (unsigned char*)d_ws;
#if MK_ONE_LAUNCH
    a.ph_lo = 0; a.ph_hi = N_PHASES;
    hipLaunchKernelGGL(fwd, dim3(grid), dim3(NWAVES * 64), LDS_BYTES, stream, a);
#else
    for (int ph = 0; ph < N_PHASES; ++ph) { a.ph_lo = ph; a.ph_hi = ph + 1; hipLaunchKernelGGL(fwd, dim3(grid), dim3(NWAVES * 64), LDS_BYTES, stream, a); }
#endif
}
```

```cpp
#include <hip/hip_runtime.h>
#include <cstdio>
#include <cstdint>
namespace pg8 {
#define PG8_LAS __attribute__((address_space(3)))
typedef unsigned short bf16_t;
typedef short bf16x8 __attribute__((ext_vector_type(8)));
typedef float f32x4 __attribute__((ext_vector_type(4)));
typedef float f32x2 __attribute__((ext_vector_type(2)));
typedef unsigned u32x4 __attribute__((ext_vector_type(4)));
typedef unsigned u32x2 __attribute__((ext_vector_type(2)));
constexpr int BM = 256, BK = 64, HALF = 128, HTB = HALF * BK * 2  , STAGE_BYTES = 8 * HTB, NXCD = 8, WGM = 8;

__host__ __device__ __forceinline__ int lds_byte(int r, int c) { const int st = (r >> 4) * 2 + (c >> 5), rr = r & 15, cc = c & 31, ob = rr * 64 + cc * 2; return st * 1024 + (ob ^ (((ob >> 9) & 1) << 5)); }
__host__ __device__ __forceinline__ void stage_rc(int b, int& R, int& C) { const int st = b / 1024, sb = b % 1024, swz = sb ^ (((sb >> 9) & 1) << 5); R = (st >> 1) * 16 + swz / 64; C = (st & 1) * 32 + (swz % 64) / 2; }
__host__ __device__ __forceinline__ int perm32(int rho) { const int n = rho >> 4, i = rho & 15; return 8 * (i >> 2) + 4 * n + (i & 3); }

struct Unit { int pm, pn, kt0, nkt, slab; };
struct Gemm { const bf16_t* A; const bf16_t* Bt; int M, N, K; size_t a_sel_bytes; };

struct StaticOrder {
    int nM, nN, nwg, G, c, KT;
    __host__ __device__ __forceinline__ void init(int M, int N, int G_, int c_, int K) { nM = M / BM; nN = N / BM; nwg = nM * nN; G = G_; c = c_; KT = K / BK; }
    __host__ __device__ __forceinline__ bool next(int i, Unit& u) const {
        const long L = (long)i * G + c; if (L >= nwg) return false;
        int wgid = (int)L; { const int q = nwg / NXCD, r = nwg % NXCD, xcd = wgid % NXCD, off = wgid / NXCD; wgid = (xcd < r ? xcd * (q + 1) : r * (q + 1) + (xcd - r) * q) + off; }
        const int nig = WGM * nN, gid = wgid / nig, fm = gid * WGM, gsz = (nM - fm) < WGM ? (nM - fm) : WGM;
        u.pm = fm + ((wgid % nig) % gsz); u.pn = (wgid % nig) / gsz; u.kt0 = 0; u.nkt = KT; u.slab = -1; return true;
    }
    __device__ __forceinline__ void a_ready(const Unit&) const {}
    __device__ __forceinline__ void done(const Unit&) const {}
};
struct SplitOrder {
    StaticOrder P; int nsl, G, c;
    __host__ __device__ __forceinline__ void init(int G_, int c_, int K) { P.init(64 * BM, 1024, G_, c_, K); G = G_; c = c_; nsl = K / (4 * BK); }
    __host__ __device__ __forceinline__ bool next(int i, Unit& u) const {
        const int nreg = c < P.nwg ? (P.nwg - c + G - 1) / G : 0;
        if (i < nreg) return P.next(i, u);
        const int j = (i - nreg) * G + c; if (j >= 16 * nsl) return false;
        const int su = j / nsl, sl = j % nsl; u.pm = 64 + (su >> 2); u.pn = su & 3; u.kt0 = 4 * sl; u.nkt = 4; u.slab = sl; return true;
    }
    __device__ __forceinline__ void a_ready(const Unit&) const {}
    __device__ __forceinline__ void done(const Unit&) const {}
};

__device__ __forceinline__ unsigned cvt_pk_bf16(float lo, float hi) { unsigned r; asm volatile("v_cvt_pk_bf16_f32 %0, %1, %2" : "=v"(r) : "v"(lo), "v"(hi)); return r; }
__device__ __forceinline__ float fast_tanh(float x) { return 1.0f - 2.0f / (1.0f + __expf(2.0f * x)); }
__device__ __forceinline__ float fast_sigmoid(float x) { return 1.0f / (1.0f + __expf(-x)); }

struct EpiF32 {
    static constexpr bool PERM = false, AFTER_DRAIN = false;
    static __device__ __forceinline__ int asel(int) { return 0; }
    float* C; int ldc;
    __device__ __forceinline__ void operator()(const f32x4 (&acc)[2][2][4][2], const Unit& u, int wr, int wc, int fr, int fq) const {
        const int row0 = u.pm * BM + wr * 64 + fr, col0 = u.pn * BM + wc * 32 + 4 * fq;
#pragma unroll
        for (int ai = 0; ai < 2; ++ai)
#pragma unroll
            for (int m = 0; m < 4; ++m) { float* rowp = C + (size_t)(row0 + ai * HALF + m * 16) * ldc + col0;
#pragma unroll
                for (int bj = 0; bj < 2; ++bj)
#pragma unroll
                    for (int n = 0; n < 2; ++n) *(f32x4*)(rowp + bj * HALF + n * 16) = acc[ai][bj][m][n]; }
    }
};
struct EpiF32S {
    static constexpr bool PERM = false, AFTER_DRAIN = false;
    static __device__ __forceinline__ int asel(int) { return 0; }
    float* C; float* SLAB;
    __device__ __forceinline__ void operator()(const f32x4 (&acc)[2][2][4][2], const Unit& u, int wr, int wc, int fr, int fq) const {
        const int row0 = u.pm * BM + wr * 64 + fr, col0 = u.pn * BM + wc * 32 + 4 * fq;
        float* base = u.slab < 0 ? C + (size_t)row0 * 1024 + col0 : SLAB + ((size_t)u.slab * 1024 + (row0 - 16384)) * 1024 + col0;
#pragma unroll
        for (int ai = 0; ai < 2; ++ai)
#pragma unroll
            for (int m = 0; m < 4; ++m) { float* rowp = base + (size_t)(ai * HALF + m * 16) * 1024;
#pragma unroll
                for (int bj = 0; bj < 2; ++bj)
#pragma unroll
                    for (int n = 0; n < 2; ++n) *(f32x4*)(rowp + bj * HALF + n * 16) = acc[ai][bj][m][n]; }
    }
};
struct EpiBf16 {
    static constexpr bool PERM = true, AFTER_DRAIN = false;
    static __device__ __forceinline__ int asel(int) { return 0; }
    bf16_t* O; int ldc;
    __device__ __forceinline__ void operator()(const f32x4 (&acc)[2][2][4][2], const Unit& u, int wr, int wc, int fr, int fq) const {
        const int row0 = u.pm * BM + wr * 64 + fr, col0 = u.pn * BM + wc * 32 + 8 * fq;
#pragma unroll
        for (int ai = 0; ai < 2; ++ai)
#pragma unroll
            for (int m = 0; m < 4; ++m) { bf16_t* rowp = O + (size_t)(row0 + ai * HALF + m * 16) * ldc + col0;
#pragma unroll
                for (int bj = 0; bj < 2; ++bj) { const f32x4 v0 = acc[ai][bj][m][0], v1 = acc[ai][bj][m][1];
                    u32x4 w; w.x = cvt_pk_bf16(v0[0], v0[1]); w.y = cvt_pk_bf16(v0[2], v0[3]); w.z = cvt_pk_bf16(v1[0], v1[1]); w.w = cvt_pk_bf16(v1[2], v1[3]);
                    *(u32x4*)(rowp + bj * HALF) = w; } }
    }
};
constexpr size_t RKV_STRIDE = (size_t)17408 * 1024;
struct EpiG1 {
    static constexpr bool PERM = false, AFTER_DRAIN = false;
    static __device__ __forceinline__ int asel(int pn) { return pn < 12 ? (pn >> 2) : pn - 9; }
    float* RKV; bf16_t* L2A;
    __device__ __forceinline__ void operator()(const f32x4 (&acc)[2][2][4][2], const Unit& u, int wr, int wc, int fr, int fq) const {
        const int row0 = u.pm * BM + wr * 64 + fr;
        if (u.pn < 12) {
            float* base = RKV + (size_t)(u.pn >> 2) * RKV_STRIDE; const int col0 = (u.pn & 3) * BM + wc * 32 + 4 * fq;
#pragma unroll
            for (int ai = 0; ai < 2; ++ai)
#pragma unroll
                for (int m = 0; m < 4; ++m) { float* rowp = base + (size_t)(row0 + ai * HALF + m * 16) * 1024 + col0;
#pragma unroll
                    for (int bj = 0; bj < 2; ++bj)
#pragma unroll
                        for (int n = 0; n < 2; ++n) *(f32x4*)(rowp + bj * HALF + n * 16) = acc[ai][bj][m][n]; }
        } else {
            const int mode = u.pn - 12, cbase = mode == 0 ? 0 : (mode == 1 ? 64 : 128);
#pragma unroll
            for (int ai = 0; ai < 2; ++ai)
#pragma unroll
                for (int m = 0; m < 4; ++m) { bf16_t* rowp = L2A + (size_t)(row0 + ai * HALF + m * 16) * 384 + cbase;
#pragma unroll
                    for (int bj = 0; bj < 2; ++bj)
#pragma unroll
                        for (int n = 0; n < 2; ++n) { const int lc = bj * HALF + wc * 32 + n * 16 + 4 * fq;
                            if (mode < 2 && lc >= 64) continue;
                            f32x4 v = acc[ai][bj][m][n];
                            if (mode == 0) { v[0] = fast_tanh(v[0]); v[1] = fast_tanh(v[1]); v[2] = fast_tanh(v[2]); v[3] = fast_tanh(v[3]); }
                            if (mode == 2) { v[0] = fast_sigmoid(v[0]); v[1] = fast_sigmoid(v[1]); v[2] = fast_sigmoid(v[2]); v[3] = fast_sigmoid(v[3]); }
                            u32x2 w; w.x = cvt_pk_bf16(v[0], v[1]); w.y = cvt_pk_bf16(v[2], v[3]); *(u32x2*)(rowp + lc) = w; } }
        }
    }
};
struct EpiL2 {
    static constexpr bool PERM = false, AFTER_DRAIN = false;
    static __device__ __forceinline__ int asel(int) { return 0; }
    float* DAG; const float* w0; const float* a0;
    __device__ __forceinline__ void operator()(const f32x4 (&acc)[2][2][4][2], const Unit& u, int wr, int wc, int fr, int fq) const {
        const int row0 = u.pm * BM + wr * 64 + fr, mode = u.pn >> 2, col0 = (u.pn & 3) * BM + wc * 32 + 4 * fq;
        float* base = DAG + (size_t)mode * RKV_STRIDE + (size_t)row0 * 1024 + col0;
        if (mode == 0) {
#pragma unroll
            for (int bj = 0; bj < 2; ++bj)
#pragma unroll
                for (int n = 0; n < 2; ++n) { const f32x4 bv = *(const f32x4*)(w0 + col0 + bj * HALF + n * 16);
#pragma unroll
                    for (int ai = 0; ai < 2; ++ai)
#pragma unroll
                        for (int m = 0; m < 4; ++m) { f32x4 v = acc[ai][bj][m][n] + bv;
#pragma unroll
                            for (int j = 0; j < 4; ++j) { const float z = v[j], sp = fmaxf(-z, 0.f) + __logf(1.0f + __expf(-fabsf(z))); v[j] = __expf(-__expf(-sp - 0.5f)); }
                            *(f32x4*)(base + (size_t)(ai * HALF + m * 16) * 1024 + bj * HALF + n * 16) = v; } }
        } else if (mode == 1) {
#pragma unroll
            for (int bj = 0; bj < 2; ++bj)
#pragma unroll
                for (int n = 0; n < 2; ++n) { const f32x4 bv = *(const f32x4*)(a0 + col0 + bj * HALF + n * 16);
#pragma unroll
                    for (int ai = 0; ai < 2; ++ai)
#pragma unroll
                        for (int m = 0; m < 4; ++m) { f32x4 v = acc[ai][bj][m][n] + bv;
#pragma unroll
                            for (int j = 0; j < 4; ++j) v[j] = fast_sigmoid(v[j]);
                            *(f32x4*)(base + (size_t)(ai * HALF + m * 16) * 1024 + bj * HALF + n * 16) = v; } }
        } else {
#pragma unroll
            for (int ai = 0; ai < 2; ++ai)
#pragma unroll
                for (int m = 0; m < 4; ++m)
#pragma unroll
                    for (int bj = 0; bj < 2; ++bj)
#pragma unroll
                        for (int n = 0; n < 2; ++n) *(f32x4*)(base + (size_t)(ai * HALF + m * 16) * 1024 + bj * HALF + n * 16) = acc[ai][bj][m][n];
        }
    }
};
constexpr int EX_FLOATS_PER_BLK = 2 * 2 * 128;
__device__ __forceinline__ float gelu_tanh_f(float x) { const float u = 0.7978845608028654f * (x + 0.044715f * x * x * x); return 0.5f * x * (1.0f + fast_tanh(u)); }
#define PG8_ROR(x, n) __builtin_bit_cast(float, __builtin_amdgcn_mov_dpp(__builtin_bit_cast(int, (x)), 0x120 + (n), 0xF, 0xF, false))
struct EpiConv {
    static constexpr bool PERM = true, AFTER_DRAIN = false;
    static __device__ __forceinline__ int asel(int) { return 0; }
    bf16_t* ACT; float* HALO; float* RAWS; float* pconv; float* sconv; const float* cw; const float* cb; PG8_LAS float* X;
    __device__ __forceinline__ void operator()(f32x4 (&acc)[2][2][4][2], const Unit& u, int wr, int wc, int fr, int fq) const {
        constexpr int FFc = 2816, F2c = 5632, MPc = 16384;
        const int lcb = wc * 32 + 8 * fq, cg = u.pn * 128 + lcb;
        if (fr >= 14) {
#pragma unroll
            for (int ai = 0; ai < 2; ++ai)
#pragma unroll
                for (int bj = 0; bj < 2; ++bj)
#pragma unroll
                    for (int n = 0; n < 2; ++n) *(PG8_LAS f32x4*)(X + (ai * 2 + wr) * EX_FLOATS_PER_BLK + ((fr - 14) * 2 + bj) * 128 + lcb + 4 * n) = acc[ai][bj][3][n];
        }
        asm volatile("s_waitcnt lgkmcnt(0)" ::: "memory"); __builtin_amdgcn_s_barrier(); asm volatile("" ::: "memory");
        const int row0 = u.pm * BM + wr * 64 + fr;
        if (u.pm >= 64) {
            const int t = fr & 7;
            if (t < 2 || t >= 6) {
#pragma unroll
                for (int ai = 0; ai < 2; ++ai)
#pragma unroll
                    for (int m = 0; m < 4; ++m) { const int rs = row0 + ai * HALF + m * 16 - MPc; float* dst = t < 2 ? RAWS + (size_t)rs * F2c : sconv + ((size_t)(rs >> 3) * 2 + (t - 6)) * F2c;
#pragma unroll
                        for (int bj = 0; bj < 2; ++bj)
#pragma unroll
                            for (int n = 0; n < 2; ++n) *(f32x4*)(dst + bj * FFc + cg + 4 * n) = acc[ai][bj][m][n]; }
            }
        } else {
            if (wr == 0 && fr < 2) {
#pragma unroll
                for (int bj = 0; bj < 2; ++bj)
#pragma unroll
                    for (int n = 0; n < 2; ++n) *(f32x4*)(HALO + ((size_t)u.pm * 4 + fr) * F2c + bj * FFc + cg + 4 * n) = acc[0][bj][0][n]; }
            if (wr == 1 && fr >= 14) {
#pragma unroll
                for (int bj = 0; bj < 2; ++bj)
#pragma unroll
                    for (int n = 0; n < 2; ++n) { *(f32x4*)(HALO + ((size_t)u.pm * 4 + fr - 12) * F2c + bj * FFc + cg + 4 * n) = acc[1][bj][3][n];
                        if ((u.pm & 7) == 7) *(f32x4*)(pconv + ((size_t)(u.pm >> 3) * 2 + (fr - 14)) * F2c + bj * FFc + cg + 4 * n) = acc[1][bj][3][n]; } }
        }
        asm volatile("" ::: "memory"); __builtin_amdgcn_sched_barrier(0);
#pragma unroll
        for (int n = 0; n < 2; ++n)
#pragma unroll
            for (int s = 0; s < 2; ++s) {
                const int c = s * FFc + cg + 4 * n;
                const f32x4 bb = *(const f32x4*)(cb + c), w0 = *(const f32x4*)(cw + c), w1 = *(const f32x4*)(cw + F2c + c), w2 = *(const f32x4*)(cw + 2 * F2c + c);
#pragma unroll
                for (int ai = 0; ai < 2; ++ai) {
                    const int pblk = wr == 1 ? ai * 2 : 1; const bool has_prev = (wr == 1 || ai == 1);
                    f32x4 e1 = *(const PG8_LAS f32x4*)(X + pblk * EX_FLOATS_PER_BLK + (1 * 2 + s) * 128 + lcb + 4 * n), e2 = *(const PG8_LAS f32x4*)(X + pblk * EX_FLOATS_PER_BLK + (0 * 2 + s) * 128 + lcb + 4 * n);
                    if (!has_prev) { e1 = (f32x4){0.f, 0.f, 0.f, 0.f}; e2 = e1; }
                    f32x4 p1, p2;
#pragma unroll
                    for (int m = 0; m < 4; ++m) {
                        const f32x4 a = acc[ai][s][m][n]; f32x4 r1, r2, h1, h2;
                        asm volatile("s_nop 1\n\tv_mov_b32_dpp %0, %8 row_ror:1 row_mask:0xf bank_mask:0xf\n\tv_mov_b32_dpp %1, %9 row_ror:1 row_mask:0xf bank_mask:0xf\n\tv_mov_b32_dpp %2, %10 row_ror:1 row_mask:0xf bank_mask:0xf\n\tv_mov_b32_dpp %3, %11 row_ror:1 row_mask:0xf bank_mask:0xf\n\t"
                                     "v_mov_b32_dpp %4, %8 row_ror:2 row_mask:0xf bank_mask:0xf\n\tv_mov_b32_dpp %5, %9 row_ror:2 row_mask:0xf bank_mask:0xf\n\tv_mov_b32_dpp %6, %10 row_ror:2 row_mask:0xf bank_mask:0xf\n\tv_mov_b32_dpp %7, %11 row_ror:2 row_mask:0xf bank_mask:0xf"
                                     : "=&v"(r1[0]), "=&v"(r1[1]), "=&v"(r1[2]), "=&v"(r1[3]), "=&v"(r2[0]), "=&v"(r2[1]), "=&v"(r2[2]), "=&v"(r2[3]) : "v"(a[0]), "v"(a[1]), "v"(a[2]), "v"(a[3]));
                        if (m == 0) { h1 = fr >= 1 ? r1 : e1; h2 = fr >= 2 ? r2 : (fr == 0 ? e2 : e1); }
                        else { h1 = fr >= 1 ? r1 : p1; h2 = fr >= 2 ? r2 : p2; }
                        p1 = r1; p2 = r2;
                        acc[ai][s][m][n] = bb + w0 * h2 + w1 * h1 + w2 * a;
                        __builtin_amdgcn_sched_barrier(0);
                    }
                }
                asm volatile("" ::: "memory"); __builtin_amdgcn_sched_barrier(0);
            }
#pragma unroll
        for (int ai = 0; ai < 2; ++ai)
#pragma unroll
            for (int m = 0; m < 4; ++m) { const int row = row0 + ai * HALF + m * 16; u32x4 o;
                { const f32x4 g = acc[ai][0][m][0], v = acc[ai][1][m][0]; o.x = cvt_pk_bf16(gelu_tanh_f(g[0]) * v[0], gelu_tanh_f(g[1]) * v[1]); o.y = cvt_pk_bf16(gelu_tanh_f(g[2]) * v[2], gelu_tanh_f(g[3]) * v[3]); }
                { const f32x4 g = acc[ai][0][m][1], v = acc[ai][1][m][1]; o.z = cvt_pk_bf16(gelu_tanh_f(g[0]) * v[0], gelu_tanh_f(g[1]) * v[1]); o.w = cvt_pk_bf16(gelu_tanh_f(g[2]) * v[2], gelu_tanh_f(g[3]) * v[3]); }
                *(u32x4*)(ACT + (size_t)row * FFc + cg) = o; }
    }
};
template <class Epi, class Sched, bool ALIGN_EPI = false, bool SP2 = false>
__device__ __forceinline__ void gemm_phase(PG8_LAS unsigned char* lds, const Gemm g, const Sched& S, const Epi& E) {
    const int tid = threadIdx.x, wid = __builtin_amdgcn_readfirstlane(tid >> 6), lane = tid & 63, wr = wid >> 2, wc = wid & 3, fr = lane & 15, fq = lane >> 4;
    int K = g.K; asm volatile("" : "+s"(K));
    unsigned voffA[2], voffB[2];
#pragma unroll
    for (int i = 0; i < 2; ++i) { int R, C; stage_rc(tid * 16 + i * 8192, R, C); const int Rb = Epi::PERM ? ((R & ~31) + perm32(R & 31)) : R;
        voffA[i] = (unsigned)(R * K + C) * 2u; voffB[i] = (unsigned)(Rb * K + C) * 2u; }
    const size_t kstep = (size_t)(BK * 2);
    const size_t hstep = (size_t)HALF * K * 2;
    const size_t tstep = 2 * hstep;
    const unsigned ldsw = (unsigned)wid * 1024u;
    const int aoff = lds_byte(wr * 64 + fr, fq * 8), boff = lds_byte(wc * 32 + fr, fq * 8);
#define PG8_SA(b, h) (((b) * 2 + (h)) * HTB)
#define PG8_SB(b, h) ((4 + (b) * 2 + (h)) * HTB)
#define PG8_STAGE(bufoff, gbase, voff) do { _Pragma("unroll") for (int _i = 0; _i < 2; ++_i) \
        __builtin_amdgcn_global_load_lds((const unsigned*)((const char*)(gbase) + (voff)[_i]), (PG8_LAS unsigned*)(lds + (bufoff) + ldsw + _i * 8192), 16, 0, 0); } while (0)
#define PG8_LDA(dst, b, h) do { _Pragma("unroll") for (int m = 0; m < 4; ++m) _Pragma("unroll") for (int k = 0; k < 2; ++k) dst[m][k] = *(const PG8_LAS bf16x8*)(lds + PG8_SA(b, h) + aoff + m * 2048 + k * 1024); } while (0)
#define PG8_LDB(dst, b, h) do { _Pragma("unroll") for (int n = 0; n < 2; ++n) _Pragma("unroll") for (int k = 0; k < 2; ++k) dst[n][k] = *(const PG8_LAS bf16x8*)(lds + PG8_SB(b, h) + boff + n * 2048 + k * 1024); } while (0)
#define PG8_MMA(ai, bj, At, Bt) do { __builtin_amdgcn_s_setprio(1); _Pragma("unroll") for (int m = 0; m < 4; ++m) _Pragma("unroll") for (int n = 0; n < 2; ++n) _Pragma("unroll") for (int k = 0; k < 2; ++k) \
        acc[ai][bj][m][n] = __builtin_amdgcn_mfma_f32_16x16x32_bf16(Bt[n][k], At[m][k], acc[ai][bj][m][n], 0, 0, 0); __builtin_amdgcn_s_setprio(0); } while (0)
#define PG8_WAIT_V(n) asm volatile("s_waitcnt vmcnt(" #n ")" ::: "memory")
#define PG8_WAIT_L(n) asm volatile("s_waitcnt lgkmcnt(" #n ")" ::: "memory")
#define PG8_BAR __builtin_amdgcn_s_barrier()
#define PG8_SCHED __builtin_amdgcn_sched_barrier(0)
    Unit cur, nxt; int ui = 0;
    if (!S.next(0, cur)) return;
    f32x4 acc[2][2][4][2];
#pragma unroll
    for (int a = 0; a < 2; ++a)
#pragma unroll
        for (int b = 0; b < 2; ++b)
#pragma unroll
            for (int m = 0; m < 4; ++m)
#pragma unroll
                for (int n = 0; n < 2; ++n) acc[a][b][m][n] = (f32x4){0.f, 0.f, 0.f, 0.f};
    bf16x8 At[4][2], B0[2][2], B1[2][2];
    const char* cA = (const char*)g.A + (size_t)Epi::asel(cur.pn) * g.a_sel_bytes + (size_t)cur.pm * tstep + (size_t)cur.kt0 * kstep; const char* cB = (const char*)g.Bt + (size_t)cur.pn * tstep + (size_t)cur.kt0 * kstep;
    S.a_ready(cur);
    if constexpr (SP2) {
        PG8_STAGE(PG8_SB(0, 0), cB, voffB); PG8_STAGE(PG8_SB(0, 1), cB + hstep, voffB); PG8_STAGE(PG8_SA(0, 0), cA, voffA); PG8_STAGE(PG8_SA(0, 1), cA + hstep, voffA);
        if (wr == 1) PG8_BAR;
        PG8_WAIT_V(2); PG8_BAR;
        PG8_STAGE(PG8_SB(1, 0), cB + kstep, voffB); PG8_STAGE(PG8_SA(1, 0), cA + kstep, voffA); PG8_STAGE(PG8_SB(1, 1), cB + hstep + kstep, voffB);
        PG8_WAIT_V(6); PG8_BAR;
    } else {
        PG8_STAGE(PG8_SB(0, 0), cB, voffB); PG8_STAGE(PG8_SA(0, 0), cA, voffA); PG8_STAGE(PG8_SB(0, 1), cB + hstep, voffB); PG8_STAGE(PG8_SA(0, 1), cA + hstep, voffA);
        if (wr == 1) PG8_BAR;
        PG8_WAIT_V(4); PG8_BAR;
        PG8_STAGE(PG8_SB(1, 0), cB + kstep, voffB); PG8_STAGE(PG8_SA(1, 0), cA + kstep, voffA); PG8_STAGE(PG8_SB(1, 1), cB + hstep + kstep, voffB);
        PG8_WAIT_V(6); PG8_BAR;
    }
    for (;;) {
        const bool has_next = S.next(ui + 1, nxt);
        const char* nA = has_next ? (const char*)g.A + (size_t)Epi::asel(nxt.pn) * g.a_sel_bytes + (size_t)nxt.pm * tstep + (size_t)nxt.kt0 * kstep : cA; const char* nB = has_next ? (const char*)g.Bt + (size_t)nxt.pn * tstep + (size_t)nxt.kt0 * kstep : cB;
        int nt = cur.nkt; asm volatile("" : "+s"(nt));
        for (int t = 0; t < nt; t += 2) {
            const bool last = (t == nt - 2);
            const char* a1 = cA + (size_t)(t + 1) * kstep;
            const char* a2 = last ? nA : cA + (size_t)(t + 2) * kstep; const char* b2 = last ? nB : cB + (size_t)(t + 2) * kstep;
            const char* a3 = a2 + kstep; const char* b3 = b2 + kstep;
            if (last && has_next) S.a_ready(nxt);
            if constexpr (SP2) {
            PG8_LDB(B0, 0, 0); PG8_LDB(B1, 0, 1); PG8_SCHED; PG8_LDA(At, 0, 0); PG8_STAGE(PG8_SA(1, 1), a1 + hstep, voffA);
            PG8_WAIT_V(8); PG8_WAIT_L(0); PG8_BAR; PG8_MMA(0, 0, At, B0); PG8_MMA(0, 1, At, B1); PG8_BAR; PG8_SCHED;
            PG8_LDA(At, 0, 1); PG8_STAGE(PG8_SB(0, 0), b2, voffB); PG8_STAGE(PG8_SB(0, 1), b2 + hstep, voffB); PG8_STAGE(PG8_SA(0, 0), a2, voffA);
            PG8_WAIT_V(8); PG8_WAIT_L(0); PG8_BAR; PG8_MMA(1, 0, At, B0); PG8_MMA(1, 1, At, B1); PG8_BAR; PG8_SCHED;
            PG8_LDB(B0, 1, 0); PG8_LDB(B1, 1, 1); PG8_SCHED; PG8_LDA(At, 1, 0); PG8_STAGE(PG8_SA(0, 1), a2 + hstep, voffA);
            PG8_WAIT_V(8); PG8_WAIT_L(0); PG8_BAR; PG8_MMA(0, 0, At, B0); PG8_MMA(0, 1, At, B1); PG8_BAR; PG8_SCHED;
            PG8_LDA(At, 1, 1); PG8_STAGE(PG8_SB(1, 0), b3, voffB); PG8_STAGE(PG8_SB(1, 1), b3 + hstep, voffB); PG8_STAGE(PG8_SA(1, 0), a3, voffA);
            PG8_WAIT_V(8); PG8_WAIT_L(0); PG8_BAR; PG8_MMA(1, 0, At, B0); PG8_MMA(1, 1, At, B1); PG8_BAR; PG8_SCHED;
            } else {
            PG8_LDB(B0, 0, 0); PG8_SCHED; PG8_LDA(At, 0, 0); PG8_STAGE(PG8_SA(1, 1), a1 + hstep, voffA);
            PG8_WAIT_L(8); PG8_BAR; PG8_WAIT_L(0); PG8_MMA(0, 0, At, B0); PG8_BAR; PG8_SCHED;
            PG8_LDB(B1, 0, 1); PG8_STAGE(PG8_SB(0, 0), b2, voffB);
            PG8_BAR; PG8_WAIT_L(0); PG8_MMA(0, 1, At, B1); PG8_BAR;
            PG8_LDA(At, 0, 1); PG8_STAGE(PG8_SA(0, 0), a2, voffA);
            PG8_BAR; PG8_WAIT_L(0); PG8_MMA(1, 0, At, B0); PG8_BAR; PG8_SCHED;
            PG8_STAGE(PG8_SB(0, 1), b2 + hstep, voffB);
            PG8_WAIT_V(6); PG8_BAR; PG8_MMA(1, 1, At, B1); PG8_BAR;
            PG8_LDB(B0, 1, 0); PG8_SCHED; PG8_LDA(At, 1, 0); PG8_STAGE(PG8_SA(0, 1), a2 + hstep, voffA);
            PG8_WAIT_L(8); PG8_BAR; PG8_WAIT_L(0); PG8_MMA(0, 0, At, B0); PG8_BAR; PG8_SCHED;
            PG8_LDB(B1, 1, 1); PG8_STAGE(PG8_SB(1, 0), b3, voffB);
            PG8_BAR; PG8_WAIT_L(0); PG8_MMA(0, 1, At, B1); PG8_BAR;
            PG8_LDA(At, 1, 1); PG8_STAGE(PG8_SA(1, 0), a3, voffA);
            PG8_BAR; PG8_WAIT_L(0); PG8_MMA(1, 0, At, B0); PG8_BAR; PG8_SCHED;
            PG8_STAGE(PG8_SB(1, 1), b3 + hstep, voffB);
            PG8_WAIT_V(6); PG8_BAR; PG8_MMA(1, 1, At, B1); PG8_BAR;
            }
        }
        if constexpr (ALIGN_EPI) { if (wr == 0) PG8_BAR; }
        if constexpr (!Epi::AFTER_DRAIN) { E(acc, cur, wr, wc, fr, fq); S.done(cur); }
        if (!has_next) break;
#pragma unroll
        for (int a = 0; a < 2; ++a)
#pragma unroll
            for (int b = 0; b < 2; ++b)
#pragma unroll
                for (int m = 0; m < 4; ++m)
#pragma unroll
                    for (int n = 0; n < 2; ++n) acc[a][b][m][n] = (f32x4){0.f, 0.f, 0.f, 0.f};
        cur = nxt; cA = nA; cB = nB; ++ui;
        if constexpr (ALIGN_EPI) { if (wr == 1) PG8_BAR; }
    }
    PG8_WAIT_V(0);
    if constexpr (!ALIGN_EPI) { if (wr == 0) PG8_BAR; }
    PG8_BAR;
    if constexpr (Epi::AFTER_DRAIN) { E.fused(acc, cur, wr, wc, fr, fq, lds, wid, lane); S.done(cur); }
#undef PG8_SA
#undef PG8_SB
#undef PG8_STAGE
#undef PG8_LDA
#undef PG8_LDB
#undef PG8_MMA
#undef PG8_WAIT_V
#undef PG8_WAIT_L
#undef PG8_BAR
#undef PG8_SCHED
}
}
using pg8::fast_tanh; using pg8::fast_sigmoid;

constexpr int D = 1024, PB = 8, PT = 2048, SBN = 128, STN = 8;
constexpr int MP = PB * PT, MS = SBN * STN, M = MP + MS;
constexpr int RH = 16, FF = 2816, F2 = 5632, AH = 8, AW = 512, NQKV = 4608;
constexpr float NORM_EPS = 1e-6f, GN_EPS = 64e-5f;
constexpr size_t O_YP = 0, O_YS = O_YP + (size_t)MP * D, O_PSHIFT = O_YS + (size_t)MS * D, O_PWKV = O_PSHIFT + (size_t)PB * D,
    O_PKV128 = O_PWKV + (size_t)PB * RH * 64 * 64, O_PKV512 = O_PKV128 + (size_t)PB * 128 * 1024, O_PKV2048 = O_PKV512 + (size_t)PB * 512 * 1024,
    O_PCONV = O_PKV2048 + (size_t)PB * 2048 * 1024, O_SSHIFT = O_PCONV + (size_t)2 * PB * 2 * F2, O_SWKV = O_SSHIFT + (size_t)SBN * D,
    O_SKV128 = O_SWKV + (size_t)SBN * RH * 64 * 64, O_SKV512 = O_SKV128 + (size_t)SBN * 8 * 1024, O_SKV2048 = O_SKV512 + (size_t)SBN * 8 * 1024,
    O_SCONV = O_SKV2048 + (size_t)SBN * 8 * 1024, O_END = O_SCONV + (size_t)2 * SBN * 2 * F2;
static_assert(O_END == 55107584, "output size");
constexpr size_t MiB = 1u << 20;
constexpr size_t WS_CTL = 0, CTL_ZERO_BYTES = 1 * MiB;
constexpr size_t WS_ROPE = 1 * MiB;
constexpr size_t WS_W1CAT = 2 * MiB, WS_WL2 = 10 * MiB, WS_WORW = 13 * MiB, WS_WUP0 = 15 * MiB, WS_WDN0 = 26 * MiB, WS_WQKV = 32 * MiB, WS_WOAT = 41 * MiB, WS_WUP1 = 42 * MiB, WS_WDN1 = 53 * MiB;
constexpr size_t RB16 = (size_t)M * D * 2, RF32 = (size_t)M * D * 4;
constexpr size_t WS_XM = 64 * MiB;
constexpr size_t WS_R = WS_XM + 6 * RB16, WS_K = WS_R + RF32, WS_V = WS_K + RF32, WS_DC = WS_V + RF32, WS_AA = WS_DC + RF32, WS_GG = WS_AA + RF32;
constexpr size_t WS_L2A = WS_GG + RF32;
constexpr size_t WS_Y = WS_L2A + 13 * MiB, WS_BONUS = WS_Y + RF32, WS_YG = WS_BONUS + 2 * MiB, WS_MO = WS_YG + RB16;
constexpr size_t WS_X1 = WS_MO + RF32, WS_X2 = WS_X1 + RF32, WS_X3 = WS_X2 + RF32, WS_XN = WS_X3 + RF32;
constexpr size_t WS_HID = WS_XN + RB16;
constexpr size_t WS_SLAB = WS_HID + 32 * MiB;
constexpr size_t WS_ACT = WS_HID + (size_t)M * F2 * 2;
constexpr size_t WS_QKV = WS_ACT + (size_t)M * FF * 2;
constexpr size_t WS_OG = WS_QKV + (size_t)M * NQKV * 2;
constexpr size_t WS_LSE = WS_OG + (size_t)3 * M * AW * 2;
constexpr size_t WS_OM = WS_LSE + 2 * MiB;
constexpr size_t WS_END = WS_OM + (size_t)M * AW * 2 + MiB;
static_assert(WS_W1CAT + (size_t)3840 * 1024 * 2 <= WS_WL2 && WS_WL2 + (size_t)3072 * 384 * 2 <= WS_WORW && WS_WUP0 + (size_t)F2 * D * 2 <= WS_WDN0 && WS_WDN0 + (size_t)D * FF * 2 <= WS_WQKV &&
              WS_WQKV + (size_t)NQKV * D * 2 <= WS_WOAT && WS_WUP1 + (size_t)F2 * D * 2 <= WS_WDN1 && WS_WDN1 + (size_t)D * FF * 2 <= WS_XM && (size_t)M * 384 * 2 <= 13 * MiB && (size_t)3 * M * 8 * 4 <= 2 * MiB, "ws map");
constexpr int CW_TMO = 0, CW_BAR = 4096;

constexpr int NWAVES = 8;
constexpr int RING_OFF = 0, RING_BYTES = 131072;
constexpr int LDSCTL_OFF = RING_BYTES, MISC_OFF = LDSCTL_OFF + 320;
constexpr int EX_OFF = MISC_OFF + 128;
constexpr int LDS_BYTES = 147456;

#define GAS __attribute__((address_space(1)))
#define LAS __attribute__((address_space(3)))
typedef unsigned short bf16;
typedef unsigned v4u __attribute__((ext_vector_type(4)));
typedef unsigned v2u __attribute__((ext_vector_type(2)));
typedef float f32x4 __attribute__((ext_vector_type(4)));
typedef float f32x2 __attribute__((ext_vector_type(2)));
typedef short bf16x8 __attribute__((ext_vector_type(8)));
typedef GAS unsigned gu32;
#define RLX_AGENT __ATOMIC_RELAXED, __HIP_MEMORY_SCOPE_AGENT
#define LDS_WAIT() asm volatile("s_waitcnt lgkmcnt(0)" ::: "memory")
#define VM_WAIT() asm volatile("s_waitcnt vmcnt(0)" ::: "memory")
__device__ __forceinline__ unsigned f2bf(float f) { unsigned u = __builtin_bit_cast(unsigned, f); return (u + 0x7fffu + ((u >> 16) & 1u)) >> 16; }
__device__ __forceinline__ unsigned pk2(float lo, float hi) { return f2bf(lo) | (f2bf(hi) << 16); }
__device__ __forceinline__ float bflo(unsigned w) { return __builtin_bit_cast(float, w << 16); }
__device__ __forceinline__ float bfhi(unsigned w) { return __builtin_bit_cast(float, w & 0xffff0000u); }
__device__ __forceinline__ float wave_sum(float v) {
#pragma unroll
    for (int o = 1; o < 64; o <<= 1) v += __shfl_xor(v, o);
    return v;
}
#define DPP_F(x, ctrl) __builtin_bit_cast(float, __builtin_amdgcn_mov_dpp(__builtin_bit_cast(int, (x)), (ctrl), 0xF, 0xF, true))
__device__ __forceinline__ float row16_sum(float x) {
    x += DPP_F(x, 0xB1);
    x += DPP_F(x, 0x4E);
    x += DPP_F(x, 0x141);
    x += DPP_F(x, 0x140);
    return x;
}
#define XB_TMO      128
#define XB_XCNT(j)  (256  + 64 * (j))
#define XB_XSUB(j)  (1280 + 64 * (j))
#define XB_XGEN(j)  (2304 + 64 * (j))
#define XB_TOP      3328
#define XB_TOPGEN   3392
#define XCD_BAR_WORDS 3456
#define XB_SPIN_CAP (1u << 18)

__device__ __forceinline__ unsigned xb_ld(unsigned* p)              { return __hip_atomic_load(p, __ATOMIC_RELAXED, __HIP_MEMORY_SCOPE_AGENT); }
__device__ __forceinline__ unsigned xb_add(unsigned* p, unsigned v) { return __hip_atomic_fetch_add(p, v, __ATOMIC_RELAXED, __HIP_MEMORY_SCOPE_AGENT); }
__device__ __forceinline__ unsigned xb_xcc_id() { return (unsigned)__builtin_amdgcn_s_getreg((3 << 11) | 20) & 0xFu; }
#define XB_SPIN(cond, bar) do { unsigned _sp = 0; while (cond) { __builtin_amdgcn_s_sleep(1); \
    if ((++_sp & 255u) == 0u) { if (xb_ld(&(bar)[XB_TMO])) break; if (_sp > XB_SPIN_CAP) { atomicAdd(&(bar)[XB_TMO], 1u); break; } } } } while (0)

struct XcdBarrier {
    unsigned* bar; unsigned x;
    volatile LAS unsigned* st;
};

__device__ __forceinline__ XcdBarrier xcd_barrier_post(unsigned* bar, volatile LAS unsigned* st) {
    XcdBarrier b; b.bar = bar; b.x = xb_xcc_id(); b.st = st;
    if (threadIdx.x == 0) (void)xb_add(&bar[XB_XCNT(b.x)], 1u);
    return b;
}
__device__ __forceinline__ void xcd_barrier_complete(unsigned* bar, unsigned x, unsigned& nloc, unsigned& nx) {
    const unsigned G = gridDim.x * gridDim.y * gridDim.z;
    unsigned sum, cnt, mine, sp = 0u;
    for (;;) {
        sum = 0u; cnt = 0u; mine = 0u;
#pragma unroll
        for (unsigned j = 0; j < 16; ++j) { const unsigned c = xb_ld(&bar[XB_XCNT(j)]); sum += c; cnt += (c > 0u) ? 1u : 0u; mine = (j == x) ? c : mine; }
        if (sum == G) break;
        __builtin_amdgcn_s_sleep(1);
        if ((++sp & 255u) == 0u) { if (xb_ld(&bar[XB_TMO])) break; if (sp > XB_SPIN_CAP) { atomicAdd(&bar[XB_TMO], 1u); break; } }
    }
    nloc = mine > 0u ? mine : 1u; nx = cnt > 0u ? cnt : 1u;
}

__device__ __forceinline__ void xcd_barrier(const XcdBarrier& b) {
    asm volatile("s_waitcnt vmcnt(0)" ::: "memory");
    __syncthreads();
    if (threadIdx.x == 0) {
        unsigned* bar = b.bar;
        __builtin_amdgcn_s_waitcnt(0);
        unsigned nloc = b.st[0], nx = b.st[1];
        if (nloc == 0u) { xcd_barrier_complete(bar, b.x, nloc, nx); b.st[0] = nloc; b.st[1] = nx; }
        const unsigned old = xb_add(&bar[XB_XSUB(b.x)], 1u);
        const unsigned gen = old / nloc;
        if (old + 1u == (gen + 1u) * nloc) {
            __builtin_amdgcn_fence(__ATOMIC_RELEASE, "agent");
            asm volatile("s_waitcnt vmcnt(0)" ::: "memory");
            const unsigned og = xb_add(&bar[XB_TOP], 1u);
            const unsigned tg = og / nx;
            if (og + 1u == (tg + 1u) * nx) xb_add(&bar[XB_TOPGEN], 1u);
            else XB_SPIN(xb_ld(&bar[XB_TOPGEN]) == tg, bar);
            __builtin_amdgcn_fence(__ATOMIC_ACQUIRE, "agent");
            xb_add(&bar[XB_XGEN(b.x)], 1u);
            asm volatile("s_waitcnt vmcnt(0)" ::: "memory");
        } else {
            XB_SPIN(xb_ld(&bar[XB_XGEN(b.x)]) == gen, bar);
            __builtin_amdgcn_fence(__ATOMIC_ACQUIRE, "agent");
            asm volatile("s_waitcnt vmcnt(0)" ::: "memory");
        }
    }
    __syncthreads();
}

struct Ctx { LAS unsigned char* lds; int tid, lane, wave, gw, NGW, G, bid; };

__device__ __forceinline__ void transpose_item(const float* W, int ldw, int Kvalid, bf16* WT, int ldt, int drow0, int dcol0, int k0, int n0, LAS float* scr, int lane) {
    f32x4 v[8];
#pragma unroll
    for (int i = 0; i < 8; ++i) { const int kk = 8 * i + (lane >> 3), k = k0 + kk; v[i] = (k < Kvalid) ? *(const GAS f32x4*)(W + (size_t)k * ldw + n0 + 4 * (lane & 7)) : (f32x4){0.f, 0.f, 0.f, 0.f}; }
#pragma unroll
    for (int i = 0; i < 8; ++i) { const int kk = 8 * i + (lane >> 3); LAS float* d = scr + kk * 33 + 4 * (lane & 7); d[0] = v[i].x; d[1] = v[i].y; d[2] = v[i].z; d[3] = v[i].w; }
    LDS_WAIT(); asm volatile("" ::: "memory");
    const int c = lane & 7;
#pragma unroll
    for (int j = 0; j < 4; ++j) { const int n = (lane >> 3) + 8 * j; const LAS float* s = scr + (8 * c) * 33 + n;
        v4u o; o.x = pk2(s[0 * 33], s[1 * 33]); o.y = pk2(s[2 * 33], s[3 * 33]); o.z = pk2(s[4 * 33], s[5 * 33]); o.w = pk2(s[6 * 33], s[7 * 33]);
        *(GAS v4u*)(WT + (size_t)(drow0 + n) * ldt + dcol0 + 8 * c) = o; }
    LDS_WAIT(); asm volatile("" ::: "memory");
}
template <bool GLU = false> __device__ __forceinline__ void transpose_mat(const Ctx& C, const float* W, int K, int N, bf16* WT, int ldt, int row_off, int& base, LAS float* scr) {
    const int nblk = N / 32, nit = ((K + 63) / 64) * nblk;
    int start = (C.gw - base) % C.NGW; if (start < 0) start += C.NGW;
    for (int it = start; it < nit; it += C.NGW) { const int kb = it / nblk, nb = it % nblk, n0 = 32 * nb;
        const int drow = GLU ? (n0 < FF ? (n0 / 128) * 256 + (n0 % 128) : ((n0 - FF) / 128) * 256 + 128 + ((n0 - FF) % 128)) : n0;
        transpose_item(W, N, K, WT, ldt, row_off + drow, 64 * kb, 64 * kb, n0, scr, C.lane); }
    base += nit;
}
__device__ __forceinline__ void zero_rows(const Ctx& C, bf16* WT, int ldt, int r0, int r1) {
    const size_t n16 = (size_t)(r1 - r0) * ldt / 8; GAS v4u* p = (GAS v4u*)(WT + (size_t)r0 * ldt);
    for (size_t i = (size_t)C.bid * 512 + C.tid; i < n16; i += (size_t)C.G * 512) p[i] = (v4u){0u, 0u, 0u, 0u};
}

struct In { const float* p[33]; };

__device__ __forceinline__ void p0_prologue(const Ctx& C, const In& in, unsigned char* ws, float* out) {
    LAS float* scr = (LAS float*)(C.lds + RING_OFF + C.wave * 16384);
    bf16* W1CAT = (bf16*)(ws + WS_W1CAT); bf16* WL2 = (bf16*)(ws + WS_WL2);
    int base = 0;
    transpose_mat(C, in.p[10], D, D, W1CAT, D, 0, base, scr);
    transpose_mat(C, in.p[11], D, D, W1CAT, D, 1024, base, scr);
    transpose_mat(C, in.p[12], D, D, W1CAT, D, 2048, base, scr);
    transpose_mat(C, in.p[15], D, 64, W1CAT, D, 3072, base, scr);
    transpose_mat(C, in.p[18], D, 64, W1CAT, D, 3328, base, scr);
    transpose_mat(C, in.p[20], D, 160, W1CAT, D, 3584, base, scr);
    transpose_mat(C, in.p[13], D, D, (bf16*)(ws + WS_WORW), D, 0, base, scr);
    transpose_mat<true>(C, in.p[29], D, F2, (bf16*)(ws + WS_WUP0), D, 0, base, scr);
    transpose_mat<true>(C, in.p[29] + (size_t)D * F2, D, F2, (bf16*)(ws + WS_WUP1), D, 0, base, scr);
    transpose_mat(C, in.p[32], FF, D, (bf16*)(ws + WS_WDN0), FF, 0, base, scr);
    transpose_mat(C, in.p[32] + (size_t)FF * D, FF, D, (bf16*)(ws + WS_WDN1), FF, 0, base, scr);
    transpose_mat(C, in.p[27], D, NQKV, (bf16*)(ws + WS_WQKV), D, 0, base, scr);
    transpose_mat(C, in.p[28], AW, D, (bf16*)(ws + WS_WOAT), AW, 0, base, scr);
    zero_rows(C, W1CAT, D, 3072 + 64, 3328); zero_rows(C, W1CAT, D, 3328 + 64, 3584); zero_rows(C, W1CAT, D, 3584 + 160, 3840);
    { const float* w2 = in.p[16]; const float* a2 = in.p[19]; const float* g2 = in.p[21];
      for (int idx = C.bid * 512 + C.tid; idx < 48 * 3072; idx += C.G * 512) { const int kc = idx / 3072, n = idx % 3072, k0 = 8 * kc; float v[8];
#pragma unroll
          for (int j = 0; j < 8; ++j) { const int k = k0 + j; float x = 0.f;
              if (n < 1024) { if (k < 64) x = w2[(size_t)k * D + n]; }
              else if (n < 2048) { if (k >= 64 && k < 128) x = a2[(size_t)(k - 64) * D + (n - 1024)]; }
              else { if (k >= 128 && k < 288) x = g2[(size_t)(k - 128) * D + (n - 2048)]; }
              v[j] = x; }
          v4u o; o.x = pk2(v[0], v[1]); o.y = pk2(v[2], v[3]); o.z = pk2(v[4], v[5]); o.w = pk2(v[6], v[7]);
          *(GAS v4u*)(WL2 + (size_t)n * 384 + k0) = o; } }
    { float* rope = (float*)(ws + WS_ROPE);
      for (int idx = C.bid * 512 + C.tid; idx < 2056 * 8; idx += C.G * 512) { const int pos = idx >> 3, i = idx & 7;
          const double c = i == 0 ? 0.15915494309189535 : i == 1 ? 0.03086376340470123 : i == 2 ? 0.005985185712713705 : i == 3 ? 0.001160663641240061 :
                           i == 4 ? 0.00022507907903927653 : i == 5 ? 4.364795279280289e-05 : i == 6 ? 8.464330808241401e-06 : 1.6414262627950345e-06;
          const double rev = (double)pos * c; const float fr = (float)(rev - __builtin_floor(rev));
          rope[2 * idx] = __builtin_amdgcn_cosf(fr); rope[2 * idx + 1] = __builtin_amdgcn_sinf(fr); } }
    { const float* g0 = in.p[8]; const float* mu = in.p[9]; bf16* XM = (bf16*)(ws + WS_XM);
      for (int m = 2 * C.gw; m < M; m += 2 * C.NGW) {
          const bool pr = m < MP; const int t = pr ? (m & (PT - 1)) : ((m - MP) & (STN - 1)), b = pr ? (m >> 11) : ((m - MP) >> 3);
          const float* xr = pr ? in.p[0] + (size_t)m * D : in.p[1] + (size_t)(m - MP) * D;
          f32x4 v0[4], v1[4], pv[4]; float s0 = 0.f, s1 = 0.f, ps = 0.f;
#pragma unroll
          for (int j = 0; j < 4; ++j) { v0[j] = *(const GAS f32x4*)(xr + 4 * C.lane + 256 * j); v1[j] = *(const GAS f32x4*)(xr + D + 4 * C.lane + 256 * j);
              pv[j] = t > 0 ? *(const GAS f32x4*)(xr - D + 4 * C.lane + 256 * j) : (pr ? (f32x4){0.f, 0.f, 0.f, 0.f} : *(const GAS f32x4*)(in.p[2] + (size_t)b * D + 4 * C.lane + 256 * j)); }
#pragma unroll
          for (int j = 0; j < 4; ++j) { s0 += (v0[j].x * v0[j].x + v0[j].y * v0[j].y) + (v0[j].z * v0[j].z + v0[j].w * v0[j].w); s1 += (v1[j].x * v1[j].x + v1[j].y * v1[j].y) + (v1[j].z * v1[j].z + v1[j].w * v1[j].w);
              ps += (pv[j].x * pv[j].x + pv[j].y * pv[j].y) + (pv[j].z * pv[j].z + pv[j].w * pv[j].w); }
          const float r0 = 1.0f / sqrtf(wave_sum(s0) * (1.f / D) + NORM_EPS), r1 = 1.0f / sqrtf(wave_sum(s1) * (1.f / D) + NORM_EPS), prs = 1.0f / sqrtf(wave_sum(ps) * (1.f / D) + NORM_EPS);
          const bool last = pr ? (t == PT - 2) : (t == STN - 2);
#pragma unroll
          for (int j = 0; j < 4; ++j) { const int col = 4 * C.lane + 256 * j; const f32x4 g = *(const GAS f32x4*)(g0 + col);
              const f32x4 h0 = v0[j] * r0 * g, h1 = v1[j] * r1 * g; const f32x4 hp = t > 0 ? pv[j] * prs * g : pv[j]; const f32x4 x0 = hp - h0, x1 = h0 - h1;
              if (last) *(GAS f32x4*)(out + (pr ? O_PSHIFT : O_SSHIFT) + (size_t)b * D + col) = h1;
#pragma unroll
              for (int i = 0; i < 6; ++i) { const f32x4 mm = *(const GAS f32x4*)(mu + i * D + col); const f32x4 a0 = h0 + x0 * mm, a1 = h1 + x1 * mm;
                  const int slot = i == 1 ? 3 : (i == 2 ? 1 : (i == 3 ? 2 : i));
                  bf16* dst = XM + (size_t)slot * M * D + (size_t)m * D + col;
                  v2u o; o.x = pk2(a0.x, a0.y); o.y = pk2(a0.z, a0.w); *(GAS v2u*)dst = o; o.x = pk2(a1.x, a1.y); o.y = pk2(a1.z, a1.w); *(GAS v2u*)(dst + D) = o; } }
      } }
}

constexpr int SC_OPS = 0, SC_OPS_BYTES = 16 * 16 * 20 * 4, SC_VV = 2 * SC_OPS_BYTES, SC_VV_BYTES = 16 * 32 * 4, SC_YB = SC_VV + 2 * SC_VV_BYTES, SC_YB_BYTES = 16 * 32 * 4;
struct ScanItem { size_t tok; int b, h, vh, nt; bool prompt, first, last, valid; };
__device__ __forceinline__ ScanItem scan_item(int q, int bid, int G) {
    ScanItem it; const int npu = (PB * RH * 2 - bid + G - 1) / G, npi = npu > 0 ? npu * 128 : 0;
    if (q < npi) { const int u = bid + (q >> 7) * G, c = q & 127; it.b = u >> 5; it.h = (u >> 1) & 15; it.vh = u & 1; it.tok = (size_t)it.b * PT + 16 * c; it.nt = 16; it.prompt = true; it.first = c == 0; it.last = c == 127; it.valid = true; }
    else { const int su = bid + (q - npi) * G; it.valid = su < SBN * RH * 2; it.b = su >> 5; it.h = (su >> 1) & 15; it.vh = su & 1; it.tok = (size_t)MP + (size_t)it.b * STN; it.nt = 8; it.prompt = false; it.first = true; it.last = true; }
    return it;
}
__device__ __forceinline__ void scan_phase(const Ctx& C, const In& in, unsigned char* ws, float* out) {
    const float* Rb = (const float*)(ws + WS_R); const float* Kb = (const float*)(ws + WS_K); const float* Vb = (const float*)(ws + WS_V);
    const float* Db = (const float*)(ws + WS_DC); const float* Ab = (const float*)(ws + WS_AA); float* Yb = (float*)(ws + WS_Y); float* Bon = (float*)(ws + WS_BONUS);
    const int row = C.tid >> 4, p = C.tid & 15;
    LAS float* OPS = (LAS float*)(C.lds + SC_OPS); LAS float* VV = (LAS float*)(C.lds + SC_VV); LAS float* YB = (LAS float*)(C.lds + SC_YB);
    const bool stg = C.tid < 256, stv = C.tid >= 256 && C.tid < 384; const int vt = (C.tid - 256) >> 3, vq = (C.tid - 256) & 7;
    f32x4 lr, lk, ld, la, lv, Snext, pka, pkw, prk, nka, nkw, nrk; lr = lk = ld = la = lv = Snext = pka = pkw = prk = nka = nkw = nrk = (f32x4){0.f, 0.f, 0.f, 0.f};
#define SC_FETCH(it) do { if ((it).valid) { \
        if (stg && row < (it).nt) { const size_t o = ((it).tok + row) * D + (it).h * 64 + 4 * p; lr = *(const GAS f32x4*)(Rb + o); lk = *(const GAS f32x4*)(Kb + o); ld = *(const GAS f32x4*)(Db + o); la = *(const GAS f32x4*)(Ab + o); } \
        if (stv && vt < (it).nt) lv = *(const GAS f32x4*)(Vb + ((it).tok + vt) * D + (it).h * 64 + 32 * (it).vh + 4 * vq); \
        if (stg && (it).first) { const int col_ = (it).h * 64 + 4 * p; nka = *(const GAS f32x4*)(in.p[23] + col_); nkw = *(const GAS f32x4*)(in.p[22] + col_); nrk = *(const GAS f32x4*)(in.p[24] + col_); } \
        if ((it).first && !(it).prompt) Snext = *(const GAS f32x4*)(in.p[3] + ((((size_t)(it).b * RH + (it).h) * 64 + 32 * (it).vh + row) * 64 + 4 * p)); } } while (0)
#define SC_STAGE(it, buf) do { if ((it).valid) { if ((it).first) { pka = nka; pkw = nkw; prk = nrk; } \
        if (stg && row < (it).nt) { \
            const f32x4 kp = lk * (1.0f + (la - 1.0f) * pka), kr = lk * pkw; const float n2 = row16_sum((kr.x * kr.x + kr.y * kr.y) + (kr.z * kr.z + kr.w * kr.w)); \
            const f32x4 kn = kr * __builtin_amdgcn_rsqf(fmaxf(n2, 1e-24f)); const f32x4 rb = lr * kp * prk; const float bon = row16_sum((rb.x + rb.y) + (rb.z + rb.w)); \
            LAS f32x4* o = (LAS f32x4*)(OPS + (buf) * (SC_OPS_BYTES / 4) + (row * 16 + p) * 20); o[0] = kn; o[1] = ld; o[2] = kp; o[3] = lr; o[4] = kn * la; \
            if ((it).vh == 0 && p == 0) Bon[((it).tok + row) * 16 + (it).h] = bon; } \
        if (stv && vt < (it).nt) *(LAS f32x4*)(VV + (buf) * (SC_VV_BYTES / 4) + vt * 32 + 4 * vq) = lv; } } while (0)
#define SC_STEP(tl) do { const f32x4 kk = op[(tl) * 80 + 0], dd = op[(tl) * 80 + 1], kp = op[(tl) * 80 + 2], rr = op[(tl) * 80 + 3], kka = op[(tl) * 80 + 4]; const float vv = vvp[(tl) * 32]; \
        f32x2 t_ = S01 * kk.lo; t_ = S23 * kk.hi + t_; const float sk = row16_sum(t_.x + t_.y); const f32x2 vv2 = (f32x2){vv, vv}, sk2 = (f32x2){sk, sk}; \
        S01 = S01 * dd.lo; S01 = kp.lo * vv2 + S01; S01 = S01 - kka.lo * sk2; S23 = S23 * dd.hi; S23 = kp.hi * vv2 + S23; S23 = S23 - kka.hi * sk2; \
        f32x2 u_ = S01 * rr.lo; u_ = S23 * rr.hi + u_; const float y = row16_sum(u_.x + u_.y); ykeep = (p == (tl)) ? y : ykeep; } while (0)
    ScanItem cur = scan_item(0, C.bid, C.G);
    if (!cur.valid) return;
    SC_FETCH(cur); SC_STAGE(cur, 0);
    f32x4 S = cur.prompt ? (f32x4){0.f, 0.f, 0.f, 0.f} : Snext; f32x2 S01 = S.lo, S23 = S.hi;
    __syncthreads();
#ifdef SCAN_DUP_STEPS
    f32x2 D01 = (f32x2){0.f, 0.f}, D23 = D01; float dacc = 0.f;
#endif
    for (int q = 0; cur.valid; ++q) {
        const int buf = q & 1; const ScanItem nxt = scan_item(q + 1, C.bid, C.G);
        SC_FETCH(nxt);
        float ykeep = 0.f;
        const LAS f32x4* op = (const LAS f32x4*)(OPS + buf * (SC_OPS_BYTES / 4) + p * 20); const LAS float* vvp = VV + buf * (SC_VV_BYTES / 4) + row;
        SC_STEP(0); SC_STEP(1); SC_STEP(2); SC_STEP(3); SC_STEP(4); SC_STEP(5); SC_STEP(6); SC_STEP(7);
        if (cur.nt == 16) { SC_STEP(8); SC_STEP(9); SC_STEP(10); SC_STEP(11); SC_STEP(12); SC_STEP(13); SC_STEP(14); SC_STEP(15); }
#ifdef SCAN_DUP_STEPS
        { f32x2 k01 = S01, k23 = S23; float yk2 = ykeep; S01 = D01; S23 = D23;
          SC_STEP(0); SC_STEP(1); SC_STEP(2); SC_STEP(3); SC_STEP(4); SC_STEP(5); SC_STEP(6); SC_STEP(7);
          if (cur.nt == 16) { SC_STEP(8); SC_STEP(9); SC_STEP(10); SC_STEP(11); SC_STEP(12); SC_STEP(13); SC_STEP(14); SC_STEP(15); }
          D01 = S01; D23 = S23; dacc += ykeep; S01 = k01; S23 = k23; ykeep = yk2; }
#endif
        if (p < cur.nt) YB[buf * (SC_YB_BYTES / 4) + p * 32 + row] = ykeep;
        if (cur.last) *(GAS f32x4*)(out + (cur.prompt ? O_PWKV : O_SWKV) + ((((size_t)cur.b * RH + cur.h) * 64 + 32 * cur.vh + row) * 64 + 4 * p)) = (f32x4){S01.x, S01.y, S23.x, S23.y};
        SC_STAGE(nxt, buf ^ 1);
        if (nxt.valid && nxt.first) { S = nxt.prompt ? (f32x4){0.f, 0.f, 0.f, 0.f} : Snext; S01 = S.lo; S23 = S.hi; }
        __syncthreads();
        { const int tl = C.tid >> 5, rr = C.tid & 31; if (tl < cur.nt) Yb[(cur.tok + tl) * D + cur.h * 64 + 32 * cur.vh + rr] = YB[buf * (SC_YB_BYTES / 4) + tl * 32 + rr]; }
        cur = nxt;
    }
#ifdef SCAN_DUP_STEPS
    ((float*)(ws + WS_ACT))[(size_t)C.bid * 512 + C.tid] = dacc + D01.x + D01.y + D23.x + D23.y;
#endif
#undef SC_FETCH
#undef SC_STAGE
#undef SC_STEP
}
__device__ __forceinline__ void scan_post_phase(const Ctx& C, const In& in, unsigned char* ws) {
    const float* Yb = (const float*)(ws + WS_Y); const float* Vb = (const float*)(ws + WS_V); const float* Gb = (const float*)(ws + WS_GG); const float* Bon = (const float*)(ws + WS_BONUS);
    bf16* YG = (bf16*)(ws + WS_YG); const float* lg = in.p[25]; const float* lb = in.p[26];
    for (int m = C.gw; m < M; m += C.NGW) {
#pragma unroll
        for (int j = 0; j < 4; ++j) { const int col = 4 * C.lane + 256 * j, head = 4 * j + (C.lane >> 4); const size_t o = (size_t)m * D + col;
            const f32x4 y = *(const GAS f32x4*)(Yb + o); const float mean = row16_sum((y.x + y.y) + (y.z + y.w)) * (1.f / 64.f);
            const f32x4 d = y - mean; const float var = row16_sum((d.x * d.x + d.y * d.y) + (d.z * d.z + d.w * d.w)) * (1.f / 64.f);
            const float rs = 1.0f / sqrtf(var + GN_EPS), bon = Bon[(size_t)m * 16 + head];
            const f32x4 vv = *(const GAS f32x4*)(Vb + o), gg = *(const GAS f32x4*)(Gb + o), g4 = *(const GAS f32x4*)(lg + col), b4 = *(const GAS f32x4*)(lb + col);
            const f32x4 r = (d * rs * g4 + b4 + vv * bon) * gg;
            v2u w; w.x = pk2(r.x, r.y); w.y = pk2(r.z, r.w); *(GAS v2u*)(YG + o) = w; }
    }
}
__device__ __forceinline__ void rowwise_phase(const Ctx& C, const In& in, const float* xin, const float* mo, const float* g1, float* xout, const float* g2, bf16* xn, int nsl) {
    const float* SLAB = (const float*)(mo) + ((ptrdiff_t)WS_SLAB - (ptrdiff_t)WS_MO) / 4;
    for (int m = C.gw; m < M; m += C.NGW) {
        const float* xr = xin ? xin + (size_t)m * D : (m < MP ? in.p[0] + (size_t)m * D : in.p[1] + (size_t)(m - MP) * D);
        f32x4 a[4], x[4]; float ss = 0.f;
#pragma unroll
        for (int j = 0; j < 4; ++j) {
            if (m < MP) a[j] = *(const GAS f32x4*)(mo + (size_t)m * D + 4 * C.lane + 256 * j);
            else { a[j] = (f32x4){0.f, 0.f, 0.f, 0.f}; for (int s = 0; s < nsl; ++s) a[j] = a[j] + *(const GAS f32x4*)(SLAB + ((size_t)s * 1024 + (m - MP)) * D + 4 * C.lane + 256 * j); }
            x[j] = *(const GAS f32x4*)(xr + 4 * C.lane + 256 * j);
            ss += (a[j].x * a[j].x + a[j].y * a[j].y) + (a[j].z * a[j].z + a[j].w * a[j].w); }
        const float rs = 1.0f / sqrtf(wave_sum(ss) * (1.f / D) + NORM_EPS); float s2 = 0.f;
#pragma unroll
        for (int j = 0; j < 4; ++j) { const int col = 4 * C.lane + 256 * j; x[j] = x[j] + a[j] * rs * *(const GAS f32x4*)(g1 + col);
            *(GAS f32x4*)(xout + (size_t)m * D + col) = x[j]; s2 += (x[j].x * x[j].x + x[j].y * x[j].y) + (x[j].z * x[j].z + x[j].w * x[j].w); }
        if (xn) { const float r2 = 1.0f / sqrtf(wave_sum(s2) * (1.f / D) + NORM_EPS);
#pragma unroll
            for (int j = 0; j < 4; ++j) { const int col = 4 * C.lane + 256 * j; const f32x4 r = x[j] * r2 * *(const GAS f32x4*)(g2 + col);
                v2u w; w.x = pk2(r.x, r.y); w.y = pk2(r.z, r.w); *(GAS v2u*)(xn + (size_t)m * D + col) = w; } }
    }
}
__device__ __forceinline__ float gelu_tanh(float x) { const float u = 0.7978845608028654f * (x + 0.044715f * x * x * x); return 0.5f * x * (1.0f + fast_tanh(u)); }
__device__ __forceinline__ void unpack8(const v4u w, float* f) { f[0] = bflo(w.x); f[1] = bfhi(w.x); f[2] = bflo(w.y); f[3] = bfhi(w.y); f[4] = bflo(w.z); f[5] = bfhi(w.z); f[6] = bflo(w.w); f[7] = bfhi(w.w); }
__device__ __forceinline__ void fixup_phase(const Ctx& C, unsigned char* ws, const float* cw, const float* cb, const float* sc) {
    const float* HALO = (const float*)(ws + WS_HID); const float* RAWS = (const float*)(ws + WS_HID + 8 * MiB); bf16* ACT = (bf16*)(ws + WS_ACT);
    constexpr int NC4 = FF / 4, NPROMPT = 56 * 2 * NC4, NSAMPLE = SBN * 2 * NC4;
    for (int idx = C.bid * 512 + C.tid; idx < NPROMPT + NSAMPLE; idx += C.G * 512) {
        const float *p0[2], *p1[2], *p2[2]; int c; size_t orow;
        if (idx < NPROMPT) { const int q = idx / NC4, r = q & 1, pi = q >> 1, pm = (pi / 7) * 8 + 1 + (pi % 7); c = (idx % NC4) * 4; orow = (size_t)pm * 256 + r;
#pragma unroll
            for (int s = 0; s < 2; ++s) { const size_t co = (size_t)s * FF + c; p0[s] = HALO + ((size_t)pm * 4 + r) * F2 + co;
                p1[s] = HALO + (r == 1 ? ((size_t)pm * 4 + 0) : ((size_t)(pm - 1) * 4 + 3)) * F2 + co; p2[s] = HALO + ((size_t)(pm - 1) * 4 + (r == 0 ? 2 : 3)) * F2 + co; }
        } else { const int q = (idx - NPROMPT) / NC4, t = q & 1, b = q >> 1, rs = b * 8 + t; c = ((idx - NPROMPT) % NC4) * 4; orow = (size_t)MP + rs;
#pragma unroll
            for (int s = 0; s < 2; ++s) { const size_t co = (size_t)s * FF + c; p0[s] = RAWS + (size_t)rs * F2 + co;
                p1[s] = t == 0 ? sc + ((size_t)b * 2 + 1) * F2 + co : RAWS + (size_t)(rs - 1) * F2 + co; p2[s] = sc + ((size_t)b * 2 + t) * F2 + co; }
        }
        f32x4 cv[2];
#pragma unroll
        for (int s = 0; s < 2; ++s) { const size_t co = (size_t)s * FF + c; const f32x4 h0 = *(const GAS f32x4*)p0[s], h1 = *(const GAS f32x4*)p1[s], h2 = *(const GAS f32x4*)p2[s];
            cv[s] = *(const GAS f32x4*)(cb + co) + *(const GAS f32x4*)(cw + co) * h2 + *(const GAS f32x4*)(cw + F2 + co) * h1 + *(const GAS f32x4*)(cw + 2 * F2 + co) * h0; }
        v2u o; o.x = pk2(gelu_tanh(cv[0].x) * cv[1].x, gelu_tanh(cv[0].y) * cv[1].y); o.y = pk2(gelu_tanh(cv[0].z) * cv[1].z, gelu_tanh(cv[0].w) * cv[1].w);
        *(GAS v2u*)(ACT + orow * FF + c) = o; }
}

constexpr float QSCALE = 0.125f * 1.4426950408889634f;
__device__ __forceinline__ void rope_phase(const Ctx& C, const In& in, unsigned char* ws, float* out) {
    bf16* QKV = (bf16*)(ws + WS_QKV); const float* rope = (const float*)(ws + WS_ROPE);
    for (int m = C.gw; m < M; m += C.NGW) {
        const bool pr = m < MP; const int t = pr ? (m & (PT - 1)) : ((m - MP) & 7), b = pr ? (m >> 11) : ((m - MP) >> 3), pos = pr ? t : PT + t;
        bf16* rowp = QKV + (size_t)m * NQKV;
        f32x4 cs0 = *(const GAS f32x4*)(rope + (size_t)pos * 16), cs1 = *(const GAS f32x4*)(rope + (size_t)pos * 16 + 4), cs2 = *(const GAS f32x4*)(rope + (size_t)pos * 16 + 8), cs3 = *(const GAS f32x4*)(rope + (size_t)pos * 16 + 12);
        const float cc[8] = {cs0.x, cs0.z, cs1.x, cs1.z, cs2.x, cs2.z, cs3.x, cs3.z}, sn[8] = {cs0.y, cs0.w, cs1.y, cs1.w, cs2.y, cs2.w, cs3.y, cs3.w};
#pragma unroll
        for (int it = 0; it < 9; ++it) {
            const int c8 = C.lane + 64 * it, col0 = 8 * c8, s = col0 / 1536, rem = col0 % 1536, g = rem / 512, h = (rem % 512) / 64, e0 = rem % 64;
            const v4u own = *(const GAS v4u*)(rowp + col0);
            const bool rot = (s < 2) && (e0 < 16);
            v4u par = own; if (rot) par = *(const GAS v4u*)(rowp + col0 + (e0 == 0 ? 8 : -8));
            float x[8], y[8], o[8]; unpack8(own, x); unpack8(par, y);
#pragma unroll
            for (int i = 0; i < 8; ++i) o[i] = !rot ? x[i] : (e0 == 0 ? x[i] * cc[i] - y[i] * sn[i] : x[i] * cc[i] + y[i] * sn[i]);
            if (s == 0) {
#pragma unroll
                for (int i = 0; i < 8; ++i) o[i] *= QSCALE; }
            if (s < 2) { v4u w; w.x = pk2(o[0], o[1]); w.y = pk2(o[2], o[3]); w.z = pk2(o[4], o[5]); w.w = pk2(o[6], o[7]); *(GAS v4u*)(rowp + col0) = w; }
            if (s >= 1) {
                const int L = g == 0 ? 128 : (g == 1 ? 512 : 2048); float* dst = nullptr;
                if (pr) { const int j = t - (PT - L); if (j >= 0) dst = out + (g == 0 ? O_PKV128 : (g == 1 ? O_PKV512 : O_PKV2048)) + ((((size_t)b * L + j) * 2 + (s - 1)) * 8 + h) * 64 + e0; }
                else dst = out + (g == 0 ? O_SKV128 : (g == 1 ? O_SKV512 : O_SKV2048)) + ((((size_t)b * 8 + t) * 2 + (s - 1)) * 8 + h) * 64 + e0;
                if (dst) { *(GAS f32x4*)dst = (f32x4){o[0], o[1], o[2], o[3]}; *(GAS f32x4*)(dst + 4) = (f32x4){o[4], o[5], o[6], o[7]}; } }
        }
    }
}

constexpr int AT_RS = 160;
constexpr int AT_K = 0, AT_V = 256 * AT_RS;
typedef short s16x4 __attribute__((ext_vector_type(4)));
__device__ __forceinline__ s16x4 lds_tr16(const LAS unsigned char* p) { return __builtin_bit_cast(s16x4, __builtin_amdgcn_ds_read_tr16_b64_v4i16((LAS s16x4*)p)); }
struct PUnit { int b, h, g, res, n; };
__device__ __forceinline__ PUnit punit(int u) { PUnit r; const int bh = u / 48, j = u % 48; r.b = bh >> 3; r.h = bh & 7;
    if (j < 16) { r.g = 0; r.res = 0; r.n = j; } else if (j < 32) { r.g = 1; r.res = (j - 16) >> 2; r.n = (j - 16) & 3; } else { r.g = 2; r.res = j - 32; r.n = 0; } return r; }
__device__ __forceinline__ void pattn_load(const Ctx& C, const bf16* QKV, const PUnit& u, v4u (&kr)[4], v4u (&vr)[4]) {
    const int Dl = u.g == 0 ? 1 : (u.g == 1 ? 4 : 16);
#pragma unroll
    for (int i = 0; i < 4; ++i) { const int ch = C.tid + 512 * i, kj = ch >> 3, c = ch & 7; int lk = (u.n - 1) * 128 + kj; lk = lk < 0 ? 0 : lk;
        const bf16* rp = QKV + ((size_t)u.b * PT + u.res + Dl * lk) * NQKV + u.h * 64 + c * 8;
        kr[i] = *(const GAS v4u*)(rp + (3 + u.g) * 512); vr[i] = *(const GAS v4u*)(rp + (6 + u.g) * 512); }
}
__device__ __forceinline__ void pattn_store_lds(const Ctx& C, const v4u (&kr)[4], const v4u (&vr)[4]) {
#pragma unroll
    for (int i = 0; i < 4; ++i) { const int ch = C.tid + 512 * i, kj = ch >> 3, c = ch & 7;
        *(LAS v4u*)(C.lds + AT_K + kj * AT_RS + c * 16) = kr[i]; *(LAS v4u*)(C.lds + AT_V + kj * AT_RS + c * 16) = vr[i]; }
}
__device__ __forceinline__ void pattn_compute(const Ctx& C, unsigned char* ws, const PUnit& u) {
    const bf16* QKV = (const bf16*)(ws + WS_QKV); bf16* OG = (bf16*)(ws + WS_OG); float* LSE = (float*)(ws + WS_LSE);
    const int Dl = u.g == 0 ? 1 : (u.g == 1 ? 4 : 16), q16 = C.lane & 15, g4 = C.lane >> 4, qi = 16 * C.wave + q16;
    const size_t qrow = (size_t)u.b * PT + u.res + Dl * (u.n * 128 + qi);
    const bf16* qp = QKV + qrow * NQKV + u.g * 512 + u.h * 64;
    const bf16x8 qf0 = *(const GAS bf16x8*)(qp + 8 * g4), qf1 = *(const GAS bf16x8*)(qp + 32 + 8 * g4);
    f32x4 sc[16];
    const LAS unsigned char* kbase = C.lds + AT_K + q16 * AT_RS + g4 * 16;
#pragma unroll
    for (int T = 0; T < 16; ++T) { const bf16x8 k0 = *(const LAS bf16x8*)(kbase + T * 16 * AT_RS), k1 = *(const LAS bf16x8*)(kbase + T * 16 * AT_RS + 64);
        f32x4 a = __builtin_amdgcn_mfma_f32_16x16x32_bf16(k0, qf0, (f32x4){0.f, 0.f, 0.f, 0.f}, 0, 0, 0); sc[T] = __builtin_amdgcn_mfma_f32_16x16x32_bf16(k1, qf1, a, 0, 0, 0); }
    const int klo = (u.n == 0 && qi < 128) ? 128 : qi; float mx = -1e30f;
#pragma unroll
    for (int T = 0; T < 16; ++T)
#pragma unroll
        for (int j = 0; j < 4; ++j) { const int kj = 16 * T + 4 * g4 + j; const bool ok = kj >= klo && kj <= qi + 128; sc[T][j] = ok ? sc[T][j] : -1e30f; mx = fmaxf(mx, sc[T][j]); }
    mx = fmaxf(mx, __shfl_xor(mx, 16)); mx = fmaxf(mx, __shfl_xor(mx, 32));
    float sum = 0.f;
#pragma unroll
    for (int T = 0; T < 16; ++T)
#pragma unroll
        for (int j = 0; j < 4; ++j) { const float p = __builtin_amdgcn_exp2f(sc[T][j] - mx); sc[T][j] = p; sum += p; }
    sum += __shfl_xor(sum, 16); sum += __shfl_xor(sum, 32);
    f32x4 oa[4] = {(f32x4){0.f, 0.f, 0.f, 0.f}, (f32x4){0.f, 0.f, 0.f, 0.f}, (f32x4){0.f, 0.f, 0.f, 0.f}, (f32x4){0.f, 0.f, 0.f, 0.f}};
    const LAS unsigned char* vbase = C.lds + AT_V + (4 * g4 + (q16 >> 2)) * AT_RS + (q16 & 3) * 8;
#pragma unroll
    for (int s = 0; s < 8; ++s) {
        pg8::u32x4 pw; pw.x = pg8::cvt_pk_bf16(sc[2 * s][0], sc[2 * s][1]); pw.y = pg8::cvt_pk_bf16(sc[2 * s][2], sc[2 * s][3]); pw.z = pg8::cvt_pk_bf16(sc[2 * s + 1][0], sc[2 * s + 1][1]); pw.w = pg8::cvt_pk_bf16(sc[2 * s + 1][2], sc[2 * s + 1][3]);
        const bf16x8 pf = __builtin_bit_cast(bf16x8, pw);
#pragma unroll
        for (int c = 0; c < 4; ++c) { const s16x4 lo = lds_tr16(vbase + (32 * s) * AT_RS + c * 32), hi = lds_tr16(vbase + (32 * s + 16) * AT_RS + c * 32);
            const bf16x8 vf = (bf16x8){lo[0], lo[1], lo[2], lo[3], hi[0], hi[1], hi[2], hi[3]};
            oa[c] = __builtin_amdgcn_mfma_f32_16x16x32_bf16(vf, pf, oa[c], 0, 0, 0); }
    }
    const float inv = 1.0f / sum;
    bf16* op = OG + ((size_t)u.g * M + qrow) * AW + u.h * 64 + 4 * g4;
#pragma unroll
    for (int c = 0; c < 4; ++c) { v2u w; w.x = pk2(oa[c][0] * inv, oa[c][1] * inv); w.y = pk2(oa[c][2] * inv, oa[c][3] * inv); *(GAS v2u*)(op + 16 * c) = w; }
    if (g4 == 0) LSE[((size_t)u.g * M + qrow) * 8 + u.h] = mx + __builtin_amdgcn_logf(sum);
}
__device__ __forceinline__ void sattn_unit(const Ctx& C, const float* cache_g, unsigned char* ws, const float* out, int b, int g, int h) {
    const bf16* QKV = (const bf16*)(ws + WS_QKV); bf16* OG = (bf16*)(ws + WS_OG); float* LSE = (float*)(ws + WS_LSE);
    const int L = g == 0 ? 128 : (g == 1 ? 512 : 2048), Dl = g == 0 ? 1 : (g == 1 ? 4 : 16), i = C.wave, d16 = C.lane & 15, sub = C.lane >> 4;
    const size_t qrow = (size_t)MP + (size_t)b * 8 + i;
    const v2u qw = *(const GAS v2u*)(QKV + qrow * NQKV + g * 512 + h * 64 + 4 * d16);
    const f32x4 q = (f32x4){bflo(qw.x), bfhi(qw.x), bflo(qw.y), bfhi(qw.y)};
    const float* cache = cache_g + (size_t)b * L * 1024 + h * 64 + 4 * d16;
    const float* fresh = out + (g == 0 ? O_SKV128 : (g == 1 ? O_SKV512 : O_SKV2048)) + (size_t)b * 8 * 1024 + h * 64 + 4 * d16;
    float s[33]; float mx = -1e30f;
#pragma unroll
    for (int it = 0; it < 33; ++it) { const int j = 4 * it + sub; const bool ok = j <= 128; const int idx = L + i - Dl * (ok ? j : 0);
        const float* kp = idx >= L ? fresh + (size_t)(idx - L) * 1024 : cache + (size_t)idx * 1024;
        const f32x4 kv = *(const GAS f32x4*)kp;
        float d = (q.x * kv.x + q.y * kv.y) + (q.z * kv.z + q.w * kv.w); d = row16_sum(d);
        s[it] = ok ? d : -1e30f; mx = fmaxf(mx, s[it]); }
    mx = fmaxf(mx, __shfl_xor(mx, 16)); mx = fmaxf(mx, __shfl_xor(mx, 32));
    float sum = 0.f; f32x4 o = (f32x4){0.f, 0.f, 0.f, 0.f};
#pragma unroll
    for (int it = 0; it < 33; ++it) { const int j = 4 * it + sub; const bool ok = j <= 128; const int idx = L + i - Dl * (ok ? j : 0);
        const float* vp = (idx >= L ? fresh + (size_t)(idx - L) * 1024 : cache + (size_t)idx * 1024) + 512;
        const f32x4 vv = *(const GAS f32x4*)vp; const float p = __builtin_amdgcn_exp2f(s[it] - mx); sum += p; o = o + vv * p; }
    sum += __shfl_xor(sum, 16); sum += __shfl_xor(sum, 32);
#pragma unroll
    for (int e = 0; e < 4; ++e) { o[e] += __shfl_xor(o[e], 16); o[e] += __shfl_xor(o[e], 32); }
    if (sub == 0) { const float inv = 1.0f / sum; v2u w; w.x = pk2(o.x * inv, o.y * inv); w.y = pk2(o.z * inv, o.w * inv);
        *(GAS v2u*)(OG + ((size_t)g * M + qrow) * AW + h * 64 + 4 * d16) = w;
        if (d16 == 0) LSE[((size_t)g * M + qrow) * 8 + h] = mx + __builtin_amdgcn_logf(sum); }
}
typedef const __attribute__((address_space(4))) In* KInP;
__device__ __forceinline__ void attn_phase(const Ctx& C, KInP kp, unsigned char* ws, float* out) {
    const bf16* QKV = (const bf16*)(ws + WS_QKV);
    constexpr int NPU = PB * 8 * 48;
    v4u kr[4], vr[4];
    int u = C.bid;
    if (u < NPU) { const PUnit pu = punit(u); pattn_load(C, QKV, pu, kr, vr); }
    for (; u < NPU; u += C.G) {
        const PUnit pu = punit(u);
        pattn_store_lds(C, kr, vr);
        __syncthreads();
        if (u + C.G < NPU) { const PUnit nu = punit(u + C.G); pattn_load(C, QKV, nu, kr, vr); }
        pattn_compute(C, ws, pu);
        __syncthreads();
    }
#ifndef ATTN_REP_SAMPLE
#define ATTN_REP_SAMPLE 1
#endif
    for (int rep_ = 0; rep_ < ATTN_REP_SAMPLE; ++rep_)
    for (int su = C.bid; su < SBN * 3 * 8; su += C.G) { const int h = su & 7, b = (su >> 3) & 127, g = su >> 10; const float* cache_g = kp->p[4 + (2 - g)];
        sattn_unit(C, cache_g, ws, out, b, 2 - g, h); }
}
__device__ __forceinline__ void merge_phase(const Ctx& C, unsigned char* ws) {
    const bf16* OG = (const bf16*)(ws + WS_OG); const float* LSE = (const float*)(ws + WS_LSE); bf16* OM = (bf16*)(ws + WS_OM);
    for (int idx = C.bid * 512 + C.tid; idx < M * 64; idx += C.G * 512) { const int m = idx >> 6, c8 = idx & 63, h = c8 >> 3;
        const float l0 = LSE[((size_t)0 * M + m) * 8 + h], l1 = LSE[((size_t)1 * M + m) * 8 + h], l2 = LSE[((size_t)2 * M + m) * 8 + h];
        const float mx = fmaxf(l0, fmaxf(l1, l2)); float w0 = __builtin_amdgcn_exp2f(l0 - mx), w1 = __builtin_amdgcn_exp2f(l1 - mx), w2 = __builtin_amdgcn_exp2f(l2 - mx);
        const float inv = 1.0f / (w0 + w1 + w2); w0 *= inv; w1 *= inv; w2 *= inv;
        float a[8], b[8], c[8];
        unpack8(*(const GAS v4u*)(OG + ((size_t)0 * M + m) * AW + 8 * c8), a); unpack8(*(const GAS v4u*)(OG + ((size_t)1 * M + m) * AW + 8 * c8), b); unpack8(*(const GAS v4u*)(OG + ((size_t)2 * M + m) * AW + 8 * c8), c);
        float o[8];
#pragma unroll
        for (int e = 0; e < 8; ++e) o[e] = w0 * a[e] + w1 * b[e] + w2 * c[e];
        v4u w; w.x = pk2(o[0], o[1]); w.y = pk2(o[2], o[3]); w.z = pk2(o[4], o[5]); w.w = pk2(o[6], o[7]);
        *(GAS v4u*)(OM + (size_t)m * AW + 8 * c8) = w; }
}

#ifndef MK_ONE_LAUNCH
#define MK_ONE_LAUNCH 1
#endif
#ifndef REP_MASK
#define REP_MASK 0
#endif
#ifndef ONLY
#define ONLY -1
#endif
constexpr int N_PHASES = 21;
struct Args { In in; float* out; unsigned char* ws; int ph_lo, ph_hi; };
typedef const __attribute__((address_space(4))) In* KIn;
__device__ __forceinline__ KIn launder_kernarg() { unsigned long long p = (unsigned long long)__builtin_amdgcn_kernarg_segment_ptr(); asm volatile("" : "+s"(p)); return (KIn)p; }
#define IN_LOAD() In in; { KIn kp_ = launder_kernarg(); _Pragma("unroll") for (int i_ = 0; i_ < 33; ++i_) in.p[i_] = kp_->p[i_]; }
#define GEMM_PHASE(EPI, Aoff, Boff, Nn, Kk, ASEL, ...) { pg8::Gemm g{(const bf16*)(ws + (Aoff)), (const bf16*)(ws + (Boff)), M, (Nn), (Kk), (ASEL)}; pg8::StaticOrder S; S.init(M, (Nn), C.G, C.bid, (Kk)); \
        pg8::EPI E{__VA_ARGS__}; pg8::gemm_phase<pg8::EPI, pg8::StaticOrder, true, true>(ring, g, S, E); }
#define SPLIT_PHASE(Aoff, Boff, Kk) { pg8::Gemm g{(const bf16*)(ws + (Aoff)), (const bf16*)(ws + (Boff)), M, D, (Kk), 0}; pg8::SplitOrder S; S.init(C.G, C.bid, (Kk)); \
        pg8::EpiF32S E{(float*)(ws + WS_MO), (float*)(ws + WS_SLAB)}; pg8::gemm_phase<pg8::EpiF32S, pg8::SplitOrder, true, true>(ring, g, S, E); }
#define DOWN_PHASE(Boff, layer) SPLIT_PHASE(WS_ACT, Boff, FF)
#define FIX_PHASE(layer) { IN_LOAD(); fixup_phase(C, ws, in.p[30] + (size_t)(layer) * 3 * F2, in.p[31] + (size_t)(layer) * F2, in.p[7] + (size_t)(layer) * SBN * 2 * F2); }
#define UP_PHASE(Boff, layer) { IN_LOAD(); GEMM_PHASE(EpiConv, WS_XN, Boff, F2, D, 0, (bf16*)(ws + WS_ACT), (float*)(ws + WS_HID), (float*)(ws + WS_HID + 8 * MiB), out + O_PCONV + (size_t)(layer) * PB * 2 * F2, out + O_SCONV + (size_t)(layer) * SBN * 2 * F2, \
        in.p[30] + (size_t)(layer) * 3 * F2, in.p[31] + (size_t)(layer) * F2, (LAS float*)(C.lds + EX_OFF)) }

#define PBODY_0 { IN_LOAD(); p0_prologue(C, in, ws, out); }
#define PBODY_1 GEMM_PHASE(EpiG1, WS_XM, WS_W1CAT, 3840, D, RB16, (float*)(ws + WS_R), (bf16*)(ws + WS_L2A))
#define PBODY_2 { IN_LOAD(); GEMM_PHASE(EpiL2, WS_L2A, WS_WL2, 3072, 384, 0, (float*)(ws + WS_DC), in.p[14], in.p[17]) }
#define PBODY_3 { IN_LOAD(); scan_phase(C, in, ws, out); }
#define PBODY_4 { IN_LOAD(); scan_post_phase(C, in, ws); }
#define PBODY_5 SPLIT_PHASE(WS_YG, WS_WORW, D)
#define PBODY_6 { IN_LOAD(); rowwise_phase(C, in, nullptr, (const float*)(ws + WS_MO), in.p[8] + 1 * D, (float*)(ws + WS_X1), in.p[8] + 2 * D, (bf16*)(ws + WS_XN), D / 256); }
#define PBODY_7 UP_PHASE(WS_WUP0, 0)
#define PBODY_8 FIX_PHASE(0)
#define PBODY_9 DOWN_PHASE(WS_WDN0, 0)
#define PBODY_10 { IN_LOAD(); rowwise_phase(C, in, (const float*)(ws + WS_X1), (const float*)(ws + WS_MO), in.p[8] + 3 * D, (float*)(ws + WS_X2), in.p[8] + 4 * D, (bf16*)(ws + WS_XN), FF / 256); }
#define PBODY_11 GEMM_PHASE(EpiBf16, WS_XN, WS_WQKV, NQKV, D, 0, (bf16*)(ws + WS_QKV), NQKV)
#define PBODY_12 { IN_LOAD(); rope_phase(C, in, ws, out); }
#define PBODY_13 { attn_phase(C, launder_kernarg(), ws, out); }
#define PBODY_14 { merge_phase(C, ws); }
#define PBODY_15 SPLIT_PHASE(WS_OM, WS_WOAT, AW)
#define PBODY_16 { IN_LOAD(); rowwise_phase(C, in, (const float*)(ws + WS_X2), (const float*)(ws + WS_MO), in.p[8] + 5 * D, (float*)(ws + WS_X3), in.p[8] + 6 * D, (bf16*)(ws + WS_XN), AW / 256); }
#define PBODY_17 UP_PHASE(WS_WUP1, 1)
#define PBODY_18 FIX_PHASE(1)
#define PBODY_19 DOWN_PHASE(WS_WDN1, 1)
#define PBODY_20 { IN_LOAD(); rowwise_phase(C, in, (const float*)(ws + WS_X3), (const float*)(ws + WS_MO), in.p[8] + 7 * D, out + O_YP, nullptr, nullptr, FF / 256); }

__global__ void __launch_bounds__(NWAVES * 64, 2) fwd(Args args) {
    extern __shared__ __attribute__((aligned(16))) unsigned char lds[];
    Ctx C; C.lds = (LAS unsigned char*)lds; C.tid = threadIdx.x; C.lane = C.tid & 63; C.wave = __builtin_amdgcn_readfirstlane(C.tid >> 6);
    C.G = gridDim.x; C.bid = blockIdx.x; C.gw = C.bid * NWAVES + C.wave; C.NGW = C.G * NWAVES;
    unsigned char* ws = args.ws; float* out = args.out;
    volatile LAS unsigned* MISC = (volatile LAS unsigned*)(C.lds + MISC_OFF);
    for (int u = C.tid; u < (LDS_BYTES - LDSCTL_OFF) / 4; u += NWAVES * 64) ((LAS unsigned*)(C.lds + LDSCTL_OFF))[u] = 0u;
    __syncthreads();
    XcdBarrier bar; bar.bar = (unsigned*)(ws + WS_CTL) + CW_BAR; bar.x = 0; bar.st = nullptr;
    const int lo = args.ph_lo, hi = args.ph_hi;
    if (hi - lo > 1) bar = xcd_barrier_post((unsigned*)(ws + WS_CTL) + CW_BAR, MISC + 8);
    LAS unsigned char* ring = C.lds + RING_OFF;
#define IN(k) ((ONLY < 0 || ONLY == (k)) && lo <= (k) && (k) < hi)
#define PHASE(k) if (IN(k)) PBODY_##k if (IN(k) && ((REP_MASK >> (k)) & 1)) { if (hi - lo > 1) xcd_barrier(bar); PBODY_##k } if (IN(k) && IN((k) + 1)) xcd_barrier(bar);
    PHASE(0) PHASE(1) PHASE(2) PHASE(3) PHASE(4) PHASE(5) PHASE(6) PHASE(7) PHASE(8) PHASE(9) PHASE(10) PHASE(11) PHASE(12) PHASE(13) PHASE(14) PHASE(15) PHASE(16) PHASE(17) PHASE(18) PHASE(19) PHASE(20)
#undef IN
#undef PHASE
}

extern "C" void kernel_launch(void* const* d_in, const int* in_sizes, int n_in, void* d_out, int out_size, void* d_ws, size_t ws_size, hipStream_t stream) {
    static int grid = 0;
    if (grid == 0) {
        if (n_in != 33 || (size_t)out_size != O_END || ws_size < WS_END) { fprintf(stderr, "kernel_launch: unexpected sizes: n_in %d out %d ws %zu (need %zu)\n", n_in, out_size, ws_size, (size_t)WS_END); grid = -1; return; }
        int dev = 0, cus = 0, per_cu = 0;
        if (hipGetDevice(&dev) != hipSuccess || hipDeviceGetAttribute(&cus, hipDeviceAttributeMultiprocessorCount, dev) != hipSuccess) { grid = -1; return; }
        if (hipFuncSetAttribute((const void*)fwd, hipFuncAttributeMaxDynamicSharedMemorySize, LDS_BYTES) != hipSuccess) { fprintf(stderr, "kernel_launch: hipFuncSetAttribute failed\n"); grid = -1; return; }
        if (hipOccupancyMaxActiveBlocksPerMultiprocessor(&per_cu, (const void*)fwd, NWAVES * 64, LDS_BYTES) != hipSuccess || per_cu < 1) { fprintf(stderr, "kernel_launch: occupancy query says %d\n", per_cu); }
        (void)hipGetLastError();
        grid = cus;
    }
    if (grid < 0) return;
    (void)hipMemsetAsync((char*)d_ws + WS_CTL, 0, CTL_ZERO_BYTES, stream);
    Args a{};
    for (int i = 0; i < 33; ++i) a.in.p[i] = (const float*)d_in[i];
    a.out = (float*)d_out; a.ws = (unsigned char*)d_ws;
#if MK_ONE_LAUNCH
    a.ph_lo = 0; a.ph_hi = N_PHASES;
    hipLaunchKernelGGL(fwd, dim3(grid), dim3(NWAVES * 64), LDS_BYTES, stream, a);
#else
    for (int ph = 0; ph < N_PHASES; ++ph) { a.ph_lo = ph; a.ph_hi = ph + 1; hipLaunchKernelGGL(fwd, dim3(grid), dim3(NWAVES * 64), LDS_BYTES, stream, a); }
#endif
}
```
